# Optimizing an MI355X kernel written in HIP

```python
import jax, jax.numpy as jnp
from jax import lax
import numpy as np

D_MODEL = 2048
BATCH = 2
SEQ = 4096
DEPTH = 2
DEC_BATCH = 8
DEC_SEQ = 16
PAST_LEN = 2048

CHUNK = 64
Q_BLOCK = 128
NORM_EPS = 1e-6
D_FF = 5632
N_ADA = 9
N_BRANCH = 3
BRANCH_WIDTH = 1024
ML_HEADS = 4
ML_DQK = 128
ML_DV = 256
ML_GATE_CAP = 15.0
MLA_HEADS = 8
MLA_NOPE = 128
MLA_ROPE = 64
MLA_V = 128
MLA_LATENT = 512
ROPE_BASE = 10000.0
RW_HEADS = 16
RW_HEAD = 64
RW_WIDTH = RW_HEADS * RW_HEAD
RW_DECAY_LORA = 64
RW_A_LORA = 64
RW_G_LORA = 128
RW_LN_EPS = 64e-5

ML_SIZES = (ML_HEADS * ML_DQK, ML_HEADS * ML_DQK, ML_HEADS * ML_DV, ML_HEADS * ML_DV, ML_HEADS, ML_HEADS)
MLA_SIZES = (MLA_HEADS * (MLA_NOPE + MLA_ROPE), MLA_LATENT, MLA_ROPE)
RW_SIZES = (RW_WIDTH, RW_WIDTH, RW_WIDTH, RW_DECAY_LORA, RW_A_LORA, RW_G_LORA)
ML_COLS = sum(ML_SIZES)
MLA_COLS = sum(MLA_SIZES)
RW_COLS = sum(RW_SIZES)
GATE_COLS = N_BRANCH * D_MODEL
IN_COLS = ML_COLS + MLA_COLS + RW_COLS + GATE_COLS

kernel_name = 'hybrid_streaming_mlstm_mla_rwkv7'


def _split(x, sizes):
    return jnp.split(x, [int(i) for i in np.cumsum(sizes)[:-1]], axis=-1)


def rms_norm(x, g, eps=NORM_EPS):
    xf = x.astype(jnp.float32)
    y = xf * lax.rsqrt(jnp.mean(xf * xf, axis=-1, keepdims=True) + eps)
    return (y * g.astype(jnp.float32)).astype(x.dtype)


def modulate(h, shift, scale):
    return h * (1.0 + scale) + shift


def softcap(x, cap=ML_GATE_CAP):
    return cap * jnp.tanh(x / cap)


def rope(x, pos):
    half = x.shape[-1] // 2
    inv = ROPE_BASE ** (-jnp.arange(half, dtype=jnp.float32) / half)
    ang = pos.astype(jnp.float32)[:, None] * inv[None, :]
    shape = (ang.shape[0],) + (1,) * (x.ndim - 3) + (half,)
    cos = jnp.cos(ang).reshape(shape)
    sin = jnp.sin(ang).reshape(shape)
    xf = x.astype(jnp.float32)
    x1, x2 = xf[..., :half], xf[..., half:]
    return jnp.concatenate([x1 * cos - x2 * sin, x2 * cos + x1 * sin], axis=-1).astype(x.dtype)


def swiglu(h, w_in, w_out):
    g, u = jnp.split(h @ w_in, 2, axis=-1)
    return (jax.nn.silu(g) * u) @ w_out


def mlstm_chunk(carry, inp):
    C, n, m = carry
    q, k, v, ig, lf = inp
    L = q.shape[1]
    b = jnp.cumsum(lf, axis=1)
    causal = jnp.tril(jnp.ones((L, L), dtype=bool))
    logD = b[:, :, None, :] - b[:, None, :, :] + ig[:, None, :, :]
    logD = jnp.where(causal[None, :, :, None], logD, -jnp.inf)
    g = b + m[:, None, :]
    m_t = jnp.maximum(g, jnp.max(logD, axis=2))
    Dm = jnp.exp(logD - m_t[:, :, None, :])
    inter = jnp.exp(g - m_t)
    qk = jnp.einsum('bthd,bshd->btsh', q, k) * Dm
    num = jnp.einsum('btsh,bshv->bthv', qk, v) + inter[..., None] * jnp.einsum('bhvd,bthd->bthv', C, q)
    den = jnp.sum(qk, axis=2) + inter * jnp.einsum('bhd,bthd->bth', n, q)
    h = num / jnp.maximum(jnp.abs(den), jnp.exp(-m_t))[..., None]
    m_new = m_t[:, -1]
    carry_w = jnp.exp(b[:, -1] + m - m_new)
    w_s = jnp.exp(b[:, -1:, :] - b + ig - m_new[:, None, :])
    C_new = carry_w[..., None, None] * C + jnp.einsum('bsh,bshv,bshd->bhvd', w_s, v, k)
    n_new = carry_w[..., None] * n + jnp.einsum('bsh,bshd->bhd', w_s, k)
    return (C_new, n_new, m_new), h


def mlstm_branch(zm, i_bias, f_bias, head_g, C0, n0, m0):
    B, T, _ = zm.shape
    q, k, v, o, ig, fg = _split(zm, ML_SIZES)
    q = q.reshape(B, T, ML_HEADS, ML_DQK).astype(jnp.float32)
    k = k.reshape(B, T, ML_HEADS, ML_DQK).astype(jnp.float32) * (ML_DQK ** -0.5)
    v = v.reshape(B, T, ML_HEADS, ML_DV).astype(jnp.float32)
    ig = softcap(ig.astype(jnp.float32) + i_bias)
    lf = jax.nn.log_sigmoid(softcap(fg.astype(jnp.float32) + f_bias))
    L = CHUNK if T % CHUNK == 0 else T
    nc = T // L
    to_blocks = lambda t: t.reshape((B, nc, L) + t.shape[2:]).swapaxes(0, 1)
    (C, n, m), h = lax.scan(mlstm_chunk, (C0, n0, m0), (to_blocks(q), to_blocks(k), to_blocks(v), to_blocks(ig), to_blocks(lf)))
    h = h.swapaxes(0, 1).reshape(B, T, ML_HEADS, ML_DV)
    h = rms_norm(h, head_g.reshape(ML_HEADS, ML_DV)).reshape(B, T, ML_HEADS * ML_DV)
    out = jax.nn.sigmoid(o.astype(jnp.float32)) * h
    return out.astype(zm.dtype), C, n, m


def block_chunk_attention(q_nope, q_rope, k_nope, k_rope, v, q_pos, k_pos):
    B, T, H, _ = q_nope.shape
    nb = T // Q_BLOCK if (T > Q_BLOCK and T % Q_BLOCK == 0) else 1
    bq = T // nb
    scale = (MLA_NOPE + MLA_ROPE) ** -0.5
    k_chunk = k_pos // CHUNK

    def one_block(blk):
        qn, qr, qp = blk
        s = (jnp.einsum('bqhd,bkhd->bhqk', qn, k_nope) + jnp.einsum('bqhd,bkd->bhqk', qr, k_rope)).astype(jnp.float32) * scale
        visible = k_chunk[None, :] <= (qp // CHUNK)[:, None]
        s = jnp.where(visible[None, None], s, -jnp.inf)
        pr = jax.nn.softmax(s, axis=-1).astype(v.dtype)
        return jnp.einsum('bhqk,bkhd->bqhd', pr, v)

    blocks = (q_nope.reshape(B, nb, bq, H, MLA_NOPE).swapaxes(0, 1),
              q_rope.reshape(B, nb, bq, H, MLA_ROPE).swapaxes(0, 1),
              q_pos.reshape(nb, bq))
    out = lax.map(one_block, blocks)
    return out.swapaxes(0, 1).reshape(B, T, H * MLA_V)


def mla_branch(za, pos, lat_past, krope_past, kv_norm_g, w_kv_b):
    B, T, _ = za.shape
    q, lat, kr = _split(za, MLA_SIZES)
    q = q.reshape(B, T, MLA_HEADS, MLA_NOPE + MLA_ROPE)
    q_nope, q_rope = q[..., :MLA_NOPE], rope(q[..., MLA_NOPE:], pos)
    lat = rms_norm(lat, kv_norm_g)
    kr = rope(kr, pos)
    lat_all = jnp.concatenate([lat_past.astype(lat.dtype), lat], axis=1)
    kr_all = jnp.concatenate([krope_past.astype(kr.dtype), kr], axis=1)
    Sk = lat_all.shape[1]
    kv = (lat_all @ w_kv_b).reshape(B, Sk, MLA_HEADS, MLA_NOPE + MLA_V)
    k_nope, v = kv[..., :MLA_NOPE], kv[..., MLA_NOPE:]
    out = block_chunk_attention(q_nope, q_rope, k_nope, kr_all, v, pos, jnp.arange(Sk))
    return out, lat, kr


def rwkv_step(S, inp):
    r, w, k, v, a, b = inp
    sa = jnp.einsum('bhvk,bhk->bhv', S, a)
    S = S * w[:, :, None, :] + sa[..., :, None] * b[..., None, :] + v[..., :, None] * k[..., None, :]
    y = jnp.einsum('bhvk,bhk->bhv', S, r)
    return S, y


def rwkv_branch(zr, shift0, S0, mu, w0, w2, a0, a2, g2, k_k, k_a, r_k, lnx_g, lnx_b):
    B, T, _ = zr.shape
    zf = zr.astype(jnp.float32)
    prev = jnp.concatenate([shift0[:, None, :].astype(jnp.float32), zf[:, :-1]], axis=1)
    xs = zf + (prev - zf) * mu
    r, k, v, wd, ad, gd = _split(xs, RW_SIZES)
    w_raw = -jax.nn.softplus(-(w0 + jnp.tanh(wd) @ w2)) - 0.5
    decay = jnp.exp(-jnp.exp(w_raw))
    a = jax.nn.sigmoid(a0 + ad @ a2)
    g = jax.nn.sigmoid(gd) @ g2
    kk = (k * k_k).reshape(B, T, RW_HEADS, RW_HEAD)
    kk = kk / jnp.maximum(jnp.sqrt(jnp.sum(kk * kk, axis=-1, keepdims=True)), 1e-12)
    k = k * (1.0 + (a - 1.0) * k_a)
    hs = lambda t: t.reshape(B, T, RW_HEADS, RW_HEAD)
    r_h, k_h, v_h, a_h = hs(r), hs(k), hs(v), hs(a)
    tm = lambda t: t.swapaxes(0, 1)
    S, y = lax.scan(rwkv_step, S0, (tm(r_h), tm(hs(decay)), tm(k_h), tm(v_h), tm(-kk), tm(kk * a_h)))
    y = y.swapaxes(0, 1)
    mean = jnp.mean(y, axis=-1, keepdims=True)
    var = jnp.mean(jnp.square(y - mean), axis=-1, keepdims=True)
    y = ((y - mean) * lax.rsqrt(var + RW_LN_EPS)).reshape(B, T, RW_WIDTH) * lnx_g + lnx_b
    y = y + (jnp.sum(r_h * k_h * r_k, axis=-1, keepdims=True) * v_h).reshape(B, T, RW_WIDTH)
    return (y * g).astype(zr.dtype), zf[:, -1], S


def layer(x, c, l, p, lat_past, krope_past, C0, n0, m0, S0, shift0):
    B, T, _ = x.shape
    mod = jax.nn.silu(c) @ p['ada_w'][l] + p['ada_b'][l]
    sh1, sc1, g1, sh2, sc2, g2, sh3, sc3, g3 = jnp.split(mod[:, None, :], N_ADA, axis=-1)
    h = modulate(rms_norm(x, p['norm_g'][l, 0]), sh1, sc1)
    x = x + 0.5 * g1 * swiglu(h, p['ffn_w_in'][l, 0], p['ffn_w_out'][l, 0])
    h = modulate(rms_norm(x, p['norm_g'][l, 1]), sh2, sc2)
    pos = lat_past.shape[1] + jnp.arange(T)
    z = h @ p['w_in'][l]
    zm, za, zr, zg = _split(z, (ML_COLS, MLA_COLS, RW_COLS, GATE_COLS))
    om, C, n, m = mlstm_branch(zm, p['mlstm_i_bias'][l], p['mlstm_f_bias'][l], p['mlstm_head_g'][l], C0, n0, m0)
    oa, lat, kr = mla_branch(za, pos, lat_past, krope_past, p['mla_kv_norm_g'][l], p['mla_w_kv_b'][l])
    orw, shift, S = rwkv_branch(zr, shift0, S0, p['rwkv_mu'][l], p['rwkv_w0'][l], p['rwkv_w2'][l], p['rwkv_a0'][l],
                                p['rwkv_a2'][l], p['rwkv_g2'][l], p['rwkv_k_k'][l], p['rwkv_k_a'][l], p['rwkv_r_k'][l],
                                p['rwkv_lnx_g'][l], p['rwkv_lnx_b'][l])
    o = jnp.stack([om, oa.astype(om.dtype), orw.astype(om.dtype)], axis=2)
    y_b = jnp.einsum('btnw,nwd->btnd', o, p['w_branch'][l])
    gates = jax.nn.sigmoid(zg + p['b_merge'][l]).reshape(B, T, N_BRANCH, D_MODEL)
    mixed = jnp.sum(gates * y_b, axis=2) @ p['w_out'][l]
    x = x + g2 * mixed
    h = modulate(rms_norm(x, p['norm_g'][l, 2]), sh3, sc3)
    x = x + 0.5 * g3 * swiglu(h, p['ffn_w_in'][l, 1], p['ffn_w_out'][l, 1])
    return x, (lat, kr, C, n, m, S, shift)


def trunk(x, c, p, lat_cache, kr_cache, C_st, n_st, m_st, S_st, sh_st):
    new = []
    for l in range(DEPTH):
        x, st = layer(x, c, l, p, lat_cache[l], kr_cache[l], C_st[l].astype(jnp.float32), n_st[l].astype(jnp.float32),
                      m_st[l].astype(jnp.float32), S_st[l].astype(jnp.float32), sh_st[l])
        new.append(st)
    y = rms_norm(x, p['final_norm_g'])
    stacked = tuple(jnp.stack(s, axis=0) for s in zip(*new))
    return y, stacked


def setup_inputs(seed: int = 0) -> dict:
    key = jax.random.key(seed)
    ks = iter(jax.random.split(key, 48))
    nrm = lambda shape, s: jax.random.normal(next(ks), shape, jnp.float32) * s
    D = D_MODEL
    return {
        'x_prompt': nrm((BATCH, SEQ, D), 1.0),
        'x_sample': nrm((DEC_BATCH, DEC_SEQ, D), 1.0),
        'c_prompt': nrm((BATCH, D), 1.0),
        'c_sample': nrm((DEC_BATCH, D), 1.0),
        'cache_mla_latent': nrm((DEPTH, DEC_BATCH, PAST_LEN, MLA_LATENT), 1.0),
        'cache_mla_krope': nrm((DEPTH, DEC_BATCH, PAST_LEN, MLA_ROPE), 1.0),
        'state_mlstm_C': nrm((DEPTH, DEC_BATCH, ML_HEADS, ML_DV, ML_DQK), 0.5),
        'state_mlstm_n': nrm((DEPTH, DEC_BATCH, ML_HEADS, ML_DQK), 0.5),
        'state_mlstm_m': nrm((DEPTH, DEC_BATCH, ML_HEADS), 1.0),
        'state_rwkv_S': nrm((DEPTH, DEC_BATCH, RW_HEADS, RW_HEAD, RW_HEAD), 0.5),
        'state_rwkv_shift': nrm((DEPTH, DEC_BATCH, RW_COLS), 1.0),
        'ada_w': nrm((DEPTH, D, N_ADA * D), 0.5 * D ** -0.5),
        'ada_b': nrm((DEPTH, N_ADA * D), 0.02),
        'norm_g': 1.0 + nrm((DEPTH, 3, D), 0.02),
        'ffn_w_in': nrm((DEPTH, 2, D, 2 * D_FF), D ** -0.5),
        'ffn_w_out': nrm((DEPTH, 2, D_FF, D), D_FF ** -0.5),
        'w_in': nrm((DEPTH, D, IN_COLS), D ** -0.5),
        'mlstm_i_bias': nrm((DEPTH, ML_HEADS), 0.1),
        'mlstm_f_bias': 3.0 + nrm((DEPTH, ML_HEADS), 0.5),
        'mlstm_head_g': 1.0 + nrm((DEPTH, ML_HEADS * ML_DV), 0.02),
        'mla_kv_norm_g': 1.0 + nrm((DEPTH, MLA_LATENT), 0.02),
        'mla_w_kv_b': nrm((DEPTH, MLA_LATENT, MLA_HEADS * (MLA_NOPE + MLA_V)), MLA_LATENT ** -0.5),
        'rwkv_mu': jax.random.uniform(next(ks), (DEPTH, RW_COLS), jnp.float32),
        'rwkv_w0': jax.random.uniform(next(ks), (DEPTH, RW_WIDTH), jnp.float32, -5.0, -0.5),
        'rwkv_w2': nrm((DEPTH, RW_DECAY_LORA, RW_WIDTH), 0.1),
        'rwkv_a0': nrm((DEPTH, RW_WIDTH), 0.1),
        'rwkv_a2': nrm((DEPTH, RW_A_LORA, RW_WIDTH), 0.1),
        'rwkv_g2': nrm((DEPTH, RW_G_LORA, RW_WIDTH), RW_G_LORA ** -0.5),
        'rwkv_k_k': 0.85 + nrm((DEPTH, RW_WIDTH), 0.05),
        'rwkv_k_a': 1.0 + nrm((DEPTH, RW_WIDTH), 0.05),
        'rwkv_r_k': nrm((DEPTH, RW_HEADS, RW_HEAD), 0.1),
        'rwkv_lnx_g': 1.0 + nrm((DEPTH, RW_WIDTH), 0.02),
        'rwkv_lnx_b': nrm((DEPTH, RW_WIDTH), 0.02),
        'w_branch': nrm((DEPTH, N_BRANCH, BRANCH_WIDTH, D), BRANCH_WIDTH ** -0.5),
        'b_merge': nrm((DEPTH, GATE_COLS), 0.1),
        'w_out': nrm((DEPTH, D, D), D ** -0.5),
        'final_norm_g': 1.0 + nrm((D,), 0.02),
    }


def reference(x_prompt, x_sample, c_prompt, c_sample, cache_mla_latent, cache_mla_krope, state_mlstm_C, state_mlstm_n,
              state_mlstm_m, state_rwkv_S, state_rwkv_shift, ada_w, ada_b, norm_g, ffn_w_in, ffn_w_out, w_in,
              mlstm_i_bias, mlstm_f_bias, mlstm_head_g, mla_kv_norm_g, mla_w_kv_b, rwkv_mu, rwkv_w0, rwkv_w2, rwkv_a0,
              rwkv_a2, rwkv_g2, rwkv_k_k, rwkv_k_a, rwkv_r_k, rwkv_lnx_g, rwkv_lnx_b, w_branch, b_merge, w_out,
              final_norm_g):
    p = dict(ada_w=ada_w, ada_b=ada_b, norm_g=norm_g, ffn_w_in=ffn_w_in, ffn_w_out=ffn_w_out, w_in=w_in,
             mlstm_i_bias=mlstm_i_bias, mlstm_f_bias=mlstm_f_bias, mlstm_head_g=mlstm_head_g,
             mla_kv_norm_g=mla_kv_norm_g, mla_w_kv_b=mla_w_kv_b, rwkv_mu=rwkv_mu, rwkv_w0=rwkv_w0, rwkv_w2=rwkv_w2,
             rwkv_a0=rwkv_a0, rwkv_a2=rwkv_a2, rwkv_g2=rwkv_g2, rwkv_k_k=rwkv_k_k, rwkv_k_a=rwkv_k_a,
             rwkv_r_k=rwkv_r_k, rwkv_lnx_g=rwkv_lnx_g, rwkv_lnx_b=rwkv_lnx_b, w_branch=w_branch, b_merge=b_merge,
             w_out=w_out, final_norm_g=final_norm_g)
    B = x_prompt.shape[0]
    f32 = jnp.float32
    y_p, (p_lat, p_kr, p_C, p_n, p_m, p_S, p_sh) = trunk(
        x_prompt, c_prompt, p,
        jnp.zeros((DEPTH, B, 0, MLA_LATENT), x_prompt.dtype), jnp.zeros((DEPTH, B, 0, MLA_ROPE), x_prompt.dtype),
        jnp.zeros((DEPTH, B, ML_HEADS, ML_DV, ML_DQK), f32), jnp.zeros((DEPTH, B, ML_HEADS, ML_DQK), f32),
        jnp.zeros((DEPTH, B, ML_HEADS), f32), jnp.zeros((DEPTH, B, RW_HEADS, RW_HEAD, RW_HEAD), f32),
        jnp.zeros((DEPTH, B, RW_COLS), f32))
    y_s, (s_lat, s_kr, s_C, s_n, s_m, s_S, s_sh) = trunk(
        x_sample, c_sample, p, cache_mla_latent, cache_mla_krope, state_mlstm_C, state_mlstm_n, state_mlstm_m,
        state_rwkv_S, state_rwkv_shift)
    return (y_p, y_s, p_lat, p_kr, p_C, p_n, p_m, p_S, p_sh, s_lat, s_kr, s_C, s_n, s_m, s_S, s_sh)
```

```cpp
#include <hip/hip_runtime.h>
#include <stdint.h>
#include <stdio.h>

#define DI __device__ __forceinline__
#define LAS __attribute__((address_space(3)))
typedef LAS unsigned char* ldsp_t;
typedef unsigned short bf16_t;
typedef short bf16x8 __attribute__((ext_vector_type(8)));
typedef short s16x4 __attribute__((ext_vector_type(4)));
typedef float f32x4 __attribute__((ext_vector_type(4)));
typedef float f32x2 __attribute__((ext_vector_type(2)));
typedef float f32x16 __attribute__((ext_vector_type(16)));
typedef unsigned u32x4 __attribute__((ext_vector_type(4)));
typedef unsigned u32x2 __attribute__((ext_vector_type(2)));
typedef __bf16 bfv2 __attribute__((ext_vector_type(2)));

#ifndef RUN_UPTO
#define RUN_UPTO 100000
#endif

constexpr int D = 2048, DFF = 5632, NTOK_P = 8192, NTOK = 8320, MP = 8448, NLAYER = 2;
constexpr int ZLD = 14848, INCOLS = 14664;
constexpr int ZQM = 0, ZKM = 512, ZVM = 1024, ZOM = 2048, ZIG = 3072, ZFG = 3076;
constexpr int ZQA = 3080, ZLAT = 4616, ZKR = 5128;
constexpr int ZR = 5192, ZRK = 6216, ZRV = 7240, ZWD = 8264;
constexpr int ZG = 8520;
constexpr int SKEY = 2112, KEYS = 8192 + 8 * SKEY;
constexpr int MODLD = 18432;
constexpr int ML_ITEMS = 544, ML_CSZ = 288 * 128;

constexpr size_t O_YP = 0, O_YS = O_YP + 16777216, O_PLAT = O_YS + 262144, O_PKR = O_PLAT + 8388608, O_PC = O_PKR + 1048576, O_PN = O_PC + 524288,
                 O_PM = O_PN + 2048, O_PS = O_PM + 16, O_PSH = O_PS + 262144, O_SLAT = O_PSH + 13312, O_SKR = O_SLAT + 131072, O_SC = O_SKR + 16384,
                 O_SN = O_SC + 2097152, O_SM = O_SN + 8192, O_SS = O_SM + 64, O_SSH = O_SS + 1048576, O_END = O_SSH + 53248;

constexpr size_t al256(size_t x) { return (x + 255) & ~(size_t)255; }
constexpr size_t WS_BAR = 0;
constexpr size_t WS_MOD = WS_BAR + 16384;
constexpr size_t WS_ROPE = WS_MOD + al256((size_t)NLAYER * 10 * MODLD * 4);
constexpr size_t WS_WFI = WS_ROPE + (size_t)4096 * 32 * 8;
constexpr size_t SZ_WFI = (size_t)2 * DFF * D * 2;
constexpr size_t WS_WFO = WS_WFI + 4 * SZ_WFI;
constexpr size_t SZ_WFO = (size_t)D * DFF * 2;
constexpr size_t WS_WIN = WS_WFO + 4 * SZ_WFO;
constexpr size_t SZ_WIN = (size_t)ZLD * D * 2;
constexpr size_t WS_WKK = WS_WIN + 2 * SZ_WIN;
constexpr size_t SZ_WKK = (size_t)1024 * 512 * 2;
constexpr size_t WS_WKV = WS_WKK + 2 * SZ_WKK;
constexpr size_t WS_WLO = WS_WKV + 2 * SZ_WKK;
constexpr size_t SZ_WLO = (size_t)3072 * 256 * 2;
constexpr size_t WS_WBR = WS_WLO + 2 * SZ_WLO;
constexpr size_t SZ_WBR = (size_t)D * 1024 * 2;
constexpr size_t WS_WO = WS_WBR + 6 * SZ_WBR;
constexpr size_t SZ_WO = (size_t)D * D * 2;
constexpr size_t WS_X = WS_WO + 2 * SZ_WO;
constexpr size_t WS_H = WS_X + (size_t)MP * D * 4;
constexpr size_t WS_ACT = WS_H + (size_t)MP * D * 2;
constexpr size_t WS_Z = WS_ACT + (size_t)MP * DFF * 2;
constexpr size_t WS_QR = WS_Z + (size_t)MP * ZLD * 2;
constexpr size_t WS_LATA = WS_QR + (size_t)MP * 512 * 2;
constexpr size_t WS_KRA = WS_LATA + (size_t)KEYS * 512 * 2;
constexpr size_t WS_KN = WS_KRA + (size_t)KEYS * 64 * 2;
constexpr size_t WS_VT = WS_KN + (size_t)KEYS * 1024 * 2;
constexpr size_t WS_LIN = WS_VT + (size_t)KEYS * 1024 * 2;
constexpr size_t WS_LOUT = WS_LIN + (size_t)MP * 256 * 2;
constexpr size_t WS_OALL = WS_LOUT + (size_t)MP * 3072 * 4;
constexpr size_t WS_MIX = WS_OALL + (size_t)MP * 3072 * 2;
constexpr size_t WS_YB = WS_MIX + (size_t)MP * D * 2;
constexpr size_t WS_RK = WS_YB + (size_t)MP * 1024 * 4;
constexpr size_t WS_NUML = WS_RK + (size_t)MP * 16 * 4;
constexpr size_t WS_DENL = WS_NUML + (size_t)ML_ITEMS * 16 * 1024 * 4;
constexpr size_t WS_MLG = WS_DENL + (size_t)NTOK * 4 * 4;
constexpr size_t WS_DC = WS_MLG + (size_t)NTOK * 8 * 4;
constexpr size_t WS_MLI = WS_DC + (size_t)ML_ITEMS * ML_CSZ * 4;
constexpr size_t WS_END = WS_MLI + al256((size_t)ML_ITEMS * 4 * 4);

constexpr int LDS_MAIN = 131072, LDS_XB = LDS_MAIN + 2048, LDS_BYTES = LDS_MAIN + 2048 + 256;

struct Params { const float* in[37]; float* out; unsigned char* ws; };
enum { I_XP = 0, I_XS, I_CP, I_CS, I_CLAT, I_CKR, I_MLC, I_MLN, I_MLM, I_RWS, I_RWSH, I_ADAW, I_ADAB, I_NORMG, I_FWI, I_FWO, I_WIN, I_MLIB, I_MLFB, I_MLHG,
       I_KVG, I_WKVB, I_MU, I_W0, I_W2, I_A0, I_A2, I_G2, I_KK, I_KA, I_RK, I_LNG, I_LNB, I_WBR, I_BM, I_WOUT, I_FNG };

DI int vtid() { int t = threadIdx.x; asm volatile("" : "+v"(t)); return t; }
DI int sbid() { int b = blockIdx.x; asm volatile("" : "+s"(b)); return b; }
DI int opq(int x) { asm volatile("" : "+s"(x)); return x; }
#define INP(i) (P.in[opq(i)])
DI unsigned char* relaunder(const void* p) { unsigned lo = (unsigned)(size_t)p, hi = (unsigned)((size_t)p >> 32); asm volatile("" : "+v"(lo), "+v"(hi));
    lo = __builtin_amdgcn_readfirstlane(lo); hi = __builtin_amdgcn_readfirstlane(hi); return (unsigned char*)(((size_t)hi << 32) | lo); }
DI unsigned char* wsp(const Params& P) { return relaunder(P.ws); }
DI float* outp(const Params& P) { return (float*)relaunder(P.out); }
DI float bf2f(bf16_t b) { return __uint_as_float(((unsigned)b) << 16); }
DI unsigned pack2(float lo, float hi) { f32x2 v = {lo, hi}; return __builtin_bit_cast(unsigned, __builtin_convertvector(v, bfv2)); }
DI bf16_t f2bf(float f) { return (bf16_t)(pack2(f, 0.f) & 0xffffu); }
DI float lo16(unsigned w) { return __uint_as_float(w << 16); }
DI float hi16(unsigned w) { return __uint_as_float(w & 0xffff0000u); }
DI float wave_sum(float v) { for (int o = 32; o >= 1; o >>= 1) v += __shfl_xor(v, o); return v; }
DI float sigmoidf_(float x) { return 1.0f / (1.0f + __expf(-x)); }
DI float siluf_(float x) { return x / (1.0f + __expf(-x)); }
DI float softcap15(float x) { return 15.0f * tanhf(x * (1.0f / 15.0f)); }
DI float logsigmoidf_(float x) { return fminf(x, 0.f) - log1pf(__expf(-fabsf(x))); }
DI int row_stream(int row) { return row < NTOK_P ? (row >> 12) : 2 + ((row - NTOK_P) >> 4); }
template <int CTRL> DI float dppf(float v) { return __builtin_bit_cast(float, __builtin_amdgcn_update_dpp(0, __builtin_bit_cast(int, v), CTRL, 0xF, 0xF, true)); }
DI float row16_sum(float v) { v += dppf<0xB1>(v); v += dppf<0x4E>(v); v += dppf<0x141>(v); v += dppf<0x140>(v); return v; }
DI int crow(int i, int hh) { return (i & 3) + 8 * (i >> 2) + 4 * hh; }
#define MFMA32(a, b, c) __builtin_amdgcn_mfma_f32_32x32x16_bf16((a), (b), (c), 0, 0, 0)


namespace pg8 {
#define PG8_LAS __attribute__((address_space(3)))
typedef unsigned short bf16_t;
typedef short bf16x8 __attribute__((ext_vector_type(8)));
typedef float f32x4 __attribute__((ext_vector_type(4)));
typedef unsigned u32x4 __attribute__((ext_vector_type(4)));
constexpr int BM = 256, BK = 64, HALF = 128, HTB = HALF * BK * 2  , STAGE_BYTES = 8 * HTB, NXCD = 8, WGM = 8;

__host__ __device__ __forceinline__ int lds_byte(int r, int c) { const int st = (r >> 4) * 2 + (c >> 5), rr = r & 15, cc = c & 31, ob = rr * 64 + cc * 2; return st * 1024 + (ob ^ (((ob >> 9) & 1) << 5)); }
__host__ __device__ __forceinline__ void stage_rc(int b, int& R, int& C) { const int st = b / 1024, sb = b % 1024, swz = sb ^ (((sb >> 9) & 1) << 5); R = (st >> 1) * 16 + swz / 64; C = (st & 1) * 32 + (swz % 64) / 2; }
__host__ __device__ __forceinline__ int perm32(int rho) { const int n = rho >> 4, i = rho & 15; return 8 * (i >> 2) + 4 * n + (i & 3); }

struct Unit { int pm, pn; };
struct Gemm { const bf16_t* A; const bf16_t* Bt; int M, N, K; };

struct StaticOrder {
    int nM, nN, nwg, G, c;
    __host__ __device__ void init(int M, int N, int G_, int c_) { nM = M / BM; nN = N / BM; nwg = nM * nN; G = G_; c = c_; }
    __host__ __device__ bool next(int i, Unit& u) const {
        const long L = (long)i * G + c; if (L >= nwg) return false;
        int wgid = (int)L; { const int q = nwg / NXCD, r = nwg % NXCD, xcd = wgid % NXCD, off = wgid / NXCD; wgid = (xcd < r ? xcd * (q + 1) : r * (q + 1) + (xcd - r) * q) + off; }
        const int nig = WGM * nN, gid = wgid / nig, fm = gid * WGM, gsz = (nM - fm) < WGM ? (nM - fm) : WGM;
        u.pm = fm + ((wgid % nig) % gsz); u.pn = (wgid % nig) / gsz; return true;
    }
    __device__ __forceinline__ void a_ready(const Unit&) const {}
    __device__ __forceinline__ void done(const Unit&) const {}
};
__device__ __forceinline__ unsigned cvt_pk_bf16(float lo, float hi) { unsigned r; asm volatile("v_cvt_pk_bf16_f32 %0, %1, %2" : "=v"(r) : "v"(lo), "v"(hi)); return r; }
typedef float f32x2 __attribute__((ext_vector_type(2)));
__device__ __forceinline__ f32x2 gelu_pk(f32x2 v) {
    const f32x2 av = __builtin_elementwise_abs(v), d = av * 0.2316418882f + 1.0f;
    f32x2 t; t.x = __builtin_amdgcn_rcpf(d.x); t.y = __builtin_amdgcn_rcpf(d.y);
    f32x2 q = t * 0.5307027145f + (-0.7265760135f); q = q * t + 0.7107068705f; q = q * t + (-0.142248368f); q = q * t + 0.127414796f; q = q * t;
    const f32x2 s = (v * v) * (-0.72134752044f);
    f32x2 e; e.x = __builtin_amdgcn_exp2f(s.x); e.y = __builtin_amdgcn_exp2f(s.y);
    const f32x2 m = v * (q * e), r = v - m;
    f32x2 o; o.x = v.x < 0.f ? m.x : r.x; o.y = v.y < 0.f ? m.y : r.y; return o;
}

struct EpiF32 {
    static constexpr bool PERM = false, AFTER_DRAIN = false;
    float* C; int ldc; const float* bias;
    __device__ __forceinline__ void operator()(const f32x4 (&acc)[2][2][4][2], const Unit& u, int wr, int wc, int fr, int fq) const {
        const int row0 = u.pm * BM + wr * 64 + fr, col0 = u.pn * BM + wc * 32 + 4 * fq;
        f32x4 bv[2][2];
#pragma unroll
        for (int bj = 0; bj < 2; ++bj)
#pragma unroll
            for (int n = 0; n < 2; ++n) bv[bj][n] = bias ? *(const f32x4*)(bias + col0 + bj * HALF + n * 16) : (f32x4){0.f, 0.f, 0.f, 0.f};
#pragma unroll
        for (int ai = 0; ai < 2; ++ai)
#pragma unroll
            for (int m = 0; m < 4; ++m) { float* rowp = C + (size_t)(row0 + ai * HALF + m * 16) * ldc + col0;
#pragma unroll
                for (int bj = 0; bj < 2; ++bj)
#pragma unroll
                    for (int n = 0; n < 2; ++n) *(f32x4*)(rowp + bj * HALF + n * 16) = acc[ai][bj][m][n] + bv[bj][n]; }
    }
};
template <int ACT  > struct EpiBf16 {
    static constexpr bool PERM = true, AFTER_DRAIN = false;
    bf16_t* O; int ldc; const float* bias; int split_cols; size_t split_stride;
    __device__ __forceinline__ void operator()(const f32x4 (&acc)[2][2][4][2], const Unit& u, int wr, int wc, int fr, int fq) const {
        const int row0 = u.pm * BM + wr * 64 + fr; int colt = u.pn * BM; bf16_t* base = O;
        if (split_cols) { const int t = colt / split_cols; base += (size_t)t * split_stride; colt -= t * split_cols; }
        const int col0 = colt + wc * 32 + 8 * fq, bcol0 = u.pn * BM + wc * 32 + 8 * fq;
        f32x4 bv[2][2];
#pragma unroll
        for (int bj = 0; bj < 2; ++bj)
#pragma unroll
            for (int n = 0; n < 2; ++n) bv[bj][n] = bias ? *(const f32x4*)(bias + bcol0 + bj * HALF + 4 * n) : (f32x4){0.f, 0.f, 0.f, 0.f};
#pragma unroll
        for (int ai = 0; ai < 2; ++ai)
#pragma unroll
            for (int m = 0; m < 4; ++m) { bf16_t* rowp = base + (size_t)(row0 + ai * HALF + m * 16) * ldc + col0;
#pragma unroll
                for (int bj = 0; bj < 2; ++bj) { f32x4 v0 = acc[ai][bj][m][0] + bv[bj][0], v1 = acc[ai][bj][m][1] + bv[bj][1];
                    if (ACT == 1) { f32x2 a = gelu_pk((f32x2){v0[0], v0[1]}), b = gelu_pk((f32x2){v0[2], v0[3]}), c = gelu_pk((f32x2){v1[0], v1[1]}), d = gelu_pk((f32x2){v1[2], v1[3]});
                        v0 = (f32x4){a.x, a.y, b.x, b.y}; v1 = (f32x4){c.x, c.y, d.x, d.y}; }
                    if (ACT == 2) {
#pragma unroll
                        for (int j = 0; j < 4; ++j) { v0[j] = 0.5f * v0[j] * (1.0f + erff(v0[j] * 0.70710678f)); v1[j] = 0.5f * v1[j] * (1.0f + erff(v1[j] * 0.70710678f)); } }
                    u32x4 w; w.x = cvt_pk_bf16(v0[0], v0[1]); w.y = cvt_pk_bf16(v0[2], v0[3]); w.z = cvt_pk_bf16(v1[0], v1[1]); w.w = cvt_pk_bf16(v1[2], v1[3]);
                    *(u32x4*)(rowp + bj * HALF) = w; } }
    }
};

template <class Epi, class Sched, bool STAMP = false>
__device__ __forceinline__ void gemm_phase(PG8_LAS unsigned char* lds, const Gemm g, const Sched& S, const Epi& E, unsigned long long* stamps) {
    const int tid = vtid(), wid = __builtin_amdgcn_readfirstlane(tid >> 6), lane = tid & 63, wr = wid >> 2, wc = wid & 3, fr = lane & 15, fq = lane >> 4;
    const int K = g.K, nt = K / BK;
    int ts_lo = 0, ts_hi = 0, nts = 0; const unsigned long long rt_entry = STAMP ? (unsigned long long)wall_clock64() : 0ull;
#define PG8_STAMP() do { if (STAMP && wid == 0 && nts < 64) { const unsigned long long _c = (unsigned long long)clock64(); \
        ts_lo = (lane == nts) ? (int)(unsigned)_c : ts_lo; ts_hi = (lane == nts) ? (int)(unsigned)(_c >> 32) : ts_hi; ++nts; } } while (0)
    PG8_STAMP();
    unsigned voffA[2], voffB[2];
#pragma unroll
    for (int i = 0; i < 2; ++i) { int R, C; stage_rc(tid * 16 + i * 8192, R, C); const int Rb = Epi::PERM ? ((R & ~31) + perm32(R & 31)) : R;
        voffA[i] = (unsigned)(R * K + C) * 2u; voffB[i] = (unsigned)(Rb * K + C) * 2u; }
    const size_t kstep = (size_t)(BK * 2);
    const size_t hstep = (size_t)HALF * K * 2;
    const size_t tstep = 2 * hstep;
    const unsigned ldsw = (unsigned)wid * 1024u;
    const int aoff = lds_byte(wr * 64 + fr, fq * 8), boff = lds_byte(wc * 32 + fr, fq * 8);
#define PG8_SA(b, h) (((b) * 2 + (h)) * HTB)
#define PG8_SB(b, h) ((4 + (b) * 2 + (h)) * HTB)
#define PG8_STAGE(bufoff, gbase, voff) do { _Pragma("unroll") for (int _i = 0; _i < 2; ++_i) \
        __builtin_amdgcn_global_load_lds((const unsigned*)((const char*)(gbase) + (voff)[_i]), (PG8_LAS unsigned*)(lds + (bufoff) + ldsw + _i * 8192), 16, 0, 0); } while (0)
#define PG8_LDA(dst, b, h) do { _Pragma("unroll") for (int m = 0; m < 4; ++m) _Pragma("unroll") for (int k = 0; k < 2; ++k) dst[m][k] = *(const PG8_LAS bf16x8*)(lds + PG8_SA(b, h) + aoff + m * 2048 + k * 1024); } while (0)
#define PG8_LDB(dst, b, h) do { _Pragma("unroll") for (int n = 0; n < 2; ++n) _Pragma("unroll") for (int k = 0; k < 2; ++k) dst[n][k] = *(const PG8_LAS bf16x8*)(lds + PG8_SB(b, h) + boff + n * 2048 + k * 1024); } while (0)
#define PG8_MMA(ai, bj, At, Bt) do { __builtin_amdgcn_s_setprio(1); _Pragma("unroll") for (int m = 0; m < 4; ++m) _Pragma("unroll") for (int n = 0; n < 2; ++n) _Pragma("unroll") for (int k = 0; k < 2; ++k) \
        acc[ai][bj][m][n] = __builtin_amdgcn_mfma_f32_16x16x32_bf16(Bt[n][k], At[m][k], acc[ai][bj][m][n], 0, 0, 0); __builtin_amdgcn_s_setprio(0); } while (0)
#define PG8_WAIT_V(n) asm volatile("s_waitcnt vmcnt(" #n ")" ::: "memory")
#define PG8_WAIT_L(n) asm volatile("s_waitcnt lgkmcnt(" #n ")" ::: "memory")
#define PG8_BAR __builtin_amdgcn_s_barrier()
#define PG8_SCHED __builtin_amdgcn_sched_barrier(0)
    Unit cur, nxt; int ui = 0;
    if (!S.next(0, cur)) return;
    f32x4 acc[2][2][4][2];
#pragma unroll
    for (int a = 0; a < 2; ++a)
#pragma unroll
        for (int b = 0; b < 2; ++b)
#pragma unroll
            for (int m = 0; m < 4; ++m)
#pragma unroll
                for (int n = 0; n < 2; ++n) acc[a][b][m][n] = (f32x4){0.f, 0.f, 0.f, 0.f};
    bf16x8 At[4][2], B0[2][2], B1[2][2];
    const char* cA = (const char*)g.A + (size_t)cur.pm * tstep; const char* cB = (const char*)g.Bt + (size_t)cur.pn * tstep;
    S.a_ready(cur);
    PG8_STAGE(PG8_SB(0, 0), cB, voffB); PG8_STAGE(PG8_SA(0, 0), cA, voffA); PG8_STAGE(PG8_SB(0, 1), cB + hstep, voffB); PG8_STAGE(PG8_SA(0, 1), cA + hstep, voffA);
    if (wr == 1) PG8_BAR;
    PG8_WAIT_V(4); PG8_BAR;
    PG8_STAGE(PG8_SB(1, 0), cB + kstep, voffB); PG8_STAGE(PG8_SA(1, 0), cA + kstep, voffA); PG8_STAGE(PG8_SB(1, 1), cB + hstep + kstep, voffB);
    PG8_WAIT_V(6); PG8_BAR;
    PG8_STAMP();
    for (;;) {
        const bool has_next = S.next(ui + 1, nxt);
        const char* nA = has_next ? (const char*)g.A + (size_t)nxt.pm * tstep : cA; const char* nB = has_next ? (const char*)g.Bt + (size_t)nxt.pn * tstep : cB;
        for (int t = 0; t < nt; t += 2) {
            const bool last = (t == nt - 2);
            const char* a1 = cA + (size_t)(t + 1) * kstep;
            const char* a2 = last ? nA : cA + (size_t)(t + 2) * kstep; const char* b2 = last ? nB : cB + (size_t)(t + 2) * kstep;
            const char* a3 = a2 + kstep; const char* b3 = b2 + kstep;
            if (last && has_next) S.a_ready(nxt);
            PG8_LDB(B0, 0, 0); PG8_SCHED; PG8_LDA(At, 0, 0); PG8_STAGE(PG8_SA(1, 1), a1 + hstep, voffA);
            PG8_WAIT_L(8); PG8_BAR; PG8_WAIT_L(0); PG8_MMA(0, 0, At, B0); PG8_BAR; PG8_SCHED;
            PG8_LDB(B1, 0, 1); PG8_STAGE(PG8_SB(0, 0), b2, voffB);
            PG8_BAR; PG8_WAIT_L(0); PG8_MMA(0, 1, At, B1); PG8_BAR;
            PG8_LDA(At, 0, 1); PG8_STAGE(PG8_SA(0, 0), a2, voffA);
            PG8_BAR; PG8_WAIT_L(0); PG8_MMA(1, 0, At, B0); PG8_BAR; PG8_SCHED;
            PG8_STAGE(PG8_SB(0, 1), b2 + hstep, voffB);
            PG8_WAIT_V(6); PG8_BAR; PG8_MMA(1, 1, At, B1); PG8_BAR;
            PG8_LDB(B0, 1, 0); PG8_SCHED; PG8_LDA(At, 1, 0); PG8_STAGE(PG8_SA(0, 1), a2 + hstep, voffA);
            PG8_WAIT_L(8); PG8_BAR; PG8_WAIT_L(0); PG8_MMA(0, 0, At, B0); PG8_BAR; PG8_SCHED;
            PG8_LDB(B1, 1, 1); PG8_STAGE(PG8_SB(1, 0), b3, voffB);
            PG8_BAR; PG8_WAIT_L(0); PG8_MMA(0, 1, At, B1); PG8_BAR;
            PG8_LDA(At, 1, 1); PG8_STAGE(PG8_SA(1, 0), a3, voffA);
            PG8_BAR; PG8_WAIT_L(0); PG8_MMA(1, 0, At, B0); PG8_BAR; PG8_SCHED;
            PG8_STAGE(PG8_SB(1, 1), b3 + hstep, voffB);
            PG8_WAIT_V(6); PG8_BAR; PG8_MMA(1, 1, At, B1); PG8_BAR;
        }
        PG8_STAMP();
        if constexpr (!Epi::AFTER_DRAIN) { E(acc, cur, wr, wc, fr, fq); S.done(cur); }
        PG8_STAMP();
        if (!has_next) break;
#pragma unroll
        for (int a = 0; a < 2; ++a)
#pragma unroll
            for (int b = 0; b < 2; ++b)
#pragma unroll
                for (int m = 0; m < 4; ++m)
#pragma unroll
                    for (int n = 0; n < 2; ++n) acc[a][b][m][n] = (f32x4){0.f, 0.f, 0.f, 0.f};
        cur = nxt; cA = nA; cB = nB; ++ui;
    }
    PG8_WAIT_V(0);
    if (wr == 0) PG8_BAR;
    PG8_BAR;
    if constexpr (Epi::AFTER_DRAIN) { E.fused(acc, cur, wr, wc, fr, fq, lds, wid, lane); S.done(cur); }
    PG8_STAMP();
    if (STAMP && wid == 0) { stamps[lane] = lane < nts ? (((unsigned long long)(unsigned)ts_hi << 32) | (unsigned)ts_lo) : 0ull;
        if (lane == 62) stamps[62] = rt_entry; if (lane == 63) stamps[63] = (unsigned long long)wall_clock64(); }
#undef PG8_STAMP
#undef PG8_SA
#undef PG8_SB
#undef PG8_STAGE
#undef PG8_LDA
#undef PG8_LDB
#undef PG8_MMA
#undef PG8_WAIT_V
#undef PG8_WAIT_L
#undef PG8_BAR
#undef PG8_SCHED
}
}

#define XB_TMO      128
#define XB_XCNT(j)  (256  + 64 * (j))
#define XB_XSUB(j)  (1280 + 64 * (j))
#define XB_XGEN(j)  (2304 + 64 * (j))
#define XB_TOP      3328
#define XB_TOPGEN   3392
#define XCD_BAR_WORDS 3456
#define XB_SPIN_CAP (1u << 18)

__device__ __forceinline__ unsigned xb_ld(unsigned* p)              { return __hip_atomic_load(p, __ATOMIC_RELAXED, __HIP_MEMORY_SCOPE_AGENT); }
__device__ __forceinline__ unsigned xb_add(unsigned* p, unsigned v) { return __hip_atomic_fetch_add(p, v, __ATOMIC_RELAXED, __HIP_MEMORY_SCOPE_AGENT); }
__device__ __forceinline__ unsigned xb_xcc_id() { return (unsigned)__builtin_amdgcn_s_getreg((3 << 11) | 20) & 0xFu; }
#define XB_SPIN(cond, bar) do { unsigned _sp = 0; while (cond) { __builtin_amdgcn_s_sleep(1); \
    if ((++_sp & 255u) == 0u) { if (xb_ld(&(bar)[XB_TMO])) break; if (_sp > XB_SPIN_CAP) { atomicAdd(&(bar)[XB_TMO], 1u); break; } } } } while (0)

struct XcdBarrier {
    unsigned* bar; unsigned x;
    volatile LAS unsigned* st;
};

__device__ __forceinline__ XcdBarrier xcd_barrier_post(unsigned* bar, volatile LAS unsigned* st) {
    XcdBarrier b; b.bar = bar; b.x = xb_xcc_id(); b.st = st;
    if (threadIdx.x == 0) (void)xb_add(&bar[XB_XCNT(b.x)], 1u);
    return b;
}
__device__ __forceinline__ void xcd_barrier_complete(unsigned* bar, unsigned x, unsigned& nloc, unsigned& nx) {
    const unsigned G = gridDim.x * gridDim.y * gridDim.z;
    unsigned sum, cnt, mine, sp = 0u;
    for (;;) {
        sum = 0u; cnt = 0u; mine = 0u;
#pragma unroll
        for (unsigned j = 0; j < 16; ++j) { const unsigned c = xb_ld(&bar[XB_XCNT(j)]); sum += c; cnt += (c > 0u) ? 1u : 0u; mine = (j == x) ? c : mine; }
        if (sum == G) break;
        __builtin_amdgcn_s_sleep(1);
        if ((++sp & 255u) == 0u) { if (xb_ld(&bar[XB_TMO])) break; if (sp > XB_SPIN_CAP) { atomicAdd(&bar[XB_TMO], 1u); break; } }
    }
    nloc = mine > 0u ? mine : 1u; nx = cnt > 0u ? cnt : 1u;
}

__device__ __forceinline__ void xcd_barrier(const XcdBarrier& b) {
    asm volatile("s_waitcnt vmcnt(0)" ::: "memory");
    __syncthreads();
    if (threadIdx.x == 0) {
        unsigned* bar = b.bar;
        __builtin_amdgcn_s_waitcnt(0);
        unsigned nloc = b.st[0], nx = b.st[1];
        if (nloc == 0u) { xcd_barrier_complete(bar, b.x, nloc, nx); b.st[0] = nloc; b.st[1] = nx; }
        const unsigned old = xb_add(&bar[XB_XSUB(b.x)], 1u);
        const unsigned gen = old / nloc;
        if (old + 1u == (gen + 1u) * nloc) {
            __builtin_amdgcn_fence(__ATOMIC_RELEASE, "agent");
            asm volatile("s_waitcnt vmcnt(0)" ::: "memory");
            const unsigned og = xb_add(&bar[XB_TOP], 1u);
            const unsigned tg = og / nx;
            if (og + 1u == (tg + 1u) * nx) xb_add(&bar[XB_TOPGEN], 1u);
            else XB_SPIN(xb_ld(&bar[XB_TOPGEN]) == tg, bar);
            __builtin_amdgcn_fence(__ATOMIC_ACQUIRE, "agent");
            xb_add(&bar[XB_XGEN(b.x)], 1u);
            asm volatile("s_waitcnt vmcnt(0)" ::: "memory");
        } else {
            XB_SPIN(xb_ld(&bar[XB_XGEN(b.x)]) == gen, bar);
            __builtin_amdgcn_fence(__ATOMIC_ACQUIRE, "agent");
            asm volatile("s_waitcnt vmcnt(0)" ::: "memory");
        }
    }
    __syncthreads();
}


struct EpiBf16Plain {
    static constexpr bool PERM = true, AFTER_DRAIN = false;
    bf16_t* O; int ldc;
    DI void operator()(const f32x4 (&acc)[2][2][4][2], const pg8::Unit& u, int wr, int wc, int fr, int fq) const {
        const int row0 = u.pm * 256 + wr * 64 + fr, col0 = u.pn * 256 + wc * 32 + 8 * fq;
#pragma unroll
        for (int ai = 0; ai < 2; ++ai)
#pragma unroll
            for (int m = 0; m < 4; ++m) { bf16_t* rowp = O + (size_t)(row0 + ai * 128 + m * 16) * ldc + col0;
#pragma unroll
                for (int bj = 0; bj < 2; ++bj) { const f32x4 v0 = acc[ai][bj][m][0], v1 = acc[ai][bj][m][1];
                    u32x4 w; w.x = pack2(v0[0], v0[1]); w.y = pack2(v0[2], v0[3]); w.z = pack2(v1[0], v1[1]); w.w = pack2(v1[2], v1[3]);
                    *(u32x4*)(rowp + bj * 128) = w; } }
    }
};
struct EpiSwiglu {
    static constexpr bool PERM = true, AFTER_DRAIN = false;
    bf16_t* O;
    DI void operator()(const f32x4 (&acc)[2][2][4][2], const pg8::Unit& u, int wr, int wc, int fr, int fq) const {
        const int row0 = u.pm * 256 + wr * 64 + fr, col0 = u.pn * 128 + wc * 32 + 8 * fq;
#pragma unroll
        for (int ai = 0; ai < 2; ++ai)
#pragma unroll
            for (int m = 0; m < 4; ++m) { bf16_t* rowp = O + (size_t)(row0 + ai * 128 + m * 16) * DFF + col0;
                const f32x4 g0 = acc[ai][0][m][0], g1 = acc[ai][0][m][1], u0 = acc[ai][1][m][0], u1 = acc[ai][1][m][1];
                float v[8];
#pragma unroll
                for (int j = 0; j < 4; ++j) { v[j] = siluf_(g0[j]) * u0[j]; v[4 + j] = siluf_(g1[j]) * u1[j]; }
                u32x4 w; w.x = pack2(v[0], v[1]); w.y = pack2(v[2], v[3]); w.z = pack2(v[4], v[5]); w.w = pack2(v[6], v[7]);
                *(u32x4*)rowp = w; }
    }
};
struct EpiResid {
    static constexpr bool PERM = false, AFTER_DRAIN = false;
    float* X; const float* gate; float scale;
    DI void operator()(const f32x4 (&acc)[2][2][4][2], const pg8::Unit& u, int wr, int wc, int fr, int fq) const {
        const int row0 = u.pm * 256 + wr * 64 + fr, col0 = u.pn * 256 + wc * 32 + 4 * fq;
#pragma unroll
        for (int ai = 0; ai < 2; ++ai)
#pragma unroll
            for (int m = 0; m < 4; ++m) { const int row = row0 + ai * 128 + m * 16;
                if (row < NTOK) { const float* gp = gate + (size_t)row_stream(row) * MODLD + col0; float* xp = X + (size_t)row * D + col0;
#pragma unroll
                    for (int bj = 0; bj < 2; ++bj)
#pragma unroll
                        for (int n = 0; n < 2; ++n) { const f32x4 gv = *(const f32x4*)(gp + bj * 128 + n * 16); f32x4 xv = *(const f32x4*)(xp + bj * 128 + n * 16);
                            xv += (gv * scale) * acc[ai][bj][m][n]; *(f32x4*)(xp + bj * 128 + n * 16) = xv; } } }
    }
};
struct EpiBranch {
    static constexpr bool PERM = false, AFTER_DRAIN = false;
    const bf16_t* Z; const float* bm; float* T; bf16_t* O; int n;
    DI void operator()(const f32x4 (&acc)[2][2][4][2], const pg8::Unit& u, int wr, int wc, int fr, int fq) const {
        const int row0 = u.pm * 256 + wr * 64 + fr, col0 = u.pn * 256 + wc * 32 + 4 * fq;
#pragma unroll
        for (int ai = 0; ai < 2; ++ai)
#pragma unroll
            for (int m = 0; m < 4; ++m) { const int row = row0 + ai * 128 + m * 16;
                if (row < NTOK) {
#pragma unroll
                    for (int bj = 0; bj < 2; ++bj)
#pragma unroll
                        for (int nn = 0; nn < 2; ++nn) { const int col = col0 + bj * 128 + nn * 16;
                            const u32x2 zw = *(const u32x2*)(Z + (size_t)row * ZLD + col); const f32x4 bv = *(const f32x4*)(bm + col);
                            f32x4 g; g[0] = sigmoidf_(lo16(zw.x) + bv[0]); g[1] = sigmoidf_(hi16(zw.x) + bv[1]); g[2] = sigmoidf_(lo16(zw.y) + bv[2]); g[3] = sigmoidf_(hi16(zw.y) + bv[3]);
                            f32x4 val = g * acc[ai][bj][m][nn]; float* tp = T + (size_t)row * D + col;
                            if (n == 0) *(f32x4*)tp = val;
                            else if (n == 1) { val += *(const f32x4*)tp; *(f32x4*)tp = val; }
                            else { val += *(const f32x4*)tp; u32x2 w; w.x = pack2(val[0], val[1]); w.y = pack2(val[2], val[3]); *(u32x2*)(O + (size_t)row * D + col) = w; } } } }
    }
};
template <class Epi> DI void run_gemm(ldsp_t lds, const bf16_t* A, const bf16_t* Bt, int M, int N, int K, const Epi& E) {
    pg8::Gemm g{A, Bt, M, N, K}; pg8::StaticOrder S; S.init(M, N, (int)gridDim.x, (int)sbid());
    pg8::gemm_phase<Epi, pg8::StaticOrder, false>((PG8_LAS unsigned char*)lds, g, S, E, nullptr);
}

DI void conv_tile(const float* __restrict src, int ldw, int K, bf16_t* __restrict dst, int valid_rows, int mode, int tr, int tk, LAS float* T) {
    const int tid = vtid(), lane = tid & 63, wave = tid >> 6;
    const int j = tr * 64 + lane; const bool valid = j < valid_rows;
    int sc;
    if (mode == 0) sc = j;
    else if (mode == 1) { const int pn = j >> 8, r = j & 255; sc = (r < 128) ? pn * 128 + r : DFF + pn * 128 + (r - 128); }
    else if (mode == 2) sc = (j >> 7) * 256 + (j & 127);
    else sc = (j >> 7) * 256 + 128 + (j & 127);
    const float* sp = src + (size_t)(tk * 256 + wave) * ldw + (valid ? sc : 0);
    float v[32];
#pragma unroll
    for (int i = 0; i < 32; ++i) v[i] = valid ? sp[(size_t)(8 * i) * ldw] : 0.f;
#pragma unroll
    for (int i = 0; i < 32; ++i) T[(wave + 8 * i) * 65 + lane] = v[i];
    __syncthreads();
    const int row = tid >> 3;
#pragma unroll
    for (int c = 0; c < 4; ++c) { const int kc = (tid & 7) * 8 + 64 * c; float f[8];
#pragma unroll
        for (int i = 0; i < 8; ++i) f[i] = T[(kc + i) * 65 + row];
        u32x4 w; w.x = pack2(f[0], f[1]); w.y = pack2(f[2], f[3]); w.z = pack2(f[4], f[5]); w.w = pack2(f[6], f[7]);
        *(u32x4*)(dst + (size_t)(tr * 64 + row) * K + tk * 256 + kc) = w; }
    __syncthreads();
}

DI void prologue_phase(const Params& P, ldsp_t lds) {
    const int tid = vtid(), lane = tid & 63, wave = tid >> 6;
    const int G = gridDim.x, gtid = sbid() * 512 + tid, gsz = G * 512;
    unsigned char* ws = wsp(P);
    const float* in_w2 = INP(I_W2); const float* in_a2 = INP(I_A2); const float* in_g2 = INP(I_G2); const float* in_cp = INP(I_CP); const float* in_cs = INP(I_CS);
    const float* in_adaw = INP(I_ADAW); const float* in_adab = INP(I_ADAB);
    { f32x2* rt = (f32x2*)(ws + WS_ROPE);
      for (int idx = gtid; idx < 4096 * 32; idx += gsz) { const int pos = idx >> 5, i = idx & 31;
          const float inv = exp2f(-(float)i * 0.41524101186092029f);
          const double turns = (double)pos * (double)inv * 0.15915494309189535;
          const float fr = (float)(turns - rint(turns));
          f32x2 cs; cs.x = __builtin_amdgcn_cosf(fr); cs.y = __builtin_amdgcn_sinf(fr); rt[idx] = cs; } }
    for (int idx = gtid; idx < 2 * 3072 * 256; idx += gsz) { const int l = idx / (3072 * 256), e = idx % (3072 * 256), j = e >> 8, k = e & 255; float v = 0.f;
        if (j < 1024) { if (k < 64) v = in_w2[((size_t)l * 64 + k) * 1024 + j]; }
        else if (j < 2048) { if (k >= 64 && k < 128) v = in_a2[((size_t)l * 64 + (k - 64)) * 1024 + (j - 1024)]; }
        else { if (k >= 128) v = in_g2[((size_t)l * 128 + (k - 128)) * 1024 + (j - 2048)]; }
        ((bf16_t*)(ws + WS_WLO))[idx] = f2bf(v); }
    { LAS float* S = (LAS float*)lds;
      LAS float* R = S + 2048 * 12;
      for (int idx = tid; idx < 2048 * 10; idx += 512) { const int s = idx >> 11, k = idx & 2047;
          const float c = s < 2 ? in_cp[s * 2048 + k] : in_cs[(s - 2) * 2048 + k]; S[k * 12 + s] = siluf_(c); }
      for (int idx = tid; idx < 2048; idx += 512) { S[idx * 12 + 10] = 0.f; S[idx * 12 + 11] = 0.f; }
      __syncthreads();
      float* mod = (float*)(ws + WS_MOD);
      for (int item = sbid(); item < 576; item += G) { const int l = item / 288, cgp = item % 288;
          const float* W = in_adaw + (size_t)l * 2048 * MODLD + cgp * 64 + lane; const int k0 = wave * 256;
          float acc[10];
#pragma unroll
          for (int s = 0; s < 10; ++s) acc[s] = 0.f;
          for (int kk = 0; kk < 256; kk += 8) { float w[8];
#pragma unroll
              for (int i = 0; i < 8; ++i) w[i] = W[(size_t)(k0 + kk + i) * MODLD];
#pragma unroll
              for (int i = 0; i < 8; ++i) { const LAS float* sp = S + (k0 + kk + i) * 12; const f32x4 s0 = *(const LAS f32x4*)sp, s1 = *(const LAS f32x4*)(sp + 4), s2 = *(const LAS f32x4*)(sp + 8);
                  acc[0] += w[i] * s0[0]; acc[1] += w[i] * s0[1]; acc[2] += w[i] * s0[2]; acc[3] += w[i] * s0[3]; acc[4] += w[i] * s1[0];
                  acc[5] += w[i] * s1[1]; acc[6] += w[i] * s1[2]; acc[7] += w[i] * s1[3]; acc[8] += w[i] * s2[0]; acc[9] += w[i] * s2[1]; } }
#pragma unroll
          for (int s = 0; s < 10; ++s) R[(wave * 10 + s) * 64 + lane] = acc[s];
          __syncthreads();
          for (int o = tid; o < 640; o += 512) { const int s = o >> 6, c = o & 63; float t = 0.f;
#pragma unroll
              for (int w8 = 0; w8 < 8; ++w8) t += R[(w8 * 10 + s) * 64 + c];
              mod[(size_t)(l * 10 + s) * MODLD + cgp * 64 + c] = t + in_adab[(size_t)l * MODLD + cgp * 64 + c]; }
          __syncthreads(); } }
    { LAS float* T = (LAS float*)lds;
      const float* in_fwi = INP(I_FWI); const float* in_fwo = INP(I_FWO); const float* in_win = INP(I_WIN); const float* in_wkvb = INP(I_WKVB); const float* in_wbr = INP(I_WBR); const float* in_wout = INP(I_WOUT);
      const int PER_LAYER = 1408 + 1408 + 704 + 704 + 1856 + 32 + 32 + 128 + 128 + 128 + 256;
      const int start = (sbid() + 64) % G;
      for (int tile = start; tile < 2 * PER_LAYER; tile += G) {
          const int l = tile / PER_LAYER; int t = tile % PER_LAYER;
          const float* src; bf16_t* dst; int ldw, K, vr, mode, nkt;
          if (t < 2816) { const int f = t / 1408; t %= 1408; src = in_fwi + (size_t)(l * 2 + f) * D * (2 * DFF); dst = (bf16_t*)(ws + WS_WFI + (l * 2 + f) * SZ_WFI); ldw = 2 * DFF; K = D; vr = 2 * DFF; mode = 1; nkt = 8; }
          else if (t < 4224) { t -= 2816; const int f = t / 704; t %= 704; src = in_fwo + (size_t)(l * 2 + f) * DFF * D; dst = (bf16_t*)(ws + WS_WFO + (l * 2 + f) * SZ_WFO); ldw = D; K = DFF; vr = D; mode = 0; nkt = 22; }
          else if (t < 6080) { t -= 4224; src = in_win + (size_t)l * D * INCOLS; dst = (bf16_t*)(ws + WS_WIN + l * SZ_WIN); ldw = INCOLS; K = D; vr = INCOLS; mode = 0; nkt = 8; }
          else if (t < 6112) { t -= 6080; src = in_wkvb + (size_t)l * 512 * 2048; dst = (bf16_t*)(ws + WS_WKK + l * SZ_WKK); ldw = 2048; K = 512; vr = 1024; mode = 2; nkt = 2; }
          else if (t < 6144) { t -= 6112; src = in_wkvb + (size_t)l * 512 * 2048; dst = (bf16_t*)(ws + WS_WKV + l * SZ_WKK); ldw = 2048; K = 512; vr = 1024; mode = 3; nkt = 2; }
          else if (t < 6528) { t -= 6144; const int n = t / 128; t %= 128; src = in_wbr + (size_t)(l * 3 + n) * 1024 * D; dst = (bf16_t*)(ws + WS_WBR + (l * 3 + n) * SZ_WBR); ldw = D; K = 1024; vr = D; mode = 0; nkt = 4; }
          else { t -= 6528; src = in_wout + (size_t)l * D * D; dst = (bf16_t*)(ws + WS_WO + l * SZ_WO); ldw = D; K = D; vr = D; mode = 0; nkt = 8; }
          conv_tile(src, ldw, K, dst, vr, mode, t / nkt, t % nkt, T); } }
}

DI void norm_phase(const Params& P, int l, int which, bool first) {
    unsigned char* ws = wsp(P); const float* in_ng = INP(I_NORMG); const float* in_xp = INP(I_XP); const float* in_xs = INP(I_XS);
    const int lane = vtid() & 63, gw = sbid() * 8 + (vtid() >> 6);
    float* xb = (float*)(ws + WS_X); bf16_t* h = (bf16_t*)(ws + WS_H); const float* mod = (const float*)(ws + WS_MOD);
    const int nwv = gridDim.x * 8, rpw = (MP + nwv - 1) / nwv, r0 = gw * rpw;
    int cur_s = -1; f32x4 gm[8], sh[8];
    for (int r = r0; r < r0 + rpw && r < MP; ++r) {
        bf16_t* hp = h + (size_t)r * D + 4 * lane;
        if (r >= NTOK) {
#pragma unroll
            for (int i = 0; i < 8; ++i) *(u32x2*)(hp + 256 * i) = (u32x2){0u, 0u};
            continue; }
        const int s = row_stream(r);
        if (s != cur_s) { cur_s = s; const float* gp = in_ng + (size_t)(l * 3 + which) * D + 4 * lane; const float* mp = mod + (size_t)(l * 10 + s) * MODLD + (which * 3) * D + 4 * lane;
#pragma unroll
            for (int i = 0; i < 8; ++i) { const f32x4 g = *(const f32x4*)(gp + 256 * i), sc = *(const f32x4*)(mp + D + 256 * i); sh[i] = *(const f32x4*)(mp + 256 * i); gm[i] = g * (sc + 1.0f); } }
        const float* xp = first ? (r < NTOK_P ? in_xp + (size_t)r * D : in_xs + (size_t)(r - NTOK_P) * D) : xb + (size_t)r * D;
        f32x4 x[8]; float ss = 0.f;
#pragma unroll
        for (int i = 0; i < 8; ++i) { x[i] = *(const f32x4*)(xp + 4 * lane + 256 * i); ss += x[i][0] * x[i][0] + x[i][1] * x[i][1] + x[i][2] * x[i][2] + x[i][3] * x[i][3]; }
        ss = wave_sum(ss); const float rstd = rsqrtf(ss * (1.0f / D) + 1e-6f);
        if (first) {
#pragma unroll
            for (int i = 0; i < 8; ++i) *(f32x4*)(xb + (size_t)r * D + 4 * lane + 256 * i) = x[i]; }
#pragma unroll
        for (int i = 0; i < 8; ++i) { const f32x4 y = x[i] * rstd * gm[i] + sh[i]; u32x2 w; w.x = pack2(y[0], y[1]); w.y = pack2(y[2], y[3]); *(u32x2*)(hp + 256 * i) = w; }
    }
}
DI void final_phase(const Params& P) {
    unsigned char* ws = wsp(P); float* out = outp(P); const float* in_fng = INP(I_FNG);
    const int lane = vtid() & 63, gw = sbid() * 8 + (vtid() >> 6), nwv = gridDim.x * 8;
    const float* xb = (const float*)(ws + WS_X);
    f32x4 g[8];
#pragma unroll
    for (int i = 0; i < 8; ++i) g[i] = *(const f32x4*)(in_fng + 4 * lane + 256 * i);
    for (int r = gw; r < NTOK; r += nwv) { const float* xp = xb + (size_t)r * D + 4 * lane; f32x4 x[8]; float ss = 0.f;
#pragma unroll
        for (int i = 0; i < 8; ++i) { x[i] = *(const f32x4*)(xp + 256 * i); ss += x[i][0] * x[i][0] + x[i][1] * x[i][1] + x[i][2] * x[i][2] + x[i][3] * x[i][3]; }
        ss = wave_sum(ss); const float rstd = rsqrtf(ss * (1.0f / D) + 1e-6f);
        float* op = out + (r < NTOK_P ? O_YP + (size_t)r * D : O_YS + (size_t)(r - NTOK_P) * D) + 4 * lane;
#pragma unroll
        for (int i = 0; i < 8; ++i) *(f32x4*)(op + 256 * i) = x[i] * rstd * g[i]; }
}

DI void prep_phase(const Params& P, int l) {
    const int lane = vtid() & 63, gw = sbid() * 8 + (vtid() >> 6), nwv = gridDim.x * 8;
    unsigned char* ws = wsp(P); float* out = outp(P); const float* in_clat = INP(I_CLAT); const float* in_ckr = INP(I_CKR); const float* in_rwsh = INP(I_RWSH);
    const bf16_t* z = (const bf16_t*)(ws + WS_Z); bf16_t* latA = (bf16_t*)(ws + WS_LATA); bf16_t* krA = (bf16_t*)(ws + WS_KRA); bf16_t* qR = (bf16_t*)(ws + WS_QR); bf16_t* lin = (bf16_t*)(ws + WS_LIN);
    const f32x2* rope = (const f32x2*)(ws + WS_ROPE);
    f32x4 kg0 = *(const f32x4*)(INP(I_KVG) + l * 512 + 8 * lane), kg1 = *(const f32x4*)(INP(I_KVG) + l * 512 + 8 * lane + 4);
    const f32x4 mu4 = *(const f32x4*)(INP(I_MU) + (size_t)l * 3328 + 3072 + 4 * lane);
    for (int row = gw; row < MP; row += nwv) {
        if (row >= NTOK) { *(u32x2*)(lin + (size_t)row * 256 + 4 * lane) = (u32x2){0u, 0u}; continue; }
        const bool pr = row < NTOK_P; const int s = row_stream(row), b = pr ? s : s - 2, t = pr ? (row & 4095) : ((row - NTOK_P) & 15), pos = pr ? t : 2048 + t, T = pr ? 4096 : 16;
        const bf16_t* zr = z + (size_t)row * ZLD;
        const int keyrow = pr ? row : NTOK_P + b * SKEY + 2048 + t;
        { const u32x4 lv = *(const u32x4*)(zr + ZLAT + 8 * lane);
          float v[8] = {lo16(lv.x), hi16(lv.x), lo16(lv.y), hi16(lv.y), lo16(lv.z), hi16(lv.z), lo16(lv.w), hi16(lv.w)}; float ss = 0.f;
#pragma unroll
          for (int j = 0; j < 8; ++j) ss += v[j] * v[j];
          ss = wave_sum(ss); const float rstd = rsqrtf(ss * (1.0f / 512.0f) + 1e-6f);
          f32x4 o0, o1;
#pragma unroll
          for (int j = 0; j < 4; ++j) { o0[j] = v[j] * rstd * kg0[j]; o1[j] = v[4 + j] * rstd * kg1[j]; }
          float* op = out + (pr ? O_PLAT + ((size_t)(l * 2 + b) * 4096 + t) * 512 : O_SLAT + ((size_t)(l * 8 + b) * 16 + t) * 512) + 8 * lane;
          *(f32x4*)op = o0; *(f32x4*)(op + 4) = o1;
          u32x4 w; w.x = pack2(o0[0], o0[1]); w.y = pack2(o0[2], o0[3]); w.z = pack2(o1[0], o1[1]); w.w = pack2(o1[2], o1[3]);
          *(u32x4*)(latA + (size_t)keyrow * 512 + 8 * lane) = w; }
        if (lane < 32) { const float x1 = bf2f(zr[ZKR + lane]), x2 = bf2f(zr[ZKR + 32 + lane]); const f32x2 cs = rope[pos * 32 + lane];
            const float o1 = x1 * cs.x - x2 * cs.y, o2 = x2 * cs.x + x1 * cs.y;
            float* op = out + (pr ? O_PKR + ((size_t)(l * 2 + b) * 4096 + t) * 64 : O_SKR + ((size_t)(l * 8 + b) * 16 + t) * 64);
            op[lane] = o1; op[32 + lane] = o2; krA[(size_t)keyrow * 64 + lane] = f2bf(o1); krA[(size_t)keyrow * 64 + 32 + lane] = f2bf(o2); }
#pragma unroll
        for (int i = 0; i < 4; ++i) { const int p = lane + 64 * i, hd = p >> 5, ii = p & 31; const bf16_t* qp = zr + ZQA + hd * 192 + 128;
            const float x1 = bf2f(qp[ii]), x2 = bf2f(qp[32 + ii]); const f32x2 cs = rope[pos * 32 + ii];
            qR[(size_t)row * 512 + hd * 64 + ii] = f2bf(x1 * cs.x - x2 * cs.y); qR[(size_t)row * 512 + hd * 64 + 32 + ii] = f2bf(x2 * cs.x + x1 * cs.y); }
        { const u32x2 cw = *(const u32x2*)(zr + ZWD + 4 * lane); f32x4 cur = {lo16(cw.x), hi16(cw.x), lo16(cw.y), hi16(cw.y)}, prev;
          if (t > 0) { const u32x2 pw = *(const u32x2*)(zr - ZLD + ZWD + 4 * lane); prev = (f32x4){lo16(pw.x), hi16(pw.x), lo16(pw.y), hi16(pw.y)}; }
          else if (pr) prev = (f32x4){0.f, 0.f, 0.f, 0.f};
          else prev = *(const f32x4*)(in_rwsh + (size_t)(l * 8 + b) * 3328 + 3072 + 4 * lane);
          f32x4 xs = cur + (prev - cur) * mu4, o;
#pragma unroll
          for (int j = 0; j < 4; ++j) o[j] = lane < 16 ? tanhf(xs[j]) : (lane < 32 ? xs[j] : sigmoidf_(xs[j]));
          u32x2 w; w.x = pack2(o[0], o[1]); w.y = pack2(o[2], o[3]); *(u32x2*)(lin + (size_t)row * 256 + 4 * lane) = w; }
        if (t == T - 1) { float* op = out + (pr ? O_PSH + (size_t)(l * 2 + b) * 3328 : O_SSH + (size_t)(l * 8 + b) * 3328);
#pragma unroll 2
            for (int c = lane; c < 3328; c += 64) op[c] = bf2f(zr[ZR + c]); }
    }
    for (int idx = gw; idx < 8 * SKEY; idx += nwv) { const int b = idx / SKEY, j = idx % SKEY; const size_t keyrow = NTOK_P + idx;
        if (j < 2048) { const float* cp = in_clat + ((size_t)(l * 8 + b) * 2048 + j) * 512 + 8 * lane; const f32x4 a = *(const f32x4*)cp, c = *(const f32x4*)(cp + 4);
            u32x4 w; w.x = pack2(a[0], a[1]); w.y = pack2(a[2], a[3]); w.z = pack2(c[0], c[1]); w.w = pack2(c[2], c[3]); *(u32x4*)(latA + keyrow * 512 + 8 * lane) = w;
            krA[keyrow * 64 + lane] = f2bf(in_ckr[((size_t)(l * 8 + b) * 2048 + j) * 64 + lane]); }
        else if (j >= 2064) { *(u32x4*)(latA + keyrow * 512 + 8 * lane) = (u32x4){0u, 0u, 0u, 0u}; krA[keyrow * 64 + lane] = 0; } }
}

DI f32x16 mma_tile32(const LAS bf16_t* A, int lda, const LAS bf16_t* Bt, int ldb, int K, f32x16 acc, int lane) {
    const int r = lane & 31, hh = lane >> 5;
    const LAS bf16_t* ap = A + r * lda + 8 * hh; const LAS bf16_t* bp = Bt + r * ldb + 8 * hh;
    for (int k = 0; k < K; k += 16) { const bf16x8 a = *(const LAS bf16x8*)(ap + k); const bf16x8 b = *(const LAS bf16x8*)(bp + k); acc = MFMA32(a, b, acc); }
    return acc;
}
DI f32x16 zero16() { f32x16 z; for (int i = 0; i < 16; ++i) z[i] = 0.f; return z; }
struct MlItem { int b, h, row0, L; bool prompt; };
DI MlItem ml_item(int item) { MlItem it; if (item < 512) { const int sh = item >> 6, c = item & 63; it.b = sh >> 2; it.h = sh & 3; it.row0 = it.b * 4096 + 64 * c; it.L = 64; it.prompt = true; }
    else { const int j = item - 512; it.b = j >> 2; it.h = j & 3; it.row0 = NTOK_P + 16 * it.b; it.L = 16; it.prompt = false; } return it; }

constexpr int MLA_QS = 0, MLA_KS = 17408, MLA_KT = 34816, MLA_VT = 53248, MLA_PS = 94720, MLA_G = 103936;
DI void mlstm_pass_a(const Params& P, ldsp_t lds, int l) {
    const int tid = vtid(), lane = tid & 63, wave = tid >> 6;
    unsigned char* ws = wsp(P); const bf16_t* z = (const bf16_t*)(ws + WS_Z);
    float* numl = (float*)(ws + WS_NUML); float* denl = (float*)(ws + WS_DENL); float* mlg = (float*)(ws + WS_MLG); float* dC = (float*)(ws + WS_DC); float* mli = (float*)(ws + WS_MLI);
    LAS bf16_t* Qs = (LAS bf16_t*)(lds + MLA_QS); LAS bf16_t* Ks = (LAS bf16_t*)(lds + MLA_KS); LAS bf16_t* KT = (LAS bf16_t*)(lds + MLA_KT);
    LAS bf16_t* VT = (LAS bf16_t*)(lds + MLA_VT); LAS bf16_t* Ps = (LAS bf16_t*)(lds + MLA_PS); LAS float* Gu = (LAS float*)(lds + MLA_G); LAS float* Gpm = Gu + 64; LAS float* Gwp = Gu + 128;
    const float* in_ib = INP(I_MLIB); const float* in_fb = INP(I_MLFB);
    for (int item = sbid(); item < ML_ITEMS; item += gridDim.x) {
        const MlItem it = ml_item(item); const int L = it.L, h = it.h, row0 = it.row0;
        if (wave == 0) { const int t = lane; const bool valid = t < L; const bf16_t* zr = z + (size_t)(row0 + (valid ? t : 0)) * ZLD;
            const float igr = bf2f(zr[ZIG + h]) + in_ib[l * 4 + h], fgr = bf2f(zr[ZFG + h]) + in_fb[l * 4 + h];
            const float ig = softcap15(igr); float bsum = valid ? logsigmoidf_(softcap15(fgr)) : 0.f;
#pragma unroll
            for (int o = 1; o < 64; o <<= 1) { const float v = __shfl_up(bsum, o); if (lane >= o) bsum += v; }
            const float u = valid ? ig - bsum : -1e30f; float pm = u;
#pragma unroll
            for (int o = 1; o < 64; o <<= 1) { const float v = __shfl_up(pm, o); if (lane >= o) pm = fmaxf(pm, v); }
            const float blast = __shfl(bsum, L - 1), pmlast = __shfl(pm, L - 1);
            Gu[t] = u; Gpm[t] = pm; Gwp[t] = valid ? __expf(u - pmlast) : 0.f;
            if (valid) { float* gp = mlg + ((size_t)(row0 + t) * 4 + h) * 2; gp[0] = bsum; gp[1] = bsum + pm; }
            if (lane == 0) { mli[item * 4 + 0] = blast; mli[item * 4 + 1] = blast + pmlast; } }
#pragma unroll
        for (int i = 0; i < 2; ++i) { const int idx = tid + 512 * i, s = idx >> 4, ch = idx & 15; u32x4 q = {0u, 0u, 0u, 0u}, k = q;
            if (s < L) { const bf16_t* zr = z + (size_t)(row0 + s) * ZLD + h * 128 + 8 * ch; q = *(const u32x4*)(zr + ZQM); k = *(const u32x4*)(zr + ZKM); }
            *(LAS u32x4*)(Qs + s * 136 + 8 * ch) = q; *(LAS u32x4*)(Ks + s * 136 + 8 * ch) = k; }
#pragma unroll
        for (int i = 0; i < 4; ++i) { const int idx = tid + 512 * i, s = idx & 63, ch = idx >> 6; u32x4 v = {0u, 0u, 0u, 0u};
            if (s < L) v = *(const u32x4*)(z + (size_t)(row0 + s) * ZLD + ZVM + h * 256 + 8 * ch);
            LAS bf16_t* vp = VT + (8 * ch) * 72 + s;
            vp[0] = (bf16_t)(v.x & 0xffff); vp[72] = (bf16_t)(v.x >> 16); vp[144] = (bf16_t)(v.y & 0xffff); vp[216] = (bf16_t)(v.y >> 16);
            vp[288] = (bf16_t)(v.z & 0xffff); vp[360] = (bf16_t)(v.z >> 16); vp[432] = (bf16_t)(v.w & 0xffff); vp[504] = (bf16_t)(v.w >> 16); }
        for (int idx = tid; idx < 32 * 64; idx += 512) { const int rr = idx >> 6, s = idx & 63; VT[(256 + rr) * 72 + s] = (rr == 0) ? (bf16_t)0x3F80 : (bf16_t)0; }
        __syncthreads();
        { const int s = tid & 63, dg = tid >> 6; const float wp = Gwp[s];
#pragma unroll
          for (int hf = 0; hf < 2; ++hf) { const u32x4 kv = *(const LAS u32x4*)(Ks + s * 136 + dg * 16 + 8 * hf); LAS bf16_t* kp = KT + (dg * 16 + 8 * hf) * 72 + s;
              kp[0] = f2bf(lo16(kv.x) * wp); kp[72] = f2bf(hi16(kv.x) * wp); kp[144] = f2bf(lo16(kv.y) * wp); kp[216] = f2bf(hi16(kv.y) * wp);
              kp[288] = f2bf(lo16(kv.z) * wp); kp[360] = f2bf(hi16(kv.z) * wp); kp[432] = f2bf(lo16(kv.w) * wp); kp[504] = f2bf(hi16(kv.w) * wp); } }
        if (wave < 4) { const int ti = wave >> 1, si = wave & 1, r = lane & 31, hh = lane >> 5;
            f32x16 acc = mma_tile32(Qs + ti * 32 * 136, 136, Ks + si * 32 * 136, 136, 128, zero16(), lane);
            const int s = si * 32 + r; const float us = Gu[s];
#pragma unroll
            for (int i = 0; i < 16; ++i) { const int t = ti * 32 + crow(i, hh); const float d = (s <= t) ? __expf(us - Gpm[t]) : 0.f;
                Ps[t * 72 + s] = f2bf(acc[i] * 0.08838834764831845f * d); } }
        __syncthreads();
        for (int tl = wave; tl < 54; tl += 8) { const int r = lane & 31, hh = lane >> 5;
            if (tl < 18) { const int ti = tl / 9, vj = tl % 9;
                const f32x16 acc = mma_tile32(Ps + ti * 32 * 72, 72, VT + vj * 32 * 72, 72, 64, zero16(), lane);
                if (vj < 8) { float* np = numl + ((size_t)item * 16 + ti * 8 + vj) * 1024 + lane * 16;
#pragma unroll
                    for (int g = 0; g < 4; ++g) *(f32x4*)(np + 4 * g) = (f32x4){acc[4 * g], acc[4 * g + 1], acc[4 * g + 2], acc[4 * g + 3]}; }
                else if (r == 0) {
#pragma unroll
                    for (int i = 0; i < 16; ++i) { const int t = ti * 32 + crow(i, hh); if (t < L) denl[(size_t)(row0 + t) * 4 + h] = acc[i]; } } }
            else { const int q = tl - 18, vi = q >> 2, kj = q & 3;
                const f32x16 acc = mma_tile32(VT + vi * 32 * 72, 72, KT + kj * 32 * 72, 72, 64, zero16(), lane);
#pragma unroll
                for (int i = 0; i < 16; ++i) { const int dv = vi * 32 + crow(i, hh); if (dv < 257) dC[(size_t)item * ML_CSZ + dv * 128 + kj * 32 + r] = acc[i] * 0.08838834764831845f; } } }
        __syncthreads();
    }
}
DI void mlstm_pass_b(const Params& P, int l, int gtid, int gsz) {
    unsigned char* ws = wsp(P); float* out = outp(P); const float* in_mlm = INP(I_MLM); const float* in_mlc = INP(I_MLC); const float* in_mln = INP(I_MLN); float* dC = (float*)(ws + WS_DC); float* mli = (float*)(ws + WS_MLI);
    constexpr int NV = 257 * 128 / 4;
    for (int v = gtid; v < 40 * NV; v += gsz) { const int seq = v / NV, e = v % NV;
        int b, h, item0, nc; float m; f32x4 st;
        if (seq < 8) { b = seq >> 2; h = seq & 3; item0 = seq * 64; nc = 64; m = 0.f; st = (f32x4){0.f, 0.f, 0.f, 0.f}; }
        else { const int j = seq - 8; b = j >> 2; h = j & 3; item0 = 512 + j; nc = 1; m = in_mlm[(l * 8 + b) * 4 + h];
            st = (e < 8192) ? *(const f32x4*)(in_mlc + ((size_t)(l * 8 + b) * 4 + h) * 32768 + 4 * e) : *(const f32x4*)(in_mln + ((size_t)(l * 8 + b) * 4 + h) * 128 + 4 * (e - 8192)); }
        for (int c = 0; c < nc; ++c) { const int item = item0 + c; const float bl = mli[item * 4 + 0], al = mli[item * 4 + 1];
            const float mn = fmaxf(bl + m, al), cw = __expf(bl + m - mn), be = __expf(al - mn);
            f32x4* p = (f32x4*)(dC + (size_t)item * ML_CSZ) + e; const f32x4 d = *p; *p = st; st = st * cw + d * be;
            if (e == 0) mli[item * 4 + 2] = m;
            m = mn; }
        const bool pr = seq < 8; const size_t sh = (size_t)(l * (pr ? 2 : 8) + b) * 4 + h;
        if (e < 8192) *(f32x4*)(out + (pr ? O_PC : O_SC) + sh * 32768 + 4 * e) = st; else *(f32x4*)(out + (pr ? O_PN : O_SN) + sh * 128 + 4 * (e - 8192)) = st;
        if (e == 0) out[(pr ? O_PM : O_SM) + sh] = m; }
}
constexpr int MLC_QS = 0, MLC_CS = 17408, MLC_HS = 17408, MLC_G = 17408 + 78336;
DI void mlstm_pass_c(const Params& P, ldsp_t lds, int l) {
    const int tid = vtid(), lane = tid & 63, wave = tid >> 6;
    unsigned char* ws = wsp(P); const bf16_t* z = (const bf16_t*)(ws + WS_Z);
    const float* numl = (const float*)(ws + WS_NUML); const float* denl = (const float*)(ws + WS_DENL); const float* mlg = (const float*)(ws + WS_MLG);
    const float* dC = (const float*)(ws + WS_DC); const float* mli = (const float*)(ws + WS_MLI); bf16_t* oall = (bf16_t*)(ws + WS_OALL);
    LAS bf16_t* Qs = (LAS bf16_t*)(lds + MLC_QS); LAS bf16_t* Cs = (LAS bf16_t*)(lds + MLC_CS); LAS float* Hs = (LAS float*)(lds + MLC_HS);
    LAS float* Gel = (LAS float*)(lds + MLC_G); LAS float* Gei = Gel + 64; LAS float* Gcl = Gel + 128; LAS float* Gqn = Gel + 192;
    const float* in_hg = INP(I_MLHG);
    for (int item = sbid(); item < ML_ITEMS; item += gridDim.x) {
        const MlItem it = ml_item(item); const int L = it.L, h = it.h, row0 = it.row0;
#pragma unroll
        for (int i = 0; i < 2; ++i) { const int idx = tid + 512 * i, s = idx >> 4, ch = idx & 15; u32x4 q = {0u, 0u, 0u, 0u};
            if (s < L) q = *(const u32x4*)(z + (size_t)(row0 + s) * ZLD + ZQM + h * 128 + 8 * ch);
            *(LAS u32x4*)(Qs + s * 136 + 8 * ch) = q; }
#pragma unroll 2
        for (int idx = tid; idx < 288 * 32; idx += 512) { const int dv = idx >> 5, c4 = idx & 31; u32x2 w = {0u, 0u};
            if (dv < 257) { const f32x4 c = *(const f32x4*)(dC + (size_t)item * ML_CSZ + dv * 128 + 4 * c4); w.x = pack2(c[0], c[1]); w.y = pack2(c[2], c[3]); }
            *(LAS u32x2*)(Cs + dv * 136 + 4 * c4) = w; }
        if (tid < 64) { const int t = tid; float el = 0.f, ei = 0.f, cl = 1.f, dn = 0.f;
            if (t < L) { const float* gp = mlg + ((size_t)(row0 + t) * 4 + h) * 2; const float bt = gp[0], at = gp[1], mp = mli[item * 4 + 2];
                const float mt = fmaxf(bt + mp, at); el = __expf(at - mt); ei = __expf(bt + mp - mt); cl = __expf(-mt); dn = el * denl[(size_t)(row0 + t) * 4 + h]; }
            Gel[t] = el; Gei[t] = ei; Gcl[t] = cl; Gqn[64 + t] = dn; }
        __syncthreads();
        const int r = lane & 31, hh = lane >> 5;
        if (wave < 2) { const f32x16 aq = mma_tile32(Qs + wave * 32 * 136, 136, Cs + 8 * 32 * 136, 136, 128, zero16(), lane);
            if (r == 0) {
#pragma unroll
                for (int i = 0; i < 16; ++i) Gqn[wave * 32 + crow(i, hh)] = aq[i]; } }
        __syncthreads();
        if (tid < 64) { const int t = tid; const float el = Gel[t], ei = Gei[t]; const float den = Gqn[64 + t] + ei * Gqn[t]; const float md = fmaxf(fabsf(den), Gcl[t]);
            Gel[t] = (t < L) ? el / md : 0.f; Gei[t] = (t < L) ? ei / md : 0.f; }
        __syncthreads();
        f32x16 hv2[2];
#pragma unroll
        for (int k = 0; k < 2; ++k) { const int tl = wave + 8 * k, ti = tl >> 3, vj = tl & 7;
            const f32x16 acc = mma_tile32(Qs + ti * 32 * 136, 136, Cs + vj * 32 * 136, 136, 128, zero16(), lane);
            const float* np = numl + ((size_t)item * 16 + tl) * 1024 + lane * 16;
#pragma unroll
            for (int g = 0; g < 4; ++g) { const f32x4 nv = *(const f32x4*)(np + 4 * g); const f32x4 ca = *(const LAS f32x4*)(Gel + ti * 32 + 8 * g + 4 * hh), cb = *(const LAS f32x4*)(Gei + ti * 32 + 8 * g + 4 * hh);
#pragma unroll
                for (int j = 0; j < 4; ++j) hv2[k][4 * g + j] = ca[j] * nv[j] + cb[j] * acc[4 * g + j]; } }
        __syncthreads();
#pragma unroll
        for (int k = 0; k < 2; ++k) { const int tl = wave + 8 * k, ti = tl >> 3, vj = tl & 7;
#pragma unroll
            for (int i = 0; i < 16; ++i) Hs[(ti * 32 + crow(i, hh)) * 260 + vj * 32 + r] = hv2[k][i]; }
        __syncthreads();
        { const f32x4 hg = *(const f32x4*)(in_hg + l * 1024 + h * 256 + 4 * lane);
#pragma unroll
          for (int i = 0; i < 8; ++i) { const int t = wave * 8 + i;
              if (t < L) { const f32x4 hv = *(const LAS f32x4*)(Hs + t * 260 + 4 * lane); float ss = hv[0] * hv[0] + hv[1] * hv[1] + hv[2] * hv[2] + hv[3] * hv[3];
                  ss = wave_sum(ss); const float rstd = rsqrtf(ss * (1.0f / 256.0f) + 1e-6f);
                  const u32x2 ow = *(const u32x2*)(z + (size_t)(row0 + t) * ZLD + ZOM + h * 256 + 4 * lane);
                  const float o0 = sigmoidf_(lo16(ow.x)) * hv[0] * rstd * hg[0], o1 = sigmoidf_(hi16(ow.x)) * hv[1] * rstd * hg[1], o2 = sigmoidf_(lo16(ow.y)) * hv[2] * rstd * hg[2], o3 = sigmoidf_(hi16(ow.y)) * hv[3] * rstd * hg[3];
                  u32x2 w; w.x = pack2(o0, o1); w.y = pack2(o2, o3); *(u32x2*)(oall + (size_t)(row0 + t) * 1024 + h * 256 + 4 * lane) = w; } } }
        __syncthreads();
    }
}

constexpr int RW_BUF = 5 * 32 * 64 * 4 + 32 * 16 * 4;
constexpr int RW_YOFF = 2 * RW_BUF;
DI void rwkv_item(const Params& P, ldsp_t lds, int l, int b, int hd, int qd, bool prompt) {
    const int tid = vtid(), lane = tid & 63, wave = tid >> 6;
    unsigned char* ws = wsp(P); float* out = outp(P); const float* in_rwsh = INP(I_RWSH); const bf16_t* z = (const bf16_t*)(ws + WS_Z); const float* lout = (const float*)(ws + WS_LOUT);
    float* ybuf = (float*)(ws + WS_YB); float* rkb = (float*)(ws + WS_RK);
    const int T = prompt ? 4096 : 16, row0 = prompt ? b * 4096 : NTOK_P + 16 * b, nc = (T + 31) / 32;
    const int col = hd * 64 + lane;
    float mu_r = 0.f, mu_k = 0.f, mu_v = 0.f, w0 = 0.f, a0 = 0.f, k_k = 0.f, k_a = 0.f, r_k = 0.f, pr = 0.f, pk = 0.f, pv = 0.f;
    if (wave >= 4) { const float* mu = INP(I_MU) + (size_t)l * 3328; mu_r = mu[col]; mu_k = mu[1024 + col]; mu_v = mu[2048 + col];
        w0 = INP(I_W0)[l * 1024 + col]; a0 = INP(I_A0)[l * 1024 + col]; k_k = INP(I_KK)[l * 1024 + col]; k_a = INP(I_KA)[l * 1024 + col]; r_k = INP(I_RK)[l * 1024 + col]; }
    f32x4 S = {0.f, 0.f, 0.f, 0.f}; const int si = lane >> 4, cg = lane & 15, vrow = 16 * qd + 4 * (wave & 3) + si;
    if (wave < 4 && !prompt) S = *(const f32x4*)(INP(I_RWS) + (((size_t)(l * 8 + b) * 16 + hd) * 64 + vrow) * 64 + 4 * cg);
    auto prep_chunk = [&](int c) {
        const int buf = c & 1; LAS float* V5 = (LAS float*)(lds + buf * RW_BUF); LAS float* Vq = V5 + 5 * 32 * 64;
        const int pw = wave - 4, t0 = 32 * c + 8 * pw;
        if (t0 < T) {
            if (t0 > 0) { const bf16_t* zp = z + (size_t)(row0 + t0 - 1) * ZLD + ZR + col; pr = bf2f(zp[0]); pk = bf2f(zp[1024]); pv = bf2f(zp[2048]); }
            else if (prompt) { pr = 0.f; pk = 0.f; pv = 0.f; }
            else { const float* sp = in_rwsh + (size_t)(l * 8 + b) * 3328 + col; pr = sp[0]; pk = sp[1024]; pv = sp[2048]; } }
#pragma unroll
        for (int j = 0; j < 8; ++j) { const int t = t0 + j;
            if (t < T) { const int row = row0 + t; const bf16_t* zp = z + (size_t)row * ZLD + ZR + col;
                const float zr = bf2f(zp[0]), zk = bf2f(zp[1024]), zv = bf2f(zp[2048]);
                const float xr = zr + (pr - zr) * mu_r, xk = zk + (pk - zk) * mu_k, xv = zv + (pv - zv) * mu_v; pr = zr; pk = zk; pv = zv;
                const float wl = lout[(size_t)row * 3072 + col], al = lout[(size_t)row * 3072 + 1024 + col];
                const float wraw = logsigmoidf_(w0 + wl) - 0.5f, decay = __expf(-__expf(wraw));
                const float a = sigmoidf_(a0 + al);
                const float kk = xk * k_k; const float ss = wave_sum(kk * kk); const float kkn = kk / fmaxf(sqrtf(ss), 1e-12f);
                const float km = xk * (1.0f + (a - 1.0f) * k_a);
                const int tl = t - 32 * c;
                V5[(0 * 32 + tl) * 64 + lane] = xr; V5[(1 * 32 + tl) * 64 + lane] = decay; V5[(2 * 32 + tl) * 64 + lane] = km; V5[(3 * 32 + tl) * 64 + lane] = -kkn; V5[(4 * 32 + tl) * 64 + lane] = kkn * a;
                if ((lane >> 4) == qd) Vq[tl * 16 + (lane & 15)] = xv;
                const float rk = wave_sum(xr * km * r_k); if (qd == 0 && lane == 0) rkb[(size_t)row * 16 + hd] = rk; } }
    };
    auto flush_y = [&](int c) {
        const LAS float* ysh = (const LAS float*)(lds + RW_YOFF) + (c & 1) * 512; const int q = tid - 256;
#pragma unroll
        for (int i = 0; i < 2; ++i) { const int e = q + 256 * i, tl = e >> 4, rr = e & 15, t = 32 * c + tl; if (t < T) ybuf[(size_t)(row0 + t) * 1024 + hd * 64 + 16 * qd + rr] = ysh[e]; }
    };
    if (wave >= 4) prep_chunk(0);
    __syncthreads();
    for (int c = 0; c < nc; ++c) {
        if (wave < 4) { const int buf = c & 1; const LAS float* V5 = (const LAS float*)(lds + buf * RW_BUF); const LAS float* Vq = V5 + 5 * 32 * 64;
            LAS float* ysh = (LAS float*)(lds + RW_YOFF) + buf * 512; const int ns = (T - 32 * c) < 32 ? (T - 32 * c) : 32;
            for (int t = 0; t < ns; ++t) {
                const f32x4 rv = *(const LAS f32x4*)(V5 + (0 * 32 + t) * 64 + 4 * cg), wv = *(const LAS f32x4*)(V5 + (1 * 32 + t) * 64 + 4 * cg), kv = *(const LAS f32x4*)(V5 + (2 * 32 + t) * 64 + 4 * cg);
                const f32x4 av = *(const LAS f32x4*)(V5 + (3 * 32 + t) * 64 + 4 * cg), bv = *(const LAS f32x4*)(V5 + (4 * 32 + t) * 64 + 4 * cg);
                const float vi = Vq[t * 16 + 4 * (wave & 3) + si];
                float sa = (S[0] * av[0] + S[1] * av[1]) + (S[2] * av[2] + S[3] * av[3]); sa = row16_sum(sa);
                S = S * wv + (bv * sa + kv * vi);
                float y = (S[0] * rv[0] + S[1] * rv[1]) + (S[2] * rv[2] + S[3] * rv[3]); y = row16_sum(y);
                if (cg == 0) ysh[t * 16 + 4 * (wave & 3) + si] = y; } }
        else { if (c + 1 < nc) prep_chunk(c + 1); if (c >= 1) flush_y(c - 1); }
        __syncthreads();
    }
    if (wave >= 4) flush_y(nc - 1);
    if (wave < 4) { float* so = out + (prompt ? O_PS + (((size_t)(l * 2 + b) * 16 + hd) * 64 + vrow) * 64 : O_SS + (((size_t)(l * 8 + b) * 16 + hd) * 64 + vrow) * 64) + 4 * cg; *(f32x4*)so = S; }
    __syncthreads();
}
DI void rwkv_post(const Params& P, int l) {
    const int lane = vtid() & 63, gw = sbid() * 8 + (vtid() >> 6), nwv = gridDim.x * 8;
    unsigned char* ws = wsp(P); const float* in_rwsh = INP(I_RWSH); const bf16_t* z = (const bf16_t*)(ws + WS_Z); const float* lout = (const float*)(ws + WS_LOUT); const float* ybuf = (const float*)(ws + WS_YB);
    const float* rkb = (const float*)(ws + WS_RK); bf16_t* oall = (bf16_t*)(ws + WS_OALL);
    const int hd = lane >> 2, c0 = hd * 64 + (lane & 3) * 16;
    f32x4 lg[4], lb[4], muv[4];
#pragma unroll
    for (int i = 0; i < 4; ++i) { lg[i] = *(const f32x4*)(INP(I_LNG) + l * 1024 + c0 + 4 * i); lb[i] = *(const f32x4*)(INP(I_LNB) + l * 1024 + c0 + 4 * i); muv[i] = *(const f32x4*)(INP(I_MU) + (size_t)l * 3328 + 2048 + c0 + 4 * i); }
    for (int row = gw; row < NTOK; row += nwv) {
        const bool pr = row < NTOK_P; const int s = row_stream(row), b = pr ? s : s - 2, t = pr ? (row & 4095) : ((row - NTOK_P) & 15);
        f32x4 y[4]; float sm = 0.f;
#pragma unroll
        for (int i = 0; i < 4; ++i) { y[i] = *(const f32x4*)(ybuf + (size_t)row * 1024 + c0 + 4 * i); sm += (y[i][0] + y[i][1]) + (y[i][2] + y[i][3]); }
        sm += dppf<0xB1>(sm); sm += dppf<0x4E>(sm); const float mean = sm * (1.0f / 64.0f); float q = 0.f;
#pragma unroll
        for (int i = 0; i < 4; ++i) { const f32x4 d = y[i] - mean; q += (d[0] * d[0] + d[1] * d[1]) + (d[2] * d[2] + d[3] * d[3]); }
        q += dppf<0xB1>(q); q += dppf<0x4E>(q); const float rstd = rsqrtf(q * (1.0f / 64.0f) + 64e-5f);
        const float rk = rkb[(size_t)row * 16 + hd];
        const bf16_t* zv = z + (size_t)row * ZLD + ZRV + c0; const float* gp = lout + (size_t)row * 3072 + 2048 + c0;
        u32x4 cw0 = *(const u32x4*)zv, cw1 = *(const u32x4*)(zv + 8), pw0 = {0u, 0u, 0u, 0u}, pw1 = pw0; float pf[16];
        if (t > 0) { pw0 = *(const u32x4*)(zv - ZLD); pw1 = *(const u32x4*)(zv - ZLD + 8); }
        const unsigned cw[8] = {cw0.x, cw0.y, cw0.z, cw0.w, cw1.x, cw1.y, cw1.z, cw1.w}, pw[8] = {pw0.x, pw0.y, pw0.z, pw0.w, pw1.x, pw1.y, pw1.z, pw1.w};
#pragma unroll
        for (int j = 0; j < 8; ++j) { pf[2 * j] = lo16(pw[j]); pf[2 * j + 1] = hi16(pw[j]); }
        if (t == 0 && !pr) { const float* sp = in_rwsh + (size_t)(l * 8 + b) * 3328 + 2048 + c0;
#pragma unroll
            for (int j = 0; j < 16; ++j) pf[j] = sp[j]; }
        unsigned ow[8];
#pragma unroll
        for (int i = 0; i < 4; ++i) { const f32x4 g = *(const f32x4*)(gp + 4 * i); float o[4];
#pragma unroll
            for (int j = 0; j < 4; ++j) { const int e = 4 * i + j; const float zc = (e & 1) ? hi16(cw[e >> 1]) : lo16(cw[e >> 1]); const float xv = zc + (pf[e] - zc) * muv[i][j];
                o[j] = (((y[i][j] - mean) * rstd) * lg[i][j] + lb[i][j] + rk * xv) * g[j]; }
            ow[2 * i] = pack2(o[0], o[1]); ow[2 * i + 1] = pack2(o[2], o[3]); }
        bf16_t* op = oall + (size_t)2 * MP * 1024 + (size_t)row * 1024 + c0;
        *(u32x4*)op = (u32x4){ow[0], ow[1], ow[2], ow[3]}; *(u32x4*)(op + 8) = (u32x4){ow[4], ow[5], ow[6], ow[7]};
    }
}

struct AttnOut { float m, l; f32x16 o[4]; };
DI void attn_wave(AttnOut& R, const bf16_t* __restrict z, const bf16_t* __restrict qR, const bf16_t* __restrict Kn, const bf16_t* __restrict krA, const bf16_t* __restrict Vt,
                  int qrow, int hd, int kbase, int kb_lo, int kb_hi, int nvalid, int lane) {
    const int r = lane & 31, hh = lane >> 5;
    bf16x8 qf[12];
#pragma unroll
    for (int ks = 0; ks < 8; ++ks) qf[ks] = *(const bf16x8*)(z + (size_t)qrow * ZLD + ZQA + hd * 192 + 16 * ks + 8 * hh);
#pragma unroll
    for (int ks = 0; ks < 4; ++ks) qf[8 + ks] = *(const bf16x8*)(qR + (size_t)qrow * 512 + hd * 64 + 16 * ks + 8 * hh);
    float m = -1e30f, l = 0.f; f32x16 o0 = zero16(), o1 = zero16(), o2 = zero16(), o3 = zero16();
    const float sc = 0.07216878364870322f * 1.4426950408889634f;
    for (int kb = kb_lo; kb < kb_hi; ++kb) {
        const size_t key = (size_t)kbase + 32 * kb + r;
        const bf16_t* kp = Kn + key * 1024 + hd * 128 + 8 * hh; const bf16_t* kp2 = krA + key * 64 + 8 * hh;
        f32x16 st = zero16();
#pragma unroll
        for (int ks = 0; ks < 8; ++ks) { const bf16x8 a = *(const bf16x8*)(kp + 16 * ks); st = MFMA32(a, qf[ks], st); }
#pragma unroll
        for (int ks = 0; ks < 4; ++ks) { const bf16x8 a = *(const bf16x8*)(kp2 + 16 * ks); st = MFMA32(a, qf[8 + ks], st); }
        const bool tail = (32 * kb + 32 > nvalid); float mx = -1e30f;
#pragma unroll
        for (int i = 0; i < 16; ++i) { float s = st[i] * sc; if (tail && (32 * kb + crow(i, hh) >= nvalid)) s = -1e30f; st[i] = s; mx = fmaxf(mx, s); }
        mx = fmaxf(mx, __shfl_xor(mx, 32));
        const float mnew = fmaxf(m, mx), alpha = __builtin_amdgcn_exp2f(m - mnew); float ls = 0.f;
#pragma unroll
        for (int i = 0; i < 16; ++i) { const float p = __builtin_amdgcn_exp2f(st[i] - mnew); st[i] = p; ls += p; }
        l = l * alpha + ls; m = mnew;
        o0 *= alpha; o1 *= alpha; o2 *= alpha; o3 *= alpha;
        const bf16_t* vp = Vt + (size_t)(hd * 128 + r) * KEYS + kbase + 32 * kb + 4 * hh;
#pragma unroll
        for (int s2 = 0; s2 < 2; ++s2) {
            u32x4 pw; pw.x = pack2(st[8 * s2 + 0], st[8 * s2 + 1]); pw.y = pack2(st[8 * s2 + 2], st[8 * s2 + 3]); pw.z = pack2(st[8 * s2 + 4], st[8 * s2 + 5]); pw.w = pack2(st[8 * s2 + 6], st[8 * s2 + 7]);
            const bf16x8 pb = __builtin_bit_cast(bf16x8, pw);
            { const s16x4 lo = *(const s16x4*)(vp + 16 * s2), hi = *(const s16x4*)(vp + 16 * s2 + 8); o0 = MFMA32(__builtin_shufflevector(lo, hi, 0, 1, 2, 3, 4, 5, 6, 7), pb, o0); }
            { const s16x4 lo = *(const s16x4*)(vp + (size_t)32 * KEYS + 16 * s2), hi = *(const s16x4*)(vp + (size_t)32 * KEYS + 16 * s2 + 8); o1 = MFMA32(__builtin_shufflevector(lo, hi, 0, 1, 2, 3, 4, 5, 6, 7), pb, o1); }
            { const s16x4 lo = *(const s16x4*)(vp + (size_t)64 * KEYS + 16 * s2), hi = *(const s16x4*)(vp + (size_t)64 * KEYS + 16 * s2 + 8); o2 = MFMA32(__builtin_shufflevector(lo, hi, 0, 1, 2, 3, 4, 5, 6, 7), pb, o2); }
            { const s16x4 lo = *(const s16x4*)(vp + (size_t)96 * KEYS + 16 * s2), hi = *(const s16x4*)(vp + (size_t)96 * KEYS + 16 * s2 + 8); o3 = MFMA32(__builtin_shufflevector(lo, hi, 0, 1, 2, 3, 4, 5, 6, 7), pb, o3); }
        }
    }
    R.m = m; R.l = l; R.o[0] = o0; R.o[1] = o1; R.o[2] = o2; R.o[3] = o3;
}
DI void attn_prompt_item(const Params& P, int item) {
    const int lane = vtid() & 63, wave = vtid() >> 6; unsigned char* ws = wsp(P);
    const bf16_t* z = (const bf16_t*)(ws + WS_Z); bf16_t* oall = (bf16_t*)(ws + WS_OALL);
    const int bh = item >> 4, jb = item & 15, b = bh >> 3, hd = bh & 7;
    const int qblk = wave < 4 ? 4 * jb + wave : 127 - (4 * jb + wave - 4);
    const int r = lane & 31, hh = lane >> 5, qrow = b * 4096 + 32 * qblk + r, nkb = 2 * (qblk >> 1) + 2;
    AttnOut R;
    attn_wave(R, z, (const bf16_t*)(ws + WS_QR), (const bf16_t*)(ws + WS_KN), (const bf16_t*)(ws + WS_KRA), (const bf16_t*)(ws + WS_VT), qrow, hd, b * 4096, 0, nkb, 1 << 30, lane);
    const float lt = R.l + __shfl_xor(R.l, 32), inv = 1.0f / lt;
    bf16_t* op = oall + (size_t)MP * 1024 + (size_t)qrow * 1024 + hd * 128;
#pragma unroll
    for (int dvb = 0; dvb < 4; ++dvb)
#pragma unroll
        for (int g = 0; g < 4; ++g) { u32x2 w; w.x = pack2(R.o[dvb][4 * g] * inv, R.o[dvb][4 * g + 1] * inv); w.y = pack2(R.o[dvb][4 * g + 2] * inv, R.o[dvb][4 * g + 3] * inv);
            *(u32x2*)(op + 32 * dvb + 8 * g + 4 * hh) = w; }
}
DI void attn_sample_item(const Params& P, ldsp_t lds, int item) {
    const int tid = vtid(), lane = tid & 63, wave = tid >> 6; unsigned char* ws = wsp(P);
    const bf16_t* z = (const bf16_t*)(ws + WS_Z); bf16_t* oall = (bf16_t*)(ws + WS_OALL);
    const int b = item >> 3, hd = item & 7, r = lane & 31, hh = lane >> 5;
    const int qrow = NTOK_P + 16 * b + (r < 16 ? r : 15);
    const int lo = wave == 0 ? 0 : 9 + 8 * (wave - 1), hi = 9 + 8 * wave;
    AttnOut R;
    attn_wave(R, z, (const bf16_t*)(ws + WS_QR), (const bf16_t*)(ws + WS_KN), (const bf16_t*)(ws + WS_KRA), (const bf16_t*)(ws + WS_VT), qrow, hd, NTOK_P + b * SKEY, lo, hi, 2064, lane);
    LAS float* oW = (LAS float*)lds;
    LAS float* mW = (LAS float*)(lds + LDS_MAIN);
    LAS float* lW = mW + 256;
    const float lt = R.l + __shfl_xor(R.l, 32);
    if (hh == 0) { mW[wave * 32 + r] = R.m; lW[wave * 32 + r] = lt; }
#pragma unroll
    for (int dvb = 0; dvb < 4; ++dvb)
#pragma unroll
        for (int i = 0; i < 16; ++i) oW[(wave * 128 + 32 * dvb + crow(i, hh)) * 32 + r] = R.o[dvb][i];
    __syncthreads();
    for (int e = tid; e < 128 * 16; e += 512) { const int q = e & 15, dv = e >> 4; float M = -1e30f;
#pragma unroll
        for (int w = 0; w < 8; ++w) M = fmaxf(M, mW[w * 32 + q]);
        float L = 0.f, acc = 0.f;
#pragma unroll
        for (int w = 0; w < 8; ++w) { const float f = __builtin_amdgcn_exp2f(mW[w * 32 + q] - M); L += lW[w * 32 + q] * f; acc += oW[(w * 128 + dv) * 32 + q] * f; }
        oall[(size_t)MP * 1024 + (size_t)(NTOK_P + 16 * b + q) * 1024 + hd * 128 + dv] = f2bf(acc / L); }
    __syncthreads();
}

#if RUN_UPTO < 100000
#ifndef DUMP_N
#define DUMP_N 0
#define DUMP_OFF 0
#define DUMP_BF16 0
#endif
#ifdef DUMP_COUNT
DI void debug_dump(const Params& P) {
    if (blockIdx.x != 0) return;
    __shared__ unsigned cnt[4];
    if (threadIdx.x < 4) cnt[threadIdx.x] = (threadIdx.x == 1) ? 0xffffffffu : 0u;
    __syncthreads();
    for (size_t i = threadIdx.x; i < (size_t)DUMP_N; i += 512) { float v = DUMP_BF16 ? bf2f(((const bf16_t*)(P.ws + (size_t)DUMP_OFF))[i]) : ((const float*)(P.ws + (size_t)DUMP_OFF))[i];
        if (!(v == v) || fabsf(v) > 1e30f) { atomicAdd(&cnt[0], 1u); atomicMin(&cnt[1], (unsigned)i); atomicMax(&cnt[2], (unsigned)i); } }
    __syncthreads();
    if (threadIdx.x == 0) P.out[0] = (DUMP_COUNT == 0) ? 1000.f + (float)cnt[0] : (DUMP_COUNT == 1 ? 1000.f + (float)cnt[1] : 1000.f + (float)cnt[2]);
}
#else
DI void debug_dump(const Params& P) {
    const size_t gt = (size_t)blockIdx.x * 512 + threadIdx.x, gs = (size_t)gridDim.x * 512;
    for (size_t i = gt; i < (size_t)DUMP_N; i += gs) { float v = DUMP_BF16 ? bf2f(((const bf16_t*)(P.ws + (size_t)DUMP_OFF))[i]) : ((const float*)(P.ws + (size_t)DUMP_OFF))[i];
#ifdef DUMP_SANITIZE
        if (!(v == v) || fabsf(v) > 1e30f) v = 777.f;
#endif
        P.out[i] = v; }
}
#endif
#else
DI void debug_dump(const Params&) {}
#endif
__global__ void __launch_bounds__(512, 2) hybrid_fwd(Params P) {
    extern __shared__ __attribute__((aligned(16))) unsigned char smem[];
    ldsp_t lds = (ldsp_t)smem;
    const int tid = threadIdx.x;
    if (tid < 4) ((LAS unsigned*)(lds + LDS_XB))[tid] = 0u;
    __syncthreads();
    XcdBarrier bar = xcd_barrier_post((unsigned*)(P.ws + WS_BAR), (volatile LAS unsigned*)(lds + LDS_XB));
    int ph = 0;
#define PHASE_PTRS() unsigned char* ws = wsp(P); float* xb = (float*)(ws + WS_X); bf16_t* hb = (bf16_t*)(ws + WS_H); bf16_t* act = (bf16_t*)(ws + WS_ACT); bf16_t* zb = (bf16_t*)(ws + WS_Z); const float* modl = (const float*)(ws + WS_MOD) + (size_t)l * 10 * MODLD; (void)xb; (void)hb; (void)act; (void)zb; (void)modl
#define SEAM() do { XcdBarrier b_ = bar; { unsigned* q_ = b_.bar; asm volatile("" : "+v"(q_)); b_.bar = q_; } xcd_barrier(b_); if (++ph >= RUN_UPTO) { debug_dump(P); return; } } while (0)

    prologue_phase(P, lds);
    SEAM();
    { constexpr int l = 0;
        norm_phase(P, l, 0, l == 0);
        SEAM();
        { PHASE_PTRS(); EpiSwiglu E{act}; run_gemm(lds, hb, (const bf16_t*)(ws + WS_WFI + (size_t)(l * 2 + 0) * SZ_WFI), MP, 2 * DFF, D, E); }
        SEAM();
        { PHASE_PTRS(); EpiResid E{xb, modl + 2 * D, 0.5f}; run_gemm(lds, act, (const bf16_t*)(ws + WS_WFO + (size_t)(l * 2 + 0) * SZ_WFO), MP, D, DFF, E); }
        SEAM();
        norm_phase(P, l, 1, false);
        SEAM();
        { PHASE_PTRS(); EpiBf16Plain E{zb, ZLD}; run_gemm(lds, hb, (const bf16_t*)(ws + WS_WIN + (size_t)l * SZ_WIN), MP, ZLD, D, E); }
        SEAM();
        prep_phase(P, l);
        SEAM();
        { PHASE_PTRS(); EpiBf16Plain E{(bf16_t*)(ws + WS_KN), 1024}; run_gemm(lds, (const bf16_t*)(ws + WS_LATA), (const bf16_t*)(ws + WS_WKK + (size_t)l * SZ_WKK), KEYS, 1024, 512, E); }
        { PHASE_PTRS(); EpiBf16Plain E{(bf16_t*)(ws + WS_VT), KEYS}; run_gemm(lds, (const bf16_t*)(ws + WS_WKV + (size_t)l * SZ_WKK), (const bf16_t*)(ws + WS_LATA), 1024, KEYS, 512, E); }
        { PHASE_PTRS(); pg8::EpiF32 E{(float*)(ws + WS_LOUT), 3072, nullptr}; run_gemm(lds, (const bf16_t*)(ws + WS_LIN), (const bf16_t*)(ws + WS_WLO + (size_t)l * SZ_WLO), MP, 3072, 256, E); }
        mlstm_pass_a(P, lds, l);
        SEAM();
        { const int G = gridDim.x, nR = G / 2, bx = blockIdx.x;
          if (bx < nR) { for (int it = bx; it < 128; it += nR) rwkv_item(P, lds, l, it >> 6, (it >> 2) & 15, it & 3, true); }
          else { const int bb = bx - nR, nO = G - nR;
              for (int it = bb; it < 512; it += nO) rwkv_item(P, lds, l, it >> 6, (it >> 2) & 15, it & 3, false);
              for (int it = bb; it < 256; it += nO) attn_prompt_item(P, it);
              for (int it = bb; it < 64; it += nO) attn_sample_item(P, lds, it);
              mlstm_pass_b(P, l, bb * 512 + vtid(), nO * 512); } }
        SEAM();
        mlstm_pass_c(P, lds, l);
        rwkv_post(P, l);
        SEAM();
        for (int n = 0; n < 3; ++n) { PHASE_PTRS(); EpiBranch E{zb + ZG + n * D, INP(I_BM) + (size_t)l * 3 * D + n * D, (float*)(ws + WS_ACT), (bf16_t*)(ws + WS_MIX), n};
            run_gemm(lds, (const bf16_t*)(ws + WS_OALL) + (size_t)n * MP * 1024, (const bf16_t*)(ws + WS_WBR + (size_t)(l * 3 + n) * SZ_WBR), MP, D, 1024, E); }
        SEAM();
        { PHASE_PTRS(); EpiResid E{xb, modl + 5 * D, 1.0f}; run_gemm(lds, (const bf16_t*)(ws + WS_MIX), (const bf16_t*)(ws + WS_WO + (size_t)l * SZ_WO), MP, D, D, E); }
        SEAM();
        norm_phase(P, l, 2, false);
        SEAM();
        { PHASE_PTRS(); EpiSwiglu E{act}; run_gemm(lds, hb, (const bf16_t*)(ws + WS_WFI + (size_t)(l * 2 + 1) * SZ_WFI), MP, 2 * DFF, D, E); }
        SEAM();
        { PHASE_PTRS(); EpiResid E{xb, modl + 8 * D, 0.5f}; run_gemm(lds, act, (const bf16_t*)(ws + WS_WFO + (size_t)(l * 2 + 1) * SZ_WFO), MP, D, DFF, E); }
        SEAM();
    }
    { constexpr int l = 1;
        norm_phase(P, l, 0, l == 0);
        SEAM();
        { PHASE_PTRS(); EpiSwiglu E{act}; run_gemm(lds, hb, (const bf16_t*)(ws + WS_WFI + (size_t)(l * 2 + 0) * SZ_WFI), MP, 2 * DFF, D, E); }
        SEAM();
        { PHASE_PTRS(); EpiResid E{xb, modl + 2 * D, 0.5f}; run_gemm(lds, act, (const bf16_t*)(ws + WS_WFO + (size_t)(l * 2 + 0) * SZ_WFO), MP, D, DFF, E); }
        SEAM();
        norm_phase(P, l, 1, false);
        SEAM();
        { PHASE_PTRS(); EpiBf16Plain E{zb, ZLD}; run_gemm(lds, hb, (const bf16_t*)(ws + WS_WIN + (size_t)l * SZ_WIN), MP, ZLD, D, E); }
        SEAM();
        prep_phase(P, l);
        SEAM();
        { PHASE_PTRS(); EpiBf16Plain E{(bf16_t*)(ws + WS_KN), 1024}; run_gemm(lds, (const bf16_t*)(ws + WS_LATA), (const bf16_t*)(ws + WS_WKK + (size_t)l * SZ_WKK), KEYS, 1024, 512, E); }
        { PHASE_PTRS(); EpiBf16Plain E{(bf16_t*)(ws + WS_VT), KEYS}; run_gemm(lds, (const bf16_t*)(ws + WS_WKV + (size_t)l * SZ_WKK), (const bf16_t*)(ws + WS_LATA), 1024, KEYS, 512, E); }
        { PHASE_PTRS(); pg8::EpiF32 E{(float*)(ws + WS_LOUT), 3072, nullptr}; run_gemm(lds, (const bf16_t*)(ws + WS_LIN), (const bf16_t*)(ws + WS_WLO + (size_t)l * SZ_WLO), MP, 3072, 256, E); }
        mlstm_pass_a(P, lds, l);
        SEAM();
        { const int G = gridDim.x, nR = G / 2, bx = blockIdx.x;
          if (bx < nR) { for (int it = bx; it < 128; it += nR) rwkv_item(P, lds, l, it >> 6, (it >> 2) & 15, it & 3, true); }
          else { const int bb = bx - nR, nO = G - nR;
              for (int it = bb; it < 512; it += nO) rwkv_item(P, lds, l, it >> 6, (it >> 2) & 15, it & 3, false);
              for (int it = bb; it < 256; it += nO) attn_prompt_item(P, it);
              for (int it = bb; it < 64; it += nO) attn_sample_item(P, lds, it);
              mlstm_pass_b(P, l, bb * 512 + vtid(), nO * 512); } }
        SEAM();
        mlstm_pass_c(P, lds, l);
        rwkv_post(P, l);
        SEAM();
        for (int n = 0; n < 3; ++n) { PHASE_PTRS(); EpiBranch E{zb + ZG + n * D, INP(I_BM) + (size_t)l * 3 * D + n * D, (float*)(ws + WS_ACT), (bf16_t*)(ws + WS_MIX), n};
            run_gemm(lds, (const bf16_t*)(ws + WS_OALL) + (size_t)n * MP * 1024, (const bf16_t*)(ws + WS_WBR + (size_t)(l * 3 + n) * SZ_WBR), MP, D, 1024, E); }
        SEAM();
        { PHASE_PTRS(); EpiResid E{xb, modl + 5 * D, 1.0f}; run_gemm(lds, (const bf16_t*)(ws + WS_MIX), (const bf16_t*)(ws + WS_WO + (size_t)l * SZ_WO), MP, D, D, E); }
        SEAM();
        norm_phase(P, l, 2, false);
        SEAM();
        { PHASE_PTRS(); EpiSwiglu E{act}; run_gemm(lds, hb, (const bf16_t*)(ws + WS_WFI + (size_t)(l * 2 + 1) * SZ_WFI), MP, 2 * DFF, D, E); }
        SEAM();
        { PHASE_PTRS(); EpiResid E{xb, modl + 8 * D, 0.5f}; run_gemm(lds, act, (const bf16_t*)(ws + WS_WFO + (size_t)(l * 2 + 1) * SZ_WFO), MP, D, DFF, E); }
        SEAM();
    }
    final_phase(P);
}

extern "C" void kernel_launch(void* const* d_in, const int* in_sizes, int n_in, void* d_out, int out_size, void* d_ws, size_t ws_size, hipStream_t stream) {
    static int grid = 0;
    if (grid == 0) {
        if (n_in != 37 || (size_t)out_size != O_END || ws_size < WS_END) { fprintf(stderr, "kernel_launch: unexpected shapes: n_in %d out %d ws %zu (need %zu)\n", n_in, out_size, ws_size, (size_t)WS_END); grid = -1; return; }
        int dev = 0, cus = 0;
        if (hipGetDevice(&dev) != hipSuccess || hipDeviceGetAttribute(&cus, hipDeviceAttributeMultiprocessorCount, dev) != hipSuccess) { grid = -1; return; }
        if (hipFuncSetAttribute((const void*)hybrid_fwd, hipFuncAttributeMaxDynamicSharedMemorySize, LDS_BYTES) != hipSuccess) { fprintf(stderr, "kernel_launch: hipFuncSetAttribute failed\n"); grid = -1; return; }
        int per_cu = 0;
        if (hipOccupancyMaxActiveBlocksPerMultiprocessor(&per_cu, (const void*)hybrid_fwd, 512, LDS_BYTES) != hipSuccess || per_cu < 1) { fprintf(stderr, "kernel_launch: occupancy query says %d\n", per_cu); }
        (void)hipGetLastError();
        grid = cus;
    }
    if (grid < 0) return;
    hipMemsetAsync((char*)d_ws + WS_BAR, 0, 16384, stream);
    Params p{};
    for (int i = 0; i < 37; ++i) p.in[i] = (const float*)d_in[i];
    p.out = (float*)d_out; p.ws = (unsigned char*)d_ws;
    hipLaunchKernelGGL(hybrid_fwd, dim3(grid), dim3(512), LDS_BYTES, stream, p);
}
```

```cpp
#include <hip/hip_runtime.h>
#include <stdint.h>
#include <stdio.h>

#define DI __device__ __forceinline__
#define LAS __attribute__((address_space(3)))
typedef LAS unsigned char* ldsp_t;
typedef unsigned short bf16_t;
typedef short bf16x8 __attribute__((ext_vector_type(8)));
typedef short s16x4 __attribute__((ext_vector_type(4)));
typedef float f32x4 __attribute__((ext_vector_type(4)));
typedef float f32x2 __attribute__((ext_vector_type(2)));
typedef float f32x16 __attribute__((ext_vector_type(16)));
typedef unsigned u32x4 __attribute__((ext_vector_type(4)));
typedef unsigned u32x2 __attribute__((ext_vector_type(2)));
typedef __bf16 bfv2 __attribute__((ext_vector_type(2)));

constexpr int D = 2048, DFF = 5632, NTOK_P = 8192, NTOK = 8320, MP = 8448, NLAYER = 2;
constexpr int ZLD = 14848, INCOLS = 14664;
constexpr int ZQM = 0, ZKM = 512, ZVM = 1024, ZOM = 2048, ZIG = 3072, ZFG = 3076;
constexpr int ZQA = 3080, ZLAT = 4616, ZKR = 5128;
constexpr int ZR = 5192, ZRK = 6216, ZRV = 7240, ZWD = 8264;
constexpr int ZG = 8520;
constexpr int SKEY = 2112, KEYS = 8192 + 8 * SKEY;
constexpr int MODLD = 18432;
constexpr int ML_ITEMS = 544, ML_CSZ = 288 * 128;

constexpr size_t O_YP = 0, O_YS = O_YP + 16777216, O_PLAT = O_YS + 262144, O_PKR = O_PLAT + 8388608, O_PC = O_PKR + 1048576, O_PN = O_PC + 524288,
                 O_PM = O_PN + 2048, O_PS = O_PM + 16, O_PSH = O_PS + 262144, O_SLAT = O_PSH + 13312, O_SKR = O_SLAT + 131072, O_SC = O_SKR + 16384,
                 O_SN = O_SC + 2097152, O_SM = O_SN + 8192, O_SS = O_SM + 64, O_SSH = O_SS + 1048576, O_END = O_SSH + 53248;

constexpr size_t al256(size_t x) { return (x + 255) & ~(size_t)255; }
constexpr size_t WS_BAR = 0;
constexpr size_t WS_MOD = WS_BAR + 16384;
constexpr size_t WS_ROPE = WS_MOD + al256((size_t)NLAYER * 10 * MODLD * 4);
constexpr size_t WS_WFI = WS_ROPE + (size_t)4096 * 32 * 8;
constexpr size_t SZ_WFI = (size_t)2 * DFF * D * 2;
constexpr size_t WS_WFO = WS_WFI + 4 * SZ_WFI;
constexpr size_t SZ_WFO = (size_t)D * DFF * 2;
constexpr size_t WS_WIN = WS_WFO + 4 * SZ_WFO;
constexpr size_t SZ_WIN = (size_t)ZLD * D * 2;
constexpr size_t WS_WKK = WS_WIN + 2 * SZ_WIN;
constexpr size_t SZ_WKK = (size_t)1024 * 512 * 2;
constexpr size_t WS_WKV = WS_WKK + 2 * SZ_WKK;
constexpr size_t WS_WLO = WS_WKV + 2 * SZ_WKK;
constexpr size_t SZ_WLO = (size_t)3072 * 256 * 2;
constexpr size_t WS_WBR = WS_WLO + 2 * SZ_WLO;
constexpr size_t SZ_WBR = (size_t)D * 1024 * 2;
constexpr size_t WS_WO = WS_WBR + 6 * SZ_WBR;
constexpr size_t SZ_WO = (size_t)D * D * 2;
constexpr size_t WS_X = WS_WO + 2 * SZ_WO;
constexpr size_t WS_H = WS_X + (size_t)MP * D * 4;
constexpr size_t WS_ACT = WS_H + (size_t)MP * D * 2;
constexpr size_t WS_Z = WS_ACT + (size_t)MP * DFF * 2;
constexpr size_t WS_QR = WS_Z + (size_t)MP * ZLD * 2;
constexpr size_t WS_LATA = WS_QR + (size_t)MP * 512 * 2;
constexpr size_t WS_KRA = WS_LATA + (size_t)KEYS * 512 * 2;
constexpr size_t WS_KN = WS_KRA + (size_t)KEYS * 64 * 2;
constexpr size_t WS_VT = WS_KN + (size_t)KEYS * 1024 * 2;
constexpr size_t WS_LIN = WS_VT + (size_t)KEYS * 1024 * 2;
constexpr size_t WS_LOUT = WS_LIN + (size_t)MP * 256 * 2;
constexpr size_t WS_OALL = WS_LOUT + (size_t)MP * 3072 * 4;
constexpr size_t WS_MIX = WS_OALL + (size_t)MP * 3072 * 2;
constexpr size_t WS_YB = WS_MIX + (size_t)MP * D * 2;
constexpr size_t WS_RK = WS_YB + (size_t)MP * 1024 * 4;
constexpr size_t WS_NUML = WS_RK + (size_t)MP * 16 * 4;
constexpr size_t WS_DENL = WS_NUML + (size_t)ML_ITEMS * 16 * 1024 * 4;
constexpr size_t WS_MLG = WS_DENL + (size_t)NTOK * 4 * 4;
constexpr size_t WS_DC = WS_MLG + (size_t)NTOK * 8 * 4;
constexpr size_t WS_MLI = WS_DC + (size_t)ML_ITEMS * ML_CSZ * 4;
constexpr size_t WS_VV = WS_MLI + al256((size_t)ML_ITEMS * 4 * 4);
constexpr size_t WS_END = WS_VV + (size_t)MP * 1024 * 4;
constexpr size_t WS_VR = WS_ACT, WS_VK = WS_ACT + (size_t)MP * 1024 * 4, WS_VA = WS_H, WS_VB = WS_MIX, WS_CD = WS_LIN;

constexpr int LDS_MAIN = 131072, LDS_XB = LDS_MAIN + 2048, LDS_BYTES = LDS_MAIN + 2048 + 256;

struct Params { const float* in[37]; float* out; unsigned char* ws; };
enum { I_XP = 0, I_XS, I_CP, I_CS, I_CLAT, I_CKR, I_MLC, I_MLN, I_MLM, I_RWS, I_RWSH, I_ADAW, I_ADAB, I_NORMG, I_FWI, I_FWO, I_WIN, I_MLIB, I_MLFB, I_MLHG,
       I_KVG, I_WKVB, I_MU, I_W0, I_W2, I_A0, I_A2, I_G2, I_KK, I_KA, I_RK, I_LNG, I_LNB, I_WBR, I_BM, I_WOUT, I_FNG };

DI int vtid() { int t = threadIdx.x; asm volatile("" : "+v"(t)); return t; }
DI int sbid() { int b = blockIdx.x; asm volatile("" : "+s"(b)); return b; }
DI int opq(int x) { asm volatile("" : "+s"(x)); return x; }
#define INP(i) (P.in[opq(i)])
DI unsigned char* relaunder(const void* p) { unsigned lo = (unsigned)(size_t)p, hi = (unsigned)((size_t)p >> 32); asm volatile("" : "+v"(lo), "+v"(hi));
    lo = __builtin_amdgcn_readfirstlane(lo); hi = __builtin_amdgcn_readfirstlane(hi); return (unsigned char*)(((size_t)hi << 32) | lo); }
DI unsigned char* wsp(const Params& P) { return relaunder(P.ws); }
DI float* outp(const Params& P) { return (float*)relaunder(P.out); }
DI float bf2f(bf16_t b) { return __uint_as_float(((unsigned)b) << 16); }
DI unsigned pack2(float lo, float hi) { f32x2 v = {lo, hi}; return __builtin_bit_cast(unsigned, __builtin_convertvector(v, bfv2)); }
DI bf16_t f2bf(float f) { return (bf16_t)(pack2(f, 0.f) & 0xffffu); }
DI float lo16(unsigned w) { return __uint_as_float(w << 16); }
DI float hi16(unsigned w) { return __uint_as_float(w & 0xffff0000u); }
DI float wave_sum(float v) { for (int o = 32; o >= 1; o >>= 1) v += __shfl_xor(v, o); return v; }
DI float sigmoidf_(float x) { return __builtin_amdgcn_rcpf(1.0f + __expf(-x)); }
DI float siluf_(float x) { return x * __builtin_amdgcn_rcpf(1.0f + __expf(-x)); }
DI float softcap15(float x) { return 15.0f * tanhf(x * (1.0f / 15.0f)); }
DI float logsigmoidf_(float x) { return fminf(x, 0.f) - log1pf(__expf(-fabsf(x))); }
DI int row_stream(int row) { return row < NTOK_P ? (row >> 12) : 2 + ((row - NTOK_P) >> 4); }
template <int CTRL> DI float dppf(float v) { return __builtin_bit_cast(float, __builtin_amdgcn_update_dpp(0, __builtin_bit_cast(int, v), CTRL, 0xF, 0xF, true)); }
DI float row16_sum(float v) { v += dppf<0xB1>(v); v += dppf<0x4E>(v); v += dppf<0x141>(v); v += dppf<0x140>(v); return v; }
DI int crow(int i, int hh) { return (i & 3) + 8 * (i >> 2) + 4 * hh; }
#define MFMA32(a, b, c) __builtin_amdgcn_mfma_f32_32x32x16_bf16((a), (b), (c), 0, 0, 0)


namespace pg8 {
#define PG8_LAS __attribute__((address_space(3)))
typedef unsigned short bf16_t;
typedef short bf16x8 __attribute__((ext_vector_type(8)));
typedef float f32x4 __attribute__((ext_vector_type(4)));
typedef unsigned u32x4 __attribute__((ext_vector_type(4)));
constexpr int BM = 256, BK = 64, HALF = 128, HTB = HALF * BK * 2  , STAGE_BYTES = 8 * HTB, NXCD = 8, WGM = 8;

__host__ __device__ __forceinline__ int lds_byte(int r, int c) { const int st = (r >> 4) * 2 + (c >> 5), rr = r & 15, cc = c & 31, ob = rr * 64 + cc * 2; return st * 1024 + (ob ^ (((ob >> 9) & 1) << 5)); }
__host__ __device__ __forceinline__ void stage_rc(int b, int& R, int& C) { const int st = b / 1024, sb = b % 1024, swz = sb ^ (((sb >> 9) & 1) << 5); R = (st >> 1) * 16 + swz / 64; C = (st & 1) * 32 + (swz % 64) / 2; }
__host__ __device__ __forceinline__ int perm32(int rho) { const int n = rho >> 4, i = rho & 15; return 8 * (i >> 2) + 4 * n + (i & 3); }

struct Unit { int pm, pn; };
struct Gemm { const bf16_t* A; const bf16_t* Bt; int M, N, K; int lda, ldb; long tsA, tsB, ksB; };

struct StaticOrder {
    int nM, nN, nwg, G, c;
    __host__ __device__ void init(int M, int N, int G_, int c_) { nM = M / BM; nN = N / BM; nwg = nM * nN; G = G_; c = c_; }
    __host__ __device__ bool next(int i, Unit& u) const {
        const long L = (long)i * G + c; if (L >= nwg) return false;
        int wgid = (int)L; { const int q = nwg / NXCD, r = nwg % NXCD, xcd = wgid % NXCD, off = wgid / NXCD; wgid = (xcd < r ? xcd * (q + 1) : r * (q + 1) + (xcd - r) * q) + off; }
        const int nig = WGM * nN, gid = wgid / nig, fm = gid * WGM, gsz = (nM - fm) < WGM ? (nM - fm) : WGM;
        u.pm = fm + ((wgid % nig) % gsz); u.pn = (wgid % nig) / gsz; return true;
    }
    __device__ __forceinline__ void a_ready(const Unit&) const {}
    __device__ __forceinline__ void done(const Unit&) const {}
};
__device__ __forceinline__ unsigned cvt_pk_bf16(float lo, float hi) { unsigned r; asm volatile("v_cvt_pk_bf16_f32 %0, %1, %2" : "=v"(r) : "v"(lo), "v"(hi)); return r; }
typedef float f32x2 __attribute__((ext_vector_type(2)));
__device__ __forceinline__ f32x2 gelu_pk(f32x2 v) {
    const f32x2 av = __builtin_elementwise_abs(v), d = av * 0.2316418882f + 1.0f;
    f32x2 t; t.x = __builtin_amdgcn_rcpf(d.x); t.y = __builtin_amdgcn_rcpf(d.y);
    f32x2 q = t * 0.5307027145f + (-0.7265760135f); q = q * t + 0.7107068705f; q = q * t + (-0.142248368f); q = q * t + 0.127414796f; q = q * t;
    const f32x2 s = (v * v) * (-0.72134752044f);
    f32x2 e; e.x = __builtin_amdgcn_exp2f(s.x); e.y = __builtin_amdgcn_exp2f(s.y);
    const f32x2 m = v * (q * e), r = v - m;
    f32x2 o; o.x = v.x < 0.f ? m.x : r.x; o.y = v.y < 0.f ? m.y : r.y; return o;
}

struct EpiF32 {
    static constexpr bool PERM = false, AFTER_DRAIN = false;
    float* C; int ldc; const float* bias;
    __device__ __forceinline__ void operator()(const f32x4 (&acc)[2][2][4][2], const Unit& u, int wr, int wc, int fr, int fq) const {
        const int row0 = u.pm * BM + wr * 64 + fr, col0 = u.pn * BM + wc * 32 + 4 * fq;
        f32x4 bv[2][2];
#pragma unroll
        for (int bj = 0; bj < 2; ++bj)
#pragma unroll
            for (int n = 0; n < 2; ++n) bv[bj][n] = bias ? *(const f32x4*)(bias + col0 + bj * HALF + n * 16) : (f32x4){0.f, 0.f, 0.f, 0.f};
#pragma unroll
        for (int ai = 0; ai < 2; ++ai)
#pragma unroll
            for (int m = 0; m < 4; ++m) { float* rowp = C + (size_t)(row0 + ai * HALF + m * 16) * ldc + col0;
#pragma unroll
                for (int bj = 0; bj < 2; ++bj)
#pragma unroll
                    for (int n = 0; n < 2; ++n) *(f32x4*)(rowp + bj * HALF + n * 16) = acc[ai][bj][m][n] + bv[bj][n]; }
    }
};
template <int ACT  > struct EpiBf16 {
    static constexpr bool PERM = true, AFTER_DRAIN = false;
    bf16_t* O; int ldc; const float* bias; int split_cols; size_t split_stride;
    __device__ __forceinline__ void operator()(const f32x4 (&acc)[2][2][4][2], const Unit& u, int wr, int wc, int fr, int fq) const {
        const int row0 = u.pm * BM + wr * 64 + fr; int colt = u.pn * BM; bf16_t* base = O;
        if (split_cols) { const int t = colt / split_cols; base += (size_t)t * split_stride; colt -= t * split_cols; }
        const int col0 = colt + wc * 32 + 8 * fq, bcol0 = u.pn * BM + wc * 32 + 8 * fq;
        f32x4 bv[2][2];
#pragma unroll
        for (int bj = 0; bj < 2; ++bj)
#pragma unroll
            for (int n = 0; n < 2; ++n) bv[bj][n] = bias ? *(const f32x4*)(bias + bcol0 + bj * HALF + 4 * n) : (f32x4){0.f, 0.f, 0.f, 0.f};
#pragma unroll
        for (int ai = 0; ai < 2; ++ai)
#pragma unroll
            for (int m = 0; m < 4; ++m) { bf16_t* rowp = base + (size_t)(row0 + ai * HALF + m * 16) * ldc + col0;
#pragma unroll
                for (int bj = 0; bj < 2; ++bj) { f32x4 v0 = acc[ai][bj][m][0] + bv[bj][0], v1 = acc[ai][bj][m][1] + bv[bj][1];
                    if (ACT == 1) { f32x2 a = gelu_pk((f32x2){v0[0], v0[1]}), b = gelu_pk((f32x2){v0[2], v0[3]}), c = gelu_pk((f32x2){v1[0], v1[1]}), d = gelu_pk((f32x2){v1[2], v1[3]});
                        v0 = (f32x4){a.x, a.y, b.x, b.y}; v1 = (f32x4){c.x, c.y, d.x, d.y}; }
                    if (ACT == 2) {
#pragma unroll
                        for (int j = 0; j < 4; ++j) { v0[j] = 0.5f * v0[j] * (1.0f + erff(v0[j] * 0.70710678f)); v1[j] = 0.5f * v1[j] * (1.0f + erff(v1[j] * 0.70710678f)); } }
                    u32x4 w; w.x = cvt_pk_bf16(v0[0], v0[1]); w.y = cvt_pk_bf16(v0[2], v0[3]); w.z = cvt_pk_bf16(v1[0], v1[1]); w.w = cvt_pk_bf16(v1[2], v1[3]);
                    *(u32x4*)(rowp + bj * HALF) = w; } }
    }
};

template <class Epi, class Sched, bool STAMP = false>
__device__ __forceinline__ void gemm_phase(PG8_LAS unsigned char* lds, const Gemm g, const Sched& S, const Epi& E, unsigned long long* stamps) {
    const int tid = vtid(), wid = __builtin_amdgcn_readfirstlane(tid >> 6), lane = tid & 63, wr = wid >> 2, wc = wid & 3, fr = lane & 15, fq = lane >> 4;
    const int K = g.K, nt = K / BK;
    int ts_lo = 0, ts_hi = 0, nts = 0; const unsigned long long rt_entry = STAMP ? (unsigned long long)wall_clock64() : 0ull;
#define PG8_STAMP() do { if (STAMP && wid == 0 && nts < 64) { const unsigned long long _c = (unsigned long long)clock64(); \
        ts_lo = (lane == nts) ? (int)(unsigned)_c : ts_lo; ts_hi = (lane == nts) ? (int)(unsigned)(_c >> 32) : ts_hi; ++nts; } } while (0)
    PG8_STAMP();
    unsigned voffA[2], voffB[2];
#pragma unroll
    for (int i = 0; i < 2; ++i) { int R, C; stage_rc(tid * 16 + i * 8192, R, C); const int Rb = Epi::PERM ? ((R & ~31) + perm32(R & 31)) : R;
        voffA[i] = (unsigned)(R * g.lda + C) * 2u; voffB[i] = (unsigned)(Rb * g.ldb + C) * 2u; }
    const size_t kstep = (size_t)(BK * 2);
    const size_t hstepA = (size_t)HALF * g.lda * 2, hstepB = (size_t)HALF * g.ldb * 2;
    const unsigned ldsw = (unsigned)wid * 1024u;
    const int aoff = lds_byte(wr * 64 + fr, fq * 8), boff = lds_byte(wc * 32 + fr, fq * 8);
#define PG8_SA(b, h) (((b) * 2 + (h)) * HTB)
#define PG8_SB(b, h) ((4 + (b) * 2 + (h)) * HTB)
#define PG8_STAGE(bufoff, gbase, voff) do { _Pragma("unroll") for (int _i = 0; _i < 2; ++_i) \
        __builtin_amdgcn_global_load_lds((const unsigned*)((const char*)(gbase) + (voff)[_i]), (PG8_LAS unsigned*)(lds + (bufoff) + ldsw + _i * 8192), 16, 0, 0); } while (0)
#define PG8_LDA(dst, b, h) do { _Pragma("unroll") for (int m = 0; m < 4; ++m) _Pragma("unroll") for (int k = 0; k < 2; ++k) dst[m][k] = *(const PG8_LAS bf16x8*)(lds + PG8_SA(b, h) + aoff + m * 2048 + k * 1024); } while (0)
#define PG8_LDB(dst, b, h) do { _Pragma("unroll") for (int n = 0; n < 2; ++n) _Pragma("unroll") for (int k = 0; k < 2; ++k) dst[n][k] = *(const PG8_LAS bf16x8*)(lds + PG8_SB(b, h) + boff + n * 2048 + k * 1024); } while (0)
#define PG8_MMA(ai, bj, At, Bt) do { __builtin_amdgcn_s_setprio(1); _Pragma("unroll") for (int m = 0; m < 4; ++m) _Pragma("unroll") for (int n = 0; n < 2; ++n) _Pragma("unroll") for (int k = 0; k < 2; ++k) \
        acc[ai][bj][m][n] = __builtin_amdgcn_mfma_f32_16x16x32_bf16(Bt[n][k], At[m][k], acc[ai][bj][m][n], 0, 0, 0); __builtin_amdgcn_s_setprio(0); } while (0)
#define PG8_WAIT_V(n) asm volatile("s_waitcnt vmcnt(" #n ")" ::: "memory")
#define PG8_WAIT_L(n) asm volatile("s_waitcnt lgkmcnt(" #n ")" ::: "memory")
#define PG8_BAR __builtin_amdgcn_s_barrier()
#define PG8_SCHED __builtin_amdgcn_sched_barrier(0)
    Unit cur, nxt; int ui = 0;
    if (!S.next(0, cur)) return;
    f32x4 acc[2][2][4][2];
#pragma unroll
    for (int a = 0; a < 2; ++a)
#pragma unroll
        for (int b = 0; b < 2; ++b)
#pragma unroll
            for (int m = 0; m < 4; ++m)
#pragma unroll
                for (int n = 0; n < 2; ++n) acc[a][b][m][n] = (f32x4){0.f, 0.f, 0.f, 0.f};
    bf16x8 At[4][2], B0[2][2], B1[2][2];
    const char* cA = (const char*)g.A + (size_t)cur.pm * g.tsA; const char* cB = (const char*)g.Bt + (size_t)cur.pn * g.tsB + (size_t)cur.pm * g.ksB;
    S.a_ready(cur);
    PG8_STAGE(PG8_SB(0, 0), cB, voffB); PG8_STAGE(PG8_SA(0, 0), cA, voffA); PG8_STAGE(PG8_SB(0, 1), cB + hstepB, voffB); PG8_STAGE(PG8_SA(0, 1), cA + hstepA, voffA);
    if (wr == 1) PG8_BAR;
    PG8_WAIT_V(4); PG8_BAR;
    PG8_STAGE(PG8_SB(1, 0), cB + kstep, voffB); PG8_STAGE(PG8_SA(1, 0), cA + kstep, voffA); PG8_STAGE(PG8_SB(1, 1), cB + hstepB + kstep, voffB);
    PG8_WAIT_V(6); PG8_BAR;
    PG8_STAMP();
    for (;;) {
        const bool has_next = S.next(ui + 1, nxt);
        const char* nA = has_next ? (const char*)g.A + (size_t)nxt.pm * g.tsA : cA; const char* nB = has_next ? (const char*)g.Bt + (size_t)nxt.pn * g.tsB + (size_t)nxt.pm * g.ksB : cB;
        for (int t = 0; t < nt; t += 2) {
            const bool last = (t == nt - 2);
            const char* a1 = cA + (size_t)(t + 1) * kstep;
            const char* a2 = last ? nA : cA + (size_t)(t + 2) * kstep; const char* b2 = last ? nB : cB + (size_t)(t + 2) * kstep;
            const char* a3 = a2 + kstep; const char* b3 = b2 + kstep;
            if (last && has_next) S.a_ready(nxt);
            PG8_LDB(B0, 0, 0); PG8_SCHED; PG8_LDA(At, 0, 0); PG8_STAGE(PG8_SA(1, 1), a1 + hstepA, voffA);
            PG8_WAIT_L(8); PG8_BAR; PG8_WAIT_L(0); PG8_MMA(0, 0, At, B0); PG8_BAR; PG8_SCHED;
            PG8_LDB(B1, 0, 1); PG8_STAGE(PG8_SB(0, 0), b2, voffB);
            PG8_BAR; PG8_WAIT_L(0); PG8_MMA(0, 1, At, B1); PG8_BAR;
            PG8_LDA(At, 0, 1); PG8_STAGE(PG8_SA(0, 0), a2, voffA);
            PG8_BAR; PG8_WAIT_L(0); PG8_MMA(1, 0, At, B0); PG8_BAR; PG8_SCHED;
            PG8_STAGE(PG8_SB(0, 1), b2 + hstepB, voffB);
            PG8_WAIT_V(6); PG8_BAR; PG8_MMA(1, 1, At, B1); PG8_BAR;
            PG8_LDB(B0, 1, 0); PG8_SCHED; PG8_LDA(At, 1, 0); PG8_STAGE(PG8_SA(0, 1), a2 + hstepA, voffA);
            PG8_WAIT_L(8); PG8_BAR; PG8_WAIT_L(0); PG8_MMA(0, 0, At, B0); PG8_BAR; PG8_SCHED;
            PG8_LDB(B1, 1, 1); PG8_STAGE(PG8_SB(1, 0), b3, voffB);
            PG8_BAR; PG8_WAIT_L(0); PG8_MMA(0, 1, At, B1); PG8_BAR;
            PG8_LDA(At, 1, 1); PG8_STAGE(PG8_SA(1, 0), a3, voffA);
            PG8_BAR; PG8_WAIT_L(0); PG8_MMA(1, 0, At, B0); PG8_BAR; PG8_SCHED;
            PG8_STAGE(PG8_SB(1, 1), b3 + hstepB, voffB);
            PG8_WAIT_V(6); PG8_BAR; PG8_MMA(1, 1, At, B1); PG8_BAR;
        }
        PG8_STAMP();
        if constexpr (!Epi::AFTER_DRAIN) { E(acc, cur, wr, wc, fr, fq); S.done(cur); }
        PG8_STAMP();
        if (!has_next) break;
#pragma unroll
        for (int a = 0; a < 2; ++a)
#pragma unroll
            for (int b = 0; b < 2; ++b)
#pragma unroll
                for (int m = 0; m < 4; ++m)
#pragma unroll
                    for (int n = 0; n < 2; ++n) acc[a][b][m][n] = (f32x4){0.f, 0.f, 0.f, 0.f};
        cur = nxt; cA = nA; cB = nB; ++ui;
    }
    PG8_WAIT_V(0);
    if (wr == 0) PG8_BAR;
    PG8_BAR;
    if constexpr (Epi::AFTER_DRAIN) { E.fused(acc, cur, wr, wc, fr, fq, lds, wid, lane); S.done(cur); }
    PG8_STAMP();
    if (STAMP && wid == 0) { stamps[lane] = lane < nts ? (((unsigned long long)(unsigned)ts_hi << 32) | (unsigned)ts_lo) : 0ull;
        if (lane == 62) stamps[62] = rt_entry; if (lane == 63) stamps[63] = (unsigned long long)wall_clock64(); }
#undef PG8_STAMP
#undef PG8_SA
#undef PG8_SB
#undef PG8_STAGE
#undef PG8_LDA
#undef PG8_LDB
#undef PG8_MMA
#undef PG8_WAIT_V
#undef PG8_WAIT_L
#undef PG8_BAR
#undef PG8_SCHED
}
}

#define XB_TMO      128
#define XB_XCNT(j)  (256  + 64 * (j))
#define XB_XSUB(j)  (1280 + 64 * (j))
#define XB_XGEN(j)  (2304 + 64 * (j))
#define XB_TOP      3328
#define XB_TOPGEN   3392
#define XCD_BAR_WORDS 3456
#define XB_SPIN_CAP (1u << 18)

__device__ __forceinline__ unsigned xb_ld(unsigned* p)              { return __hip_atomic_load(p, __ATOMIC_RELAXED, __HIP_MEMORY_SCOPE_AGENT); }
__device__ __forceinline__ unsigned xb_add(unsigned* p, unsigned v) { return __hip_atomic_fetch_add(p, v, __ATOMIC_RELAXED, __HIP_MEMORY_SCOPE_AGENT); }
__device__ __forceinline__ unsigned xb_xcc_id() { return (unsigned)__builtin_amdgcn_s_getreg((3 << 11) | 20) & 0xFu; }
#define XB_SPIN(cond, bar) do { unsigned _sp = 0; while (cond) { __builtin_amdgcn_s_sleep(1); \
    if ((++_sp & 255u) == 0u) { if (xb_ld(&(bar)[XB_TMO])) break; if (_sp > XB_SPIN_CAP) { atomicAdd(&(bar)[XB_TMO], 1u); break; } } } } while (0)

struct XcdBarrier {
    unsigned* bar; unsigned x;
    volatile LAS unsigned* st;
};

__device__ __forceinline__ XcdBarrier xcd_barrier_post(unsigned* bar, volatile LAS unsigned* st) {
    XcdBarrier b; b.bar = bar; b.x = xb_xcc_id(); b.st = st;
    if (threadIdx.x == 0) (void)xb_add(&bar[XB_XCNT(b.x)], 1u);
    return b;
}
__device__ __forceinline__ void xcd_barrier_complete(unsigned* bar, unsigned x, unsigned& nloc, unsigned& nx) {
    const unsigned G = gridDim.x * gridDim.y * gridDim.z;
    unsigned sum, cnt, mine, sp = 0u;
    for (;;) {
        sum = 0u; cnt = 0u; mine = 0u;
#pragma unroll
        for (unsigned j = 0; j < 16; ++j) { const unsigned c = xb_ld(&bar[XB_XCNT(j)]); sum += c; cnt += (c > 0u) ? 1u : 0u; mine = (j == x) ? c : mine; }
        if (sum == G) break;
        __builtin_amdgcn_s_sleep(1);
        if ((++sp & 255u) == 0u) { if (xb_ld(&bar[XB_TMO])) break; if (sp > XB_SPIN_CAP) { atomicAdd(&bar[XB_TMO], 1u); break; } }
    }
    nloc = mine > 0u ? mine : 1u; nx = cnt > 0u ? cnt : 1u;
}

__device__ __forceinline__ void xcd_barrier(const XcdBarrier& b) {
    asm volatile("s_waitcnt vmcnt(0)" ::: "memory");
    __syncthreads();
    if (threadIdx.x == 0) {
        unsigned* bar = b.bar;
        __builtin_amdgcn_s_waitcnt(0);
        unsigned nloc = b.st[0], nx = b.st[1];
        if (nloc == 0u) { xcd_barrier_complete(bar, b.x, nloc, nx); b.st[0] = nloc; b.st[1] = nx; }
        const unsigned old = xb_add(&bar[XB_XSUB(b.x)], 1u);
        const unsigned gen = old / nloc;
        if (old + 1u == (gen + 1u) * nloc) {
            __builtin_amdgcn_fence(__ATOMIC_RELEASE, "agent");
            asm volatile("s_waitcnt vmcnt(0)" ::: "memory");
            const unsigned og = xb_add(&bar[XB_TOP], 1u);
            const unsigned tg = og / nx;
            if (og + 1u == (tg + 1u) * nx) xb_add(&bar[XB_TOPGEN], 1u);
            else XB_SPIN(xb_ld(&bar[XB_TOPGEN]) == tg, bar);
            __builtin_amdgcn_fence(__ATOMIC_ACQUIRE, "agent");
            xb_add(&bar[XB_XGEN(b.x)], 1u);
            asm volatile("s_waitcnt vmcnt(0)" ::: "memory");
        } else {
            XB_SPIN(xb_ld(&bar[XB_XGEN(b.x)]) == gen, bar);
            __builtin_amdgcn_fence(__ATOMIC_ACQUIRE, "agent");
            asm volatile("s_waitcnt vmcnt(0)" ::: "memory");
        }
    }
    __syncthreads();
}


struct EpiBf16Plain {
    static constexpr bool PERM = true, AFTER_DRAIN = false;
    bf16_t* O; int ldc;
    DI void operator()(const f32x4 (&acc)[2][2][4][2], const pg8::Unit& u, int wr, int wc, int fr, int fq) const {
        const int row0 = u.pm * 256 + wr * 64 + fr, col0 = u.pn * 256 + wc * 32 + 8 * fq;
#pragma unroll
        for (int ai = 0; ai < 2; ++ai)
#pragma unroll
            for (int m = 0; m < 4; ++m) { bf16_t* rowp = O + (size_t)(row0 + ai * 128 + m * 16) * ldc + col0;
#pragma unroll
                for (int bj = 0; bj < 2; ++bj) { const f32x4 v0 = acc[ai][bj][m][0], v1 = acc[ai][bj][m][1];
                    u32x4 w; w.x = pack2(v0[0], v0[1]); w.y = pack2(v0[2], v0[3]); w.z = pack2(v1[0], v1[1]); w.w = pack2(v1[2], v1[3]);
                    *(u32x4*)(rowp + bj * 128) = w; } }
    }
};
struct EpiSwiglu {
    static constexpr bool PERM = true, AFTER_DRAIN = false;
    bf16_t* O;
    DI void operator()(const f32x4 (&acc)[2][2][4][2], const pg8::Unit& u, int wr, int wc, int fr, int fq) const {
        const int row0 = u.pm * 256 + wr * 64 + fr, col0 = u.pn * 128 + wc * 32 + 8 * fq;
#pragma unroll
        for (int ai = 0; ai < 2; ++ai)
#pragma unroll
            for (int m = 0; m < 4; ++m) { bf16_t* rowp = O + (size_t)(row0 + ai * 128 + m * 16) * DFF + col0;
                const f32x4 g0 = acc[ai][0][m][0], g1 = acc[ai][0][m][1], u0 = acc[ai][1][m][0], u1 = acc[ai][1][m][1];
                float v[8];
#pragma unroll
                for (int j = 0; j < 4; ++j) { v[j] = siluf_(g0[j]) * u0[j]; v[4 + j] = siluf_(g1[j]) * u1[j]; }
                u32x4 w; w.x = pack2(v[0], v[1]); w.y = pack2(v[2], v[3]); w.z = pack2(v[4], v[5]); w.w = pack2(v[6], v[7]);
                *(u32x4*)rowp = w; }
    }
};
struct EpiResid {
    static constexpr bool PERM = true, AFTER_DRAIN = false;
    float* X; const float* gate; float scale;
    DI void operator()(const f32x4 (&acc)[2][2][4][2], const pg8::Unit& u, int wr, int wc, int fr, int fq) const {
        const int row0 = u.pm * 256 + wr * 64 + fr, col0 = u.pn * 256 + wc * 32 + 8 * fq;
#pragma unroll
        for (int ai = 0; ai < 2; ++ai)
#pragma unroll
            for (int mh = 0; mh < 2; ++mh) { const int rowa = row0 + ai * 128 + mh * 32;
                if (rowa < NTOK) { f32x4 xv[2][2][2], gv[2][2][2];
#pragma unroll
                    for (int mm = 0; mm < 2; ++mm) { const int row = rowa + mm * 16; const float* gp = gate + (size_t)row_stream(row) * MODLD + col0; const float* xp = X + (size_t)row * D + col0;
#pragma unroll
                        for (int bj = 0; bj < 2; ++bj)
#pragma unroll
                            for (int n = 0; n < 2; ++n) { xv[mm][bj][n] = *(const f32x4*)(xp + bj * 128 + n * 4); gv[mm][bj][n] = *(const f32x4*)(gp + bj * 128 + n * 4); } }
#pragma unroll
                    for (int mm = 0; mm < 2; ++mm) { float* xp = X + (size_t)(rowa + mm * 16) * D + col0;
#pragma unroll
                        for (int bj = 0; bj < 2; ++bj)
#pragma unroll
                            for (int n = 0; n < 2; ++n) *(f32x4*)(xp + bj * 128 + n * 4) = xv[mm][bj][n] + (gv[mm][bj][n] * scale) * acc[ai][bj][2 * mh + mm][n]; } } }
    }
};
struct EpiLora {
    static constexpr bool PERM = false, AFTER_DRAIN = false;
    float* C; const float* w0; const float* a0;
    DI void operator()(const f32x4 (&acc)[2][2][4][2], const pg8::Unit& u, int wr, int wc, int fr, int fq) const {
        const int row0 = u.pm * 256 + wr * 64 + fr, col0 = u.pn * 256 + wc * 32 + 4 * fq; const int kind = u.pn >> 2;
        const float* bp = (kind == 0 ? w0 : a0) + (col0 & 1023);
#pragma unroll
        for (int bj = 0; bj < 2; ++bj)
#pragma unroll
            for (int n = 0; n < 2; ++n) { f32x4 bv = {0.f, 0.f, 0.f, 0.f}; if (kind < 2) bv = *(const f32x4*)(bp + bj * 128 + n * 16);
#pragma unroll
                for (int ai = 0; ai < 2; ++ai)
#pragma unroll
                    for (int m = 0; m < 4; ++m) { f32x4 v = acc[ai][bj][m][n] + bv;
                        if (kind == 0) {
#pragma unroll
                            for (int j = 0; j < 4; ++j) { const float x = v[j]; const float ls = fminf(x, 0.f) - __logf(1.0f + __expf(-fabsf(x))); v[j] = __expf(-__expf(ls - 0.5f)); } }
                        else if (kind == 1) {
#pragma unroll
                            for (int j = 0; j < 4; ++j) v[j] = sigmoidf_(v[j]); }
                        *(f32x4*)(C + (size_t)(row0 + ai * 128 + m * 16) * 3072 + col0 + bj * 128 + n * 16) = v; }
                asm volatile("" ::: "memory"); }
    }
};
struct BranchOrder {
    int c, ntile;
    __device__ __forceinline__ bool next(int i, pg8::Unit& u) const { const int n = i % 3, t = c + (i / 3) * (int)gridDim.x; if (t >= ntile) return false;
        const int x = t & 7, j = t >> 3, rt = 4 * x + (j >> 3), ct = j & 7;     u.pm = n * 33 + rt; u.pn = n * 8 + ct; return true; }
    __device__ __forceinline__ void a_ready(const pg8::Unit&) const {}
    __device__ __forceinline__ void done(const pg8::Unit&) const {}
};
struct EpiBranchSeq {
    static constexpr bool PERM = true, AFTER_DRAIN = false;
    const bf16_t* Z; const float* bm; float* T; bf16_t* O;
    DI void operator()(const f32x4 (&acc)[2][2][4][2], const pg8::Unit& u, int wr, int wc, int fr, int fq) const {
        const int n = u.pn >> 3, ct = u.pn & 7, rt = u.pm - 33 * n;
        const int row0 = rt * 256 + wr * 64 + fr, col0 = ct * 256 + wc * 32 + 8 * fq;
        f32x4 bb[2][2];
#pragma unroll
        for (int bj = 0; bj < 2; ++bj) { bb[bj][0] = *(const f32x4*)(bm + n * D + col0 + bj * 128); bb[bj][1] = *(const f32x4*)(bm + n * D + col0 + bj * 128 + 4); }
#pragma unroll
        for (int ai = 0; ai < 2; ++ai) {
            u32x4 zw[4][2];
#pragma unroll
            for (int m = 0; m < 4; ++m)
#pragma unroll
                for (int bj = 0; bj < 2; ++bj) zw[m][bj] = *(const u32x4*)(Z + (size_t)(row0 + ai * 128 + m * 16) * ZLD + n * D + col0 + bj * 128);
#pragma unroll
            for (int mh = 0; mh < 2; ++mh) { f32x4 tv[2][2][2];
                if (n != 0) {
#pragma unroll
                    for (int mm = 0; mm < 2; ++mm)
#pragma unroll
                        for (int bj = 0; bj < 2; ++bj) { const float* tp = T + (size_t)(row0 + ai * 128 + (2 * mh + mm) * 16) * D + col0 + bj * 128; tv[mm][bj][0] = *(const f32x4*)tp; tv[mm][bj][1] = *(const f32x4*)(tp + 4); } }
#pragma unroll
                for (int mm = 0; mm < 2; ++mm)
#pragma unroll
                    for (int bj = 0; bj < 2; ++bj) { const int m = 2 * mh + mm; const u32x4 w = zw[m][bj]; const size_t o = (size_t)(row0 + ai * 128 + m * 16) * D + col0 + bj * 128;
                        f32x4 g0, g1; g0[0] = sigmoidf_(lo16(w.x) + bb[bj][0][0]); g0[1] = sigmoidf_(hi16(w.x) + bb[bj][0][1]); g0[2] = sigmoidf_(lo16(w.y) + bb[bj][0][2]); g0[3] = sigmoidf_(hi16(w.y) + bb[bj][0][3]);
                        g1[0] = sigmoidf_(lo16(w.z) + bb[bj][1][0]); g1[1] = sigmoidf_(hi16(w.z) + bb[bj][1][1]); g1[2] = sigmoidf_(lo16(w.w) + bb[bj][1][2]); g1[3] = sigmoidf_(hi16(w.w) + bb[bj][1][3]);
                        f32x4 v0 = g0 * acc[ai][bj][m][0], v1 = g1 * acc[ai][bj][m][1];
                        if (n != 0) { v0 += tv[mm][bj][0]; v1 += tv[mm][bj][1]; }
                        if (n != 2) { *(f32x4*)(T + o) = v0; *(f32x4*)(T + o + 4) = v1; }
                        else { u32x4 ow; ow.x = pack2(v0[0], v0[1]); ow.y = pack2(v0[2], v0[3]); ow.z = pack2(v1[0], v1[1]); ow.w = pack2(v1[2], v1[3]); *(u32x4*)(O + o) = ow; } } } }
    }
};
struct EpiResidSample {
    static constexpr bool PERM = false, AFTER_DRAIN = false;
    float* X; const float* gate; float scale;
    DI void operator()(const f32x4 (&acc)[2][2][4][2], const pg8::Unit& u, int wr, int wc, int fr, int fq) const {
        const int col0 = u.pn * 256 + wc * 32 + 4 * fq;
#pragma unroll
        for (int m = 0; m < 4; ++m) { const int rl = wr * 64 + m * 16 + fr; const float* gp = gate + (size_t)(2 + (rl >> 4)) * MODLD + col0; float* xp = X + (size_t)(NTOK_P + rl) * D + col0;
#pragma unroll
            for (int bj = 0; bj < 2; ++bj)
#pragma unroll
                for (int n = 0; n < 2; ++n) { const f32x4 gv = *(const f32x4*)(gp + bj * 128 + n * 16); const f32x4 v = (gv * scale) * acc[0][bj][m][n]; float* p = xp + bj * 128 + n * 16;
                    unsafeAtomicAdd(p, v[0]); unsafeAtomicAdd(p + 1, v[1]); unsafeAtomicAdd(p + 2, v[2]); unsafeAtomicAdd(p + 3, v[3]); } }
    }
};
struct EpiBranchSample {
    static constexpr bool PERM = false, AFTER_DRAIN = false;
    const bf16_t* Z; const float* bm; float* T;
    DI void operator()(const f32x4 (&acc)[2][2][4][2], const pg8::Unit& u, int wr, int wc, int fr, int fq) const {
        const int col0 = u.pn * 256 + wc * 32 + 4 * fq;
#pragma unroll
        for (int m = 0; m < 4; ++m) { const int row = NTOK_P + wr * 64 + m * 16 + fr;
#pragma unroll
            for (int bj = 0; bj < 2; ++bj)
#pragma unroll
                for (int nn = 0; nn < 2; ++nn) { const int col = col0 + bj * 128 + nn * 16;
                    const u32x2 zw = *(const u32x2*)(Z + (size_t)row * ZLD + col); const f32x4 bv = *(const f32x4*)(bm + col);
                    f32x4 g; g[0] = sigmoidf_(lo16(zw.x) + bv[0]); g[1] = sigmoidf_(hi16(zw.x) + bv[1]); g[2] = sigmoidf_(lo16(zw.y) + bv[2]); g[3] = sigmoidf_(hi16(zw.y) + bv[3]);
                    const f32x4 v = g * acc[0][bj][m][nn]; float* p = T + (size_t)row * D + col;
                    unsafeAtomicAdd(p, v[0]); unsafeAtomicAdd(p + 1, v[1]); unsafeAtomicAdd(p + 2, v[2]); unsafeAtomicAdd(p + 3, v[3]); } }
    }
};
template <class Epi> DI void run_gemm_splitk(ldsp_t lds, const bf16_t* Atile, const bf16_t* Bt, int N, int Kfull, int Ks, const Epi& E) {
    const int S = Kfull / Ks;
    pg8::Gemm g{Atile, Bt, S * 256, N, Ks, Kfull, Kfull, (long)Ks * 2, (long)Kfull * 512, (long)Ks * 2}; pg8::StaticOrder So; So.init(S * 256, N, (int)gridDim.x, (int)sbid());
    pg8::gemm_phase<Epi, pg8::StaticOrder, false>((PG8_LAS unsigned char*)lds, g, So, E, nullptr);
}
template <class Epi> DI void run_gemm(ldsp_t lds, const bf16_t* A, const bf16_t* Bt, int M, int N, int K, const Epi& E) {
    pg8::Gemm g{A, Bt, M, N, K, K, K, (long)K * 512, (long)K * 512, 0}; pg8::StaticOrder S; S.init(M, N, (int)gridDim.x, (int)sbid());
    pg8::gemm_phase<Epi, pg8::StaticOrder, false>((PG8_LAS unsigned char*)lds, g, S, E, nullptr);
}

DI void conv_tile(const float* __restrict src, int ldw, int K, bf16_t* __restrict dst, int valid_rows, int mode, int tr, int tk, LAS float* T) {
    const int tid = vtid(), lane = tid & 63, wave = tid >> 6;
    const int j = tr * 64 + lane; const bool valid = j < valid_rows;
    int sc;
    if (mode == 0) sc = j;
    else if (mode == 1) { const int pn = j >> 8, r = j & 255; sc = (r < 128) ? pn * 128 + r : DFF + pn * 128 + (r - 128); }
    else if (mode == 2) sc = (j >> 7) * 256 + (j & 127);
    else sc = (j >> 7) * 256 + 128 + (j & 127);
    const float* sp = src + (size_t)(tk * 256 + wave) * ldw + (valid ? sc : 0);
    float v[32];
#pragma unroll
    for (int i = 0; i < 32; ++i) v[i] = valid ? sp[(size_t)(8 * i) * ldw] : 0.f;
#pragma unroll
    for (int i = 0; i < 32; ++i) T[(wave + 8 * i) * 65 + lane] = v[i];
    __syncthreads();
    const int row = tid >> 3;
#pragma unroll
    for (int c = 0; c < 4; ++c) { const int kc = (tid & 7) * 8 + 64 * c; float f[8];
#pragma unroll
        for (int i = 0; i < 8; ++i) f[i] = T[(kc + i) * 65 + row];
        u32x4 w; w.x = pack2(f[0], f[1]); w.y = pack2(f[2], f[3]); w.z = pack2(f[4], f[5]); w.w = pack2(f[6], f[7]);
        *(u32x4*)(dst + (size_t)(tr * 64 + row) * K + tk * 256 + kc) = w; }
    __syncthreads();
}

DI void prologue_phase(const Params& P, ldsp_t lds) {
    const int tid = vtid(), lane = tid & 63, wave = tid >> 6;
    const int G = gridDim.x, gtid = sbid() * 512 + tid, gsz = G * 512;
    unsigned char* ws = wsp(P);
    const float* in_w2 = INP(I_W2); const float* in_a2 = INP(I_A2); const float* in_g2 = INP(I_G2); const float* in_cp = INP(I_CP); const float* in_cs = INP(I_CS);
    const float* in_adaw = INP(I_ADAW); const float* in_adab = INP(I_ADAB);
    { f32x2* rt = (f32x2*)(ws + WS_ROPE);
      for (int idx = gtid; idx < 4096 * 32; idx += gsz) { const int pos = idx >> 5, i = idx & 31;
          const float inv = exp2f(-(float)i * 0.41524101186092029f);
          const double turns = (double)pos * (double)inv * 0.15915494309189535;
          const float fr = (float)(turns - rint(turns));
          f32x2 cs; cs.x = __builtin_amdgcn_cosf(fr); cs.y = __builtin_amdgcn_sinf(fr); rt[idx] = cs; } }
    for (int idx = gtid; idx < 2 * 3072 * 256; idx += gsz) { const int l = idx / (3072 * 256), e = idx % (3072 * 256), j = e >> 8, k = e & 255; float v = 0.f;
        if (j < 1024) { if (k < 64) v = in_w2[((size_t)l * 64 + k) * 1024 + j]; }
        else if (j < 2048) { if (k >= 64 && k < 128) v = in_a2[((size_t)l * 64 + (k - 64)) * 1024 + (j - 1024)]; }
        else { if (k >= 128) v = in_g2[((size_t)l * 128 + (k - 128)) * 1024 + (j - 2048)]; }
        ((bf16_t*)(ws + WS_WLO))[idx] = f2bf(v); }
    { LAS float* S = (LAS float*)lds;
      LAS float* R = S + 2048 * 12;
      for (int idx = tid; idx < 2048 * 10; idx += 512) { const int s = idx >> 11, k = idx & 2047;
          const float c = s < 2 ? in_cp[s * 2048 + k] : in_cs[(s - 2) * 2048 + k]; S[k * 12 + s] = siluf_(c); }
      for (int idx = tid; idx < 2048; idx += 512) { S[idx * 12 + 10] = 0.f; S[idx * 12 + 11] = 0.f; }
      __syncthreads();
      float* mod = (float*)(ws + WS_MOD);
      for (int item = sbid(); item < 576; item += G) { const int l = item / 288, cgp = item % 288;
          const float* W = in_adaw + (size_t)l * 2048 * MODLD + cgp * 64 + lane; const int k0 = wave * 256;
          float acc[10];
#pragma unroll
          for (int s = 0; s < 10; ++s) acc[s] = 0.f;
          for (int kk = 0; kk < 256; kk += 8) { float w[8];
#pragma unroll
              for (int i = 0; i < 8; ++i) w[i] = W[(size_t)(k0 + kk + i) * MODLD];
#pragma unroll
              for (int i = 0; i < 8; ++i) { const LAS float* sp = S + (k0 + kk + i) * 12; const f32x4 s0 = *(const LAS f32x4*)sp, s1 = *(const LAS f32x4*)(sp + 4), s2 = *(const LAS f32x4*)(sp + 8);
                  acc[0] += w[i] * s0[0]; acc[1] += w[i] * s0[1]; acc[2] += w[i] * s0[2]; acc[3] += w[i] * s0[3]; acc[4] += w[i] * s1[0];
                  acc[5] += w[i] * s1[1]; acc[6] += w[i] * s1[2]; acc[7] += w[i] * s1[3]; acc[8] += w[i] * s2[0]; acc[9] += w[i] * s2[1]; } }
#pragma unroll
          for (int s = 0; s < 10; ++s) R[(wave * 10 + s) * 64 + lane] = acc[s];
          __syncthreads();
          for (int o = tid; o < 640; o += 512) { const int s = o >> 6, c = o & 63; float t = 0.f;
#pragma unroll
              for (int w8 = 0; w8 < 8; ++w8) t += R[(w8 * 10 + s) * 64 + c];
              mod[(size_t)(l * 10 + s) * MODLD + cgp * 64 + c] = t + in_adab[(size_t)l * MODLD + cgp * 64 + c]; }
          __syncthreads(); } }
    { LAS float* T = (LAS float*)lds;
      const float* in_fwi = INP(I_FWI); const float* in_fwo = INP(I_FWO); const float* in_win = INP(I_WIN); const float* in_wkvb = INP(I_WKVB); const float* in_wbr = INP(I_WBR); const float* in_wout = INP(I_WOUT);
      const int PER_LAYER = 1408 + 1408 + 704 + 704 + 1856 + 32 + 32 + 128 + 128 + 128 + 256;
      const int start = (sbid() + 64) % G;
      for (int tile = start; tile < 2 * PER_LAYER; tile += G) {
          const int l = tile / PER_LAYER; int t = tile % PER_LAYER;
          const float* src; bf16_t* dst; int ldw, K, vr, mode, nkt;
          if (t < 2816) { const int f = t / 1408; t %= 1408; src = in_fwi + (size_t)(l * 2 + f) * D * (2 * DFF); dst = (bf16_t*)(ws + WS_WFI + (l * 2 + f) * SZ_WFI); ldw = 2 * DFF; K = D; vr = 2 * DFF; mode = 1; nkt = 8; }
          else if (t < 4224) { t -= 2816; const int f = t / 704; t %= 704; src = in_fwo + (size_t)(l * 2 + f) * DFF * D; dst = (bf16_t*)(ws + WS_WFO + (l * 2 + f) * SZ_WFO); ldw = D; K = DFF; vr = D; mode = 0; nkt = 22; }
          else if (t < 6080) { t -= 4224; src = in_win + (size_t)l * D * INCOLS; dst = (bf16_t*)(ws + WS_WIN + l * SZ_WIN); ldw = INCOLS; K = D; vr = INCOLS; mode = 0; nkt = 8; }
          else if (t < 6112) { t -= 6080; src = in_wkvb + (size_t)l * 512 * 2048; dst = (bf16_t*)(ws + WS_WKK + l * SZ_WKK); ldw = 2048; K = 512; vr = 1024; mode = 2; nkt = 2; }
          else if (t < 6144) { t -= 6112; src = in_wkvb + (size_t)l * 512 * 2048; dst = (bf16_t*)(ws + WS_WKV + l * SZ_WKK); ldw = 2048; K = 512; vr = 1024; mode = 3; nkt = 2; }
          else if (t < 6528) { t -= 6144; const int n = t / 128; t %= 128; src = in_wbr + (size_t)(l * 3 + n) * 1024 * D; dst = (bf16_t*)(ws + WS_WBR + (l * 3 + n) * SZ_WBR); ldw = D; K = 1024; vr = D; mode = 0; nkt = 4; }
          else { t -= 6528; src = in_wout + (size_t)l * D * D; dst = (bf16_t*)(ws + WS_WO + l * SZ_WO); ldw = D; K = D; vr = D; mode = 0; nkt = 8; }
          conv_tile(src, ldw, K, dst, vr, mode, t / nkt, t % nkt, T); } }
}

DI void norm_phase(const Params& P, int l, int which, bool first) {
    unsigned char* ws = wsp(P); const float* in_ng = INP(I_NORMG); const float* in_xp = INP(I_XP); const float* in_xs = INP(I_XS);
    const int lane = vtid() & 63, gw = sbid() * 8 + (vtid() >> 6);
    float* xb = (float*)(ws + WS_X); bf16_t* h = (bf16_t*)(ws + WS_H); const float* mod = (const float*)(ws + WS_MOD);
    const int nwv = gridDim.x * 8, rpw = (MP + nwv - 1) / nwv, r0 = gw * rpw;
    int cur_s = -1; f32x4 gm[8], sh[8];
    for (int r = r0; r < r0 + rpw && r < MP; ++r) {
        bf16_t* hp = h + (size_t)r * D + 4 * lane;
        if (r >= NTOK) {
#pragma unroll
            for (int i = 0; i < 8; ++i) *(u32x2*)(hp + 256 * i) = (u32x2){0u, 0u};
            continue; }
        const int s = row_stream(r);
        if (s != cur_s) { cur_s = s; const float* gp = in_ng + (size_t)(l * 3 + which) * D + 4 * lane; const float* mp = mod + (size_t)(l * 10 + s) * MODLD + (which * 3) * D + 4 * lane;
#pragma unroll
            for (int i = 0; i < 8; ++i) { const f32x4 g = *(const f32x4*)(gp + 256 * i), sc = *(const f32x4*)(mp + D + 256 * i); sh[i] = *(const f32x4*)(mp + 256 * i); gm[i] = g * (sc + 1.0f); } }
        const float* xp = first ? (r < NTOK_P ? in_xp + (size_t)r * D : in_xs + (size_t)(r - NTOK_P) * D) : xb + (size_t)r * D;
        f32x4 x[8]; float ss = 0.f;
#pragma unroll
        for (int i = 0; i < 8; ++i) { x[i] = *(const f32x4*)(xp + 4 * lane + 256 * i); ss += x[i][0] * x[i][0] + x[i][1] * x[i][1] + x[i][2] * x[i][2] + x[i][3] * x[i][3]; }
        ss = wave_sum(ss); const float rstd = rsqrtf(ss * (1.0f / D) + 1e-6f);
        if (first) {
#pragma unroll
            for (int i = 0; i < 8; ++i) *(f32x4*)(xb + (size_t)r * D + 4 * lane + 256 * i) = x[i]; }
#pragma unroll
        for (int i = 0; i < 8; ++i) { const f32x4 y = x[i] * rstd * gm[i] + sh[i]; u32x2 w; w.x = pack2(y[0], y[1]); w.y = pack2(y[2], y[3]); *(u32x2*)(hp + 256 * i) = w; }
    }
}
DI void final_phase(const Params& P) {
    unsigned char* ws = wsp(P); float* out = outp(P); const float* in_fng = INP(I_FNG);
    const int lane = vtid() & 63, gw = sbid() * 8 + (vtid() >> 6), nwv = gridDim.x * 8;
    const float* xb = (const float*)(ws + WS_X);
    f32x4 g[8];
#pragma unroll
    for (int i = 0; i < 8; ++i) g[i] = *(const f32x4*)(in_fng + 4 * lane + 256 * i);
    for (int r = gw; r < NTOK; r += nwv) { const float* xp = xb + (size_t)r * D + 4 * lane; f32x4 x[8]; float ss = 0.f;
#pragma unroll
        for (int i = 0; i < 8; ++i) { x[i] = *(const f32x4*)(xp + 256 * i); ss += x[i][0] * x[i][0] + x[i][1] * x[i][1] + x[i][2] * x[i][2] + x[i][3] * x[i][3]; }
        ss = wave_sum(ss); const float rstd = rsqrtf(ss * (1.0f / D) + 1e-6f);
        float* op = out + (r < NTOK_P ? O_YP + (size_t)r * D : O_YS + (size_t)(r - NTOK_P) * D) + 4 * lane;
#pragma unroll
        for (int i = 0; i < 8; ++i) *(f32x4*)(op + 256 * i) = x[i] * rstd * g[i]; }
}

DI void prep_phase(const Params& P, int l) {
    const int lane = vtid() & 63, gw = sbid() * 8 + (vtid() >> 6), nwv = gridDim.x * 8;
    unsigned char* ws = wsp(P); float* out = outp(P); const float* in_clat = INP(I_CLAT); const float* in_ckr = INP(I_CKR); const float* in_rwsh = INP(I_RWSH);
    const bf16_t* z = (const bf16_t*)(ws + WS_Z); bf16_t* latA = (bf16_t*)(ws + WS_LATA); bf16_t* krA = (bf16_t*)(ws + WS_KRA); bf16_t* qR = (bf16_t*)(ws + WS_QR); bf16_t* lin = (bf16_t*)(ws + WS_LIN);
    const f32x2* rope = (const f32x2*)(ws + WS_ROPE);
    f32x4 kg0 = *(const f32x4*)(INP(I_KVG) + l * 512 + 8 * lane), kg1 = *(const f32x4*)(INP(I_KVG) + l * 512 + 8 * lane + 4);
    const f32x4 mu4 = *(const f32x4*)(INP(I_MU) + (size_t)l * 3328 + 3072 + 4 * lane);
    for (int row = gw; row < MP; row += nwv) {
        if (row >= NTOK) { *(u32x2*)(lin + (size_t)row * 256 + 4 * lane) = (u32x2){0u, 0u}; continue; }
        const bool pr = row < NTOK_P; const int s = row_stream(row), b = pr ? s : s - 2, t = pr ? (row & 4095) : ((row - NTOK_P) & 15), pos = pr ? t : 2048 + t, T = pr ? 4096 : 16;
        const bf16_t* zr = z + (size_t)row * ZLD;
        const int keyrow = pr ? row : NTOK_P + b * SKEY + 2048 + t;
        { const u32x4 lv = *(const u32x4*)(zr + ZLAT + 8 * lane);
          float v[8] = {lo16(lv.x), hi16(lv.x), lo16(lv.y), hi16(lv.y), lo16(lv.z), hi16(lv.z), lo16(lv.w), hi16(lv.w)}; float ss = 0.f;
#pragma unroll
          for (int j = 0; j < 8; ++j) ss += v[j] * v[j];
          ss = wave_sum(ss); const float rstd = rsqrtf(ss * (1.0f / 512.0f) + 1e-6f);
          f32x4 o0, o1;
#pragma unroll
          for (int j = 0; j < 4; ++j) { o0[j] = v[j] * rstd * kg0[j]; o1[j] = v[4 + j] * rstd * kg1[j]; }
          float* op = out + (pr ? O_PLAT + ((size_t)(l * 2 + b) * 4096 + t) * 512 : O_SLAT + ((size_t)(l * 8 + b) * 16 + t) * 512) + 8 * lane;
          *(f32x4*)op = o0; *(f32x4*)(op + 4) = o1;
          u32x4 w; w.x = pack2(o0[0], o0[1]); w.y = pack2(o0[2], o0[3]); w.z = pack2(o1[0], o1[1]); w.w = pack2(o1[2], o1[3]);
          *(u32x4*)(latA + (size_t)keyrow * 512 + 8 * lane) = w; }
        if (lane < 32) { const float x1 = bf2f(zr[ZKR + lane]), x2 = bf2f(zr[ZKR + 32 + lane]); const f32x2 cs = rope[pos * 32 + lane];
            const float o1 = x1 * cs.x - x2 * cs.y, o2 = x2 * cs.x + x1 * cs.y;
            float* op = out + (pr ? O_PKR + ((size_t)(l * 2 + b) * 4096 + t) * 64 : O_SKR + ((size_t)(l * 8 + b) * 16 + t) * 64);
            op[lane] = o1; op[32 + lane] = o2; krA[(size_t)keyrow * 64 + lane] = f2bf(o1); krA[(size_t)keyrow * 64 + 32 + lane] = f2bf(o2); }
#pragma unroll
        for (int i = 0; i < 4; ++i) { const int p = lane + 64 * i, hd = p >> 5, ii = p & 31; const bf16_t* qp = zr + ZQA + hd * 192 + 128;
            const float x1 = bf2f(qp[ii]), x2 = bf2f(qp[32 + ii]); const f32x2 cs = rope[pos * 32 + ii];
            qR[(size_t)row * 512 + hd * 64 + ii] = f2bf(x1 * cs.x - x2 * cs.y); qR[(size_t)row * 512 + hd * 64 + 32 + ii] = f2bf(x2 * cs.x + x1 * cs.y); }
        { const u32x2 cw = *(const u32x2*)(zr + ZWD + 4 * lane); f32x4 cur = {lo16(cw.x), hi16(cw.x), lo16(cw.y), hi16(cw.y)}, prev;
          if (t > 0) { const u32x2 pw = *(const u32x2*)(zr - ZLD + ZWD + 4 * lane); prev = (f32x4){lo16(pw.x), hi16(pw.x), lo16(pw.y), hi16(pw.y)}; }
          else if (pr) prev = (f32x4){0.f, 0.f, 0.f, 0.f};
          else prev = *(const f32x4*)(in_rwsh + (size_t)(l * 8 + b) * 3328 + 3072 + 4 * lane);
          f32x4 xs = cur + (prev - cur) * mu4, o;
#pragma unroll
          for (int j = 0; j < 4; ++j) o[j] = lane < 16 ? tanhf(xs[j]) : (lane < 32 ? xs[j] : sigmoidf_(xs[j]));
          u32x2 w; w.x = pack2(o[0], o[1]); w.y = pack2(o[2], o[3]); *(u32x2*)(lin + (size_t)row * 256 + 4 * lane) = w; }
        if (t == T - 1) { float* op = out + (pr ? O_PSH + (size_t)(l * 2 + b) * 3328 : O_SSH + (size_t)(l * 8 + b) * 3328);
#pragma unroll 2
            for (int c = lane; c < 3328; c += 64) op[c] = bf2f(zr[ZR + c]); }
    }
    for (int idx = gw; idx < 8 * SKEY; idx += nwv) { const int b = idx / SKEY, j = idx % SKEY; const size_t keyrow = NTOK_P + idx;
        if (j < 2048) { const float* cp = in_clat + ((size_t)(l * 8 + b) * 2048 + j) * 512 + 8 * lane; const f32x4 a = *(const f32x4*)cp, c = *(const f32x4*)(cp + 4);
            u32x4 w; w.x = pack2(a[0], a[1]); w.y = pack2(a[2], a[3]); w.z = pack2(c[0], c[1]); w.w = pack2(c[2], c[3]); *(u32x4*)(latA + keyrow * 512 + 8 * lane) = w;
            krA[keyrow * 64 + lane] = f2bf(in_ckr[((size_t)(l * 8 + b) * 2048 + j) * 64 + lane]); }
        else if (j >= 2064) { *(u32x4*)(latA + keyrow * 512 + 8 * lane) = (u32x4){0u, 0u, 0u, 0u}; krA[keyrow * 64 + lane] = 0; } }
}

DI void sample_mix_zero(const Params& P) {
    unsigned char* ws = wsp(P); f32x4* T = (f32x4*)((float*)(ws + WS_ACT) + (size_t)NTOK_P * D);
    for (int i = sbid() * 512 + vtid(); i < 128 * D / 4; i += gridDim.x * 512) T[i] = (f32x4){0.f, 0.f, 0.f, 0.f};
}
DI void sample_mix_convert(const Params& P) {
    unsigned char* ws = wsp(P); const f32x4* T = (const f32x4*)((const float*)(ws + WS_ACT) + (size_t)NTOK_P * D); u32x2* M = (u32x2*)((bf16_t*)(ws + WS_MIX) + (size_t)NTOK_P * D);
    for (int i = sbid() * 512 + vtid(); i < 128 * D / 4; i += gridDim.x * 512) { const f32x4 v = T[i]; u32x2 w; w.x = pack2(v[0], v[1]); w.y = pack2(v[2], v[3]); M[i] = w; }
}

DI f32x16 mma_tile32(const LAS bf16_t* A, int lda, const LAS bf16_t* Bt, int ldb, int K, f32x16 acc, int lane) {
    const int r = lane & 31, hh = lane >> 5;
    const LAS bf16_t* ap = A + r * lda + 8 * hh; const LAS bf16_t* bp = Bt + r * ldb + 8 * hh;
    for (int k = 0; k < K; k += 16) { const bf16x8 a = *(const LAS bf16x8*)(ap + k); const bf16x8 b = *(const LAS bf16x8*)(bp + k); acc = MFMA32(a, b, acc); }
    return acc;
}
DI f32x16 zero16() { f32x16 z; for (int i = 0; i < 16; ++i) z[i] = 0.f; return z; }
struct MlItem { int b, h, row0, L; bool prompt; };
DI MlItem ml_item(int item) { MlItem it; if (item < 512) { const int sh = item >> 6, c = item & 63; it.b = sh >> 2; it.h = sh & 3; it.row0 = it.b * 4096 + 64 * c; it.L = 64; it.prompt = true; }
    else { const int j = item - 512; it.b = j >> 2; it.h = j & 3; it.row0 = NTOK_P + 16 * it.b; it.L = 16; it.prompt = false; } return it; }

constexpr int MLA_QS = 0, MLA_KS = 17408, MLA_KT = 34816, MLA_VT = 53248, MLA_PS = 94720, MLA_G = 103936;
DI void mlstm_pass_a(const Params& P, ldsp_t lds, int l) {
    const int tid = vtid(), lane = tid & 63, wave = tid >> 6;
    unsigned char* ws = wsp(P); const bf16_t* z = (const bf16_t*)(ws + WS_Z);
    float* numl = (float*)(ws + WS_NUML); float* denl = (float*)(ws + WS_DENL); float* mlg = (float*)(ws + WS_MLG); float* dC = (float*)(ws + WS_DC); float* mli = (float*)(ws + WS_MLI);
    LAS bf16_t* Qs = (LAS bf16_t*)(lds + MLA_QS); LAS bf16_t* Ks = (LAS bf16_t*)(lds + MLA_KS); LAS bf16_t* KT = (LAS bf16_t*)(lds + MLA_KT);
    LAS bf16_t* VT = (LAS bf16_t*)(lds + MLA_VT); LAS bf16_t* Ps = (LAS bf16_t*)(lds + MLA_PS); LAS float* Gu = (LAS float*)(lds + MLA_G); LAS float* Gpm = Gu + 64; LAS float* Gwp = Gu + 128;
    const float* in_ib = INP(I_MLIB); const float* in_fb = INP(I_MLFB);
    for (int item = sbid(); item < ML_ITEMS; item += gridDim.x) {
        const MlItem it = ml_item(item); const int L = it.L, h = it.h, row0 = it.row0;
        if (wave == 0) { const int t = lane; const bool valid = t < L; const bf16_t* zr = z + (size_t)(row0 + (valid ? t : 0)) * ZLD;
            const float igr = bf2f(zr[ZIG + h]) + in_ib[l * 4 + h], fgr = bf2f(zr[ZFG + h]) + in_fb[l * 4 + h];
            const float ig = softcap15(igr); float bsum = valid ? logsigmoidf_(softcap15(fgr)) : 0.f;
#pragma unroll
            for (int o = 1; o < 64; o <<= 1) { const float v = __shfl_up(bsum, o); if (lane >= o) bsum += v; }
            const float u = valid ? ig - bsum : -1e30f; float pm = u;
#pragma unroll
            for (int o = 1; o < 64; o <<= 1) { const float v = __shfl_up(pm, o); if (lane >= o) pm = fmaxf(pm, v); }
            const float blast = __shfl(bsum, L - 1), pmlast = __shfl(pm, L - 1);
            Gu[t] = u; Gpm[t] = pm; Gwp[t] = valid ? __expf(u - pmlast) : 0.f;
            if (valid) { float* gp = mlg + ((size_t)(row0 + t) * 4 + h) * 2; gp[0] = bsum; gp[1] = bsum + pm; }
            if (lane == 0) { mli[item * 4 + 0] = blast; mli[item * 4 + 1] = blast + pmlast; } }
#pragma unroll
        for (int i = 0; i < 2; ++i) { const int idx = tid + 512 * i, s = idx >> 4, ch = idx & 15; u32x4 q = {0u, 0u, 0u, 0u}, k = q;
            if (s < L) { const bf16_t* zr = z + (size_t)(row0 + s) * ZLD + h * 128 + 8 * ch; q = *(const u32x4*)(zr + ZQM); k = *(const u32x4*)(zr + ZKM); }
            *(LAS u32x4*)(Qs + s * 136 + 8 * ch) = q; *(LAS u32x4*)(Ks + s * 136 + 8 * ch) = k; }
#pragma unroll
        for (int i = 0; i < 4; ++i) { const int idx = tid + 512 * i, s = idx & 63, ch = idx >> 6; u32x4 v = {0u, 0u, 0u, 0u};
            if (s < L) v = *(const u32x4*)(z + (size_t)(row0 + s) * ZLD + ZVM + h * 256 + 8 * ch);
            LAS bf16_t* vp = VT + (8 * ch) * 72 + s;
            vp[0] = (bf16_t)(v.x & 0xffff); vp[72] = (bf16_t)(v.x >> 16); vp[144] = (bf16_t)(v.y & 0xffff); vp[216] = (bf16_t)(v.y >> 16);
            vp[288] = (bf16_t)(v.z & 0xffff); vp[360] = (bf16_t)(v.z >> 16); vp[432] = (bf16_t)(v.w & 0xffff); vp[504] = (bf16_t)(v.w >> 16); }
        for (int idx = tid; idx < 32 * 64; idx += 512) { const int rr = idx >> 6, s = idx & 63; VT[(256 + rr) * 72 + s] = (rr == 0) ? (bf16_t)0x3F80 : (bf16_t)0; }
        __syncthreads();
        { const int s = tid & 63, dg = tid >> 6; const float wp = Gwp[s];
#pragma unroll
          for (int hf = 0; hf < 2; ++hf) { const u32x4 kv = *(const LAS u32x4*)(Ks + s * 136 + dg * 16 + 8 * hf); LAS bf16_t* kp = KT + (dg * 16 + 8 * hf) * 72 + s;
              kp[0] = f2bf(lo16(kv.x) * wp); kp[72] = f2bf(hi16(kv.x) * wp); kp[144] = f2bf(lo16(kv.y) * wp); kp[216] = f2bf(hi16(kv.y) * wp);
              kp[288] = f2bf(lo16(kv.z) * wp); kp[360] = f2bf(hi16(kv.z) * wp); kp[432] = f2bf(lo16(kv.w) * wp); kp[504] = f2bf(hi16(kv.w) * wp); } }
        if (wave < 4) { const int ti = wave >> 1, si = wave & 1, r = lane & 31, hh = lane >> 5;
            f32x16 acc = mma_tile32(Qs + ti * 32 * 136, 136, Ks + si * 32 * 136, 136, 128, zero16(), lane);
            const int s = si * 32 + r; const float us = Gu[s];
#pragma unroll
            for (int i = 0; i < 16; ++i) { const int t = ti * 32 + crow(i, hh); const float d = (s <= t) ? __expf(us - Gpm[t]) : 0.f;
                Ps[t * 72 + s] = f2bf(acc[i] * 0.08838834764831845f * d); } }
        __syncthreads();
        for (int tl = wave; tl < 54; tl += 8) { const int r = lane & 31, hh = lane >> 5;
            if (tl < 18) { const int ti = tl / 9, vj = tl % 9;
                const f32x16 acc = mma_tile32(Ps + ti * 32 * 72, 72, VT + vj * 32 * 72, 72, 64, zero16(), lane);
                if (vj < 8) { float* np = numl + ((size_t)item * 16 + ti * 8 + vj) * 1024 + lane * 16;
#pragma unroll
                    for (int g = 0; g < 4; ++g) *(f32x4*)(np + 4 * g) = (f32x4){acc[4 * g], acc[4 * g + 1], acc[4 * g + 2], acc[4 * g + 3]}; }
                else if (r == 0) {
#pragma unroll
                    for (int i = 0; i < 16; ++i) { const int t = ti * 32 + crow(i, hh); if (t < L) denl[(size_t)(row0 + t) * 4 + h] = acc[i]; } } }
            else { const int q = tl - 18, vi = q >> 2, kj = q & 3;
                const f32x16 acc = mma_tile32(VT + vi * 32 * 72, 72, KT + kj * 32 * 72, 72, 64, zero16(), lane);
#pragma unroll
                for (int i = 0; i < 16; ++i) { const int dv = vi * 32 + crow(i, hh); if (dv < 257) dC[(size_t)item * ML_CSZ + dv * 128 + kj * 32 + r] = acc[i] * 0.08838834764831845f; } } }
        __syncthreads();
    }
}
DI void mlstm_pass_b(const Params& P, int l, int gtid, int gsz) {
    unsigned char* ws = wsp(P); float* out = outp(P); const float* in_mlm = INP(I_MLM); const float* in_mlc = INP(I_MLC); const float* in_mln = INP(I_MLN); float* dC = (float*)(ws + WS_DC); float* mli = (float*)(ws + WS_MLI);
    constexpr int NV = 257 * 128 / 4;
    for (int v = gtid; v < 40 * NV; v += gsz) { const int seq = v / NV, e = v % NV;
        int b, h, item0, nc; float m; f32x4 st;
        if (seq < 8) { b = seq >> 2; h = seq & 3; item0 = seq * 64; nc = 64; m = 0.f; st = (f32x4){0.f, 0.f, 0.f, 0.f}; }
        else { const int j = seq - 8; b = j >> 2; h = j & 3; item0 = 512 + j; nc = 1; m = in_mlm[(l * 8 + b) * 4 + h];
            st = (e < 8192) ? *(const f32x4*)(in_mlc + ((size_t)(l * 8 + b) * 4 + h) * 32768 + 4 * e) : *(const f32x4*)(in_mln + ((size_t)(l * 8 + b) * 4 + h) * 128 + 4 * (e - 8192)); }
        for (int c = 0; c < nc; ++c) { const int item = item0 + c; const float bl = mli[item * 4 + 0], al = mli[item * 4 + 1];
            const float mn = fmaxf(bl + m, al), cw = __expf(bl + m - mn), be = __expf(al - mn);
            f32x4* p = (f32x4*)(dC + (size_t)item * ML_CSZ) + e; const f32x4 d = *p; *p = st; st = st * cw + d * be;
            if (e == 0) mli[item * 4 + 2] = m;
            m = mn; }
        const bool pr = seq < 8; const size_t sh = (size_t)(l * (pr ? 2 : 8) + b) * 4 + h;
        if (e < 8192) *(f32x4*)(out + (pr ? O_PC : O_SC) + sh * 32768 + 4 * e) = st; else *(f32x4*)(out + (pr ? O_PN : O_SN) + sh * 128 + 4 * (e - 8192)) = st;
        if (e == 0) out[(pr ? O_PM : O_SM) + sh] = m; }
}
constexpr int MLC_QS = 0, MLC_CS = 17408, MLC_HS = 17408, MLC_G = 17408 + 78336;
DI void mlstm_pass_c(const Params& P, ldsp_t lds, int l) {
    const int tid = vtid(), lane = tid & 63, wave = tid >> 6;
    unsigned char* ws = wsp(P); const bf16_t* z = (const bf16_t*)(ws + WS_Z);
    const float* numl = (const float*)(ws + WS_NUML); const float* denl = (const float*)(ws + WS_DENL); const float* mlg = (const float*)(ws + WS_MLG);
    const float* dC = (const float*)(ws + WS_DC); const float* mli = (const float*)(ws + WS_MLI); bf16_t* oall = (bf16_t*)(ws + WS_OALL);
    LAS bf16_t* Qs = (LAS bf16_t*)(lds + MLC_QS); LAS bf16_t* Cs = (LAS bf16_t*)(lds + MLC_CS); LAS float* Hs = (LAS float*)(lds + MLC_HS);
    LAS float* Gel = (LAS float*)(lds + MLC_G); LAS float* Gei = Gel + 64; LAS float* Gcl = Gel + 128; LAS float* Gqn = Gel + 192;
    const float* in_hg = INP(I_MLHG);
    for (int item = sbid(); item < ML_ITEMS; item += gridDim.x) {
        const MlItem it = ml_item(item); const int L = it.L, h = it.h, row0 = it.row0;
#pragma unroll
        for (int i = 0; i < 2; ++i) { const int idx = tid + 512 * i, s = idx >> 4, ch = idx & 15; u32x4 q = {0u, 0u, 0u, 0u};
            if (s < L) q = *(const u32x4*)(z + (size_t)(row0 + s) * ZLD + ZQM + h * 128 + 8 * ch);
            *(LAS u32x4*)(Qs + s * 136 + 8 * ch) = q; }
#pragma unroll 2
        for (int idx = tid; idx < 288 * 32; idx += 512) { const int dv = idx >> 5, c4 = idx & 31; u32x2 w = {0u, 0u};
            if (dv < 257) { const f32x4 c = *(const f32x4*)(dC + (size_t)item * ML_CSZ + dv * 128 + 4 * c4); w.x = pack2(c[0], c[1]); w.y = pack2(c[2], c[3]); }
            *(LAS u32x2*)(Cs + dv * 136 + 4 * c4) = w; }
        if (tid < 64) { const int t = tid; float el = 0.f, ei = 0.f, cl = 1.f, dn = 0.f;
            if (t < L) { const float* gp = mlg + ((size_t)(row0 + t) * 4 + h) * 2; const float bt = gp[0], at = gp[1], mp = mli[item * 4 + 2];
                const float mt = fmaxf(bt + mp, at); el = __expf(at - mt); ei = __expf(bt + mp - mt); cl = __expf(-mt); dn = el * denl[(size_t)(row0 + t) * 4 + h]; }
            Gel[t] = el; Gei[t] = ei; Gcl[t] = cl; Gqn[64 + t] = dn; }
        __syncthreads();
        const int r = lane & 31, hh = lane >> 5;
        if (wave < 2) { const f32x16 aq = mma_tile32(Qs + wave * 32 * 136, 136, Cs + 8 * 32 * 136, 136, 128, zero16(), lane);
            if (r == 0) {
#pragma unroll
                for (int i = 0; i < 16; ++i) Gqn[wave * 32 + crow(i, hh)] = aq[i]; } }
        __syncthreads();
        if (tid < 64) { const int t = tid; const float el = Gel[t], ei = Gei[t]; const float den = Gqn[64 + t] + ei * Gqn[t]; const float md = fmaxf(fabsf(den), Gcl[t]);
            Gel[t] = (t < L) ? el / md : 0.f; Gei[t] = (t < L) ? ei / md : 0.f; }
        __syncthreads();
        f32x16 hv2[2];
#pragma unroll
        for (int k = 0; k < 2; ++k) { const int tl = wave + 8 * k, ti = tl >> 3, vj = tl & 7;
            const f32x16 acc = mma_tile32(Qs + ti * 32 * 136, 136, Cs + vj * 32 * 136, 136, 128, zero16(), lane);
            const float* np = numl + ((size_t)item * 16 + tl) * 1024 + lane * 16;
#pragma unroll
            for (int g = 0; g < 4; ++g) { const f32x4 nv = *(const f32x4*)(np + 4 * g); const f32x4 ca = *(const LAS f32x4*)(Gel + ti * 32 + 8 * g + 4 * hh), cb = *(const LAS f32x4*)(Gei + ti * 32 + 8 * g + 4 * hh);
#pragma unroll
                for (int j = 0; j < 4; ++j) hv2[k][4 * g + j] = ca[j] * nv[j] + cb[j] * acc[4 * g + j]; } }
        __syncthreads();
#pragma unroll
        for (int k = 0; k < 2; ++k) { const int tl = wave + 8 * k, ti = tl >> 3, vj = tl & 7;
#pragma unroll
            for (int i = 0; i < 16; ++i) Hs[(ti * 32 + crow(i, hh)) * 260 + vj * 32 + r] = hv2[k][i]; }
        __syncthreads();
        { const f32x4 hg = *(const f32x4*)(in_hg + l * 1024 + h * 256 + 4 * lane);
#pragma unroll
          for (int i = 0; i < 8; ++i) { const int t = wave * 8 + i;
              if (t < L) { const f32x4 hv = *(const LAS f32x4*)(Hs + t * 260 + 4 * lane); float ss = hv[0] * hv[0] + hv[1] * hv[1] + hv[2] * hv[2] + hv[3] * hv[3];
                  ss = wave_sum(ss); const float rstd = rsqrtf(ss * (1.0f / 256.0f) + 1e-6f);
                  const u32x2 ow = *(const u32x2*)(z + (size_t)(row0 + t) * ZLD + ZOM + h * 256 + 4 * lane);
                  const float o0 = sigmoidf_(lo16(ow.x)) * hv[0] * rstd * hg[0], o1 = sigmoidf_(hi16(ow.x)) * hv[1] * rstd * hg[1], o2 = sigmoidf_(lo16(ow.y)) * hv[2] * rstd * hg[2], o3 = sigmoidf_(hi16(ow.y)) * hv[3] * rstd * hg[3];
                  u32x2 w; w.x = pack2(o0, o1); w.y = pack2(o2, o3); *(u32x2*)(oall + (size_t)(row0 + t) * 1024 + h * 256 + 4 * lane) = w; } } }
        __syncthreads();
    }
}

constexpr int RW_R = 0, RW_W = 8192, RW_K = 16384, RW_A = 24576, RW_B = RW_A + 36 * 256, RW_V = RW_B + 8192, RW_CD = RW_V + 2048, RW_BUF = RW_CD + 1024;
constexpr int RW_YOFF = 2 * RW_BUF;
DI float wave_sum_dpp(float v) { v = row16_sum(v);
    const int iv = __builtin_bit_cast(int, v);
    return (__builtin_bit_cast(float, __builtin_amdgcn_readlane(iv, 0)) + __builtin_bit_cast(float, __builtin_amdgcn_readlane(iv, 16))) + (__builtin_bit_cast(float, __builtin_amdgcn_readlane(iv, 32)) + __builtin_bit_cast(float, __builtin_amdgcn_readlane(iv, 48))); }
DI void rwkv_pre(const Params& P, int l) {
    const int lane = vtid() & 63, gw = sbid() * 8 + (vtid() >> 6), nwv = gridDim.x * 8;
    unsigned char* ws = wsp(P); const bf16_t* z = (const bf16_t*)(ws + WS_Z); const float* lout = (const float*)(ws + WS_LOUT);
    float* VR = (float*)(ws + WS_VR); float* VK = (float*)(ws + WS_VK); float* VA = (float*)(ws + WS_VA); float* VB = (float*)(ws + WS_VB); float* VV = (float*)(ws + WS_VV); float* CD = (float*)(ws + WS_CD); float* rkb = (float*)(ws + WS_RK);
    const float* in_mu = INP(I_MU) + (size_t)l * 3328; const float* in_kk = INP(I_KK) + l * 1024; const float* in_ka = INP(I_KA) + l * 1024; const float* in_rk = INP(I_RK) + l * 1024; const float* in_sh = INP(I_RWSH) + (size_t)l * 8 * 3328;
    for (int item = gw; item < 16640; item += nwv) {
        int b, run, hd, T, row0; bool prompt;
        if (item < 16384) { prompt = true; hd = item & 15; run = (item >> 4) & 511; b = item >> 13; T = 4096; row0 = b * 4096; }
        else { const int j = item - 16384; prompt = false; hd = j & 15; run = (j >> 4) & 1; b = j >> 5; T = 16; row0 = NTOK_P + 16 * b; }
        const int col = hd * 64 + lane, t0 = 8 * run;
        const float mu_r = in_mu[col], mu_k = in_mu[1024 + col], mu_v = in_mu[2048 + col], k_k = in_kk[col], k_a = in_ka[col], r_k = in_rk[col];
        float pr, pk, pv;
        if (t0 > 0) { const bf16_t* zp = z + (size_t)(row0 + t0 - 1) * ZLD + ZR + col; pr = bf2f(zp[0]); pk = bf2f(zp[1024]); pv = bf2f(zp[2048]); }
        else if (prompt) { pr = 0.f; pk = 0.f; pv = 0.f; }
        else { const float* sp = in_sh + (size_t)b * 3328 + col; pr = sp[0]; pk = sp[1024]; pv = sp[2048]; }
        float zr[8], zk[9], zv[8], aa[8];
#pragma unroll
        for (int j = 0; j < 8; ++j) { const bf16_t* zp = z + (size_t)(row0 + t0 + j) * ZLD + ZR + col; zr[j] = bf2f(zp[0]); zk[j] = bf2f(zp[1024]); zv[j] = bf2f(zp[2048]); aa[j] = lout[(size_t)(row0 + t0 + j) * 3072 + 1024 + col]; }
        { const int t = t0 + 8 < T ? t0 + 8 : T - 1; zk[8] = bf2f(z[(size_t)(row0 + t) * ZLD + ZR + 1024 + col]); }
        float xk[9], kkn[9];
#pragma unroll
        for (int j = 0; j < 9; ++j) { xk[j] = zk[j] + (pk - zk[j]) * mu_k; pk = zk[j]; const float kk = xk[j] * k_k; const float ss = wave_sum_dpp(kk * kk); kkn[j] = (t0 + j < T) ? kk / fmaxf(sqrtf(ss), 1e-12f) : 0.f; }
#pragma unroll
        for (int j = 0; j < 8; ++j) { const size_t row = (size_t)(row0 + t0 + j);
            const float xr = zr[j] + (pr - zr[j]) * mu_r, xv = zv[j] + (pv - zv[j]) * mu_v; pr = zr[j]; pv = zv[j];
            const float a = aa[j], km = xk[j] * (1.0f + (a - 1.0f) * k_a), bq = kkn[j] * a;
            const float cc = wave_sum_dpp(bq * -kkn[j + 1]), dd = wave_sum_dpp(bq * xr), rk = wave_sum_dpp(xr * km * r_k);
            VR[row * 1024 + col] = xr; VK[row * 1024 + col] = km; VA[row * 1024 + col] = -kkn[j]; VB[row * 1024 + col] = bq; VV[row * 1024 + col] = xv;
            if (lane == 0) { *(f32x2*)(CD + ((size_t)hd * MP + row) * 2) = (f32x2){cc, dd}; rkb[row * 16 + hd] = rk; } }
    }
}
DI void rwkv_flush_y(ldsp_t lds, float* __restrict ybuf, int c, int lane, int T, int row0, int hd, int qd) {
    const LAS float* ysh = (const LAS float*)(lds + RW_YOFF) + (c & 1) * 512;
#pragma unroll
    for (int i = 0; i < 8; ++i) { const int e = lane + 64 * i, tl = e >> 4, rr = e & 15, t = 32 * c + tl; if (t < T) ybuf[(size_t)(row0 + t) * 1024 + hd * 64 + 16 * qd + rr] = ysh[e]; }
}
DI void rwkv_dma_chunk(ldsp_t lds, const unsigned char* __restrict ws, int c, int lane, int T, int row0, int hd, int qd) {
    const int buf = (c & 1) * RW_BUF, t0 = 32 * c, l4 = lane >> 4, c4 = 4 * (lane & 15);
    const float* VR = (const float*)(ws + WS_VR); const float* VK = (const float*)(ws + WS_VK); const float* VA = (const float*)(ws + WS_VA); const float* VB = (const float*)(ws + WS_VB);
    const float* VV = (const float*)(ws + WS_VV); const float* CD = (const float*)(ws + WS_CD); const float* W = (const float*)(ws + WS_LOUT);
#pragma unroll
    for (int i = 0; i < 8; ++i) { const int t = t0 + 4 * i + l4 < T ? t0 + 4 * i + l4 : T - 1; const size_t off = (size_t)(row0 + t) * 1024 + hd * 64 + c4;
        __builtin_amdgcn_global_load_lds((const unsigned*)(VR + off), (LAS unsigned*)(lds + buf + RW_R + i * 1024), 16, 0, 0);
        __builtin_amdgcn_global_load_lds((const unsigned*)(W + (size_t)(row0 + t) * 3072 + hd * 64 + c4), (LAS unsigned*)(lds + buf + RW_W + i * 1024), 16, 0, 0);
        __builtin_amdgcn_global_load_lds((const unsigned*)(VK + off), (LAS unsigned*)(lds + buf + RW_K + i * 1024), 16, 0, 0);
        __builtin_amdgcn_global_load_lds((const unsigned*)(VB + off), (LAS unsigned*)(lds + buf + RW_B + i * 1024), 16, 0, 0); }
#pragma unroll
    for (int i = 0; i < 9; ++i) { const int t = t0 + 4 * i + l4 < T ? t0 + 4 * i + l4 : T - 1;
        __builtin_amdgcn_global_load_lds((const unsigned*)(VA + (size_t)(row0 + t) * 1024 + hd * 64 + c4), (LAS unsigned*)(lds + buf + RW_A + i * 1024), 16, 0, 0); }
#pragma unroll
    for (int i = 0; i < 2; ++i) { const int t = t0 + 16 * i + (lane >> 2) < T ? t0 + 16 * i + (lane >> 2) : T - 1;
        __builtin_amdgcn_global_load_lds((const unsigned*)(VV + (size_t)(row0 + t) * 1024 + hd * 64 + 16 * qd + 4 * (lane & 3)), (LAS unsigned*)(lds + buf + RW_V + i * 1024), 16, 0, 0); }
    { const int t = t0 + 2 * lane < T - 1 ? t0 + 2 * lane : T - 2;
      __builtin_amdgcn_global_load_lds((const unsigned*)(CD + ((size_t)hd * MP + row0 + t) * 2), (LAS unsigned*)(lds + buf + RW_CD), 16, 0, 0); }
}
DI void rwkv_item(const Params& P, ldsp_t lds, int l, int b, int hd, int qd, bool prompt) {
    const int tid = vtid(), lane = tid & 63, wave = __builtin_amdgcn_readfirstlane(tid >> 6);
    unsigned char* ws = wsp(P); float* out = outp(P); float* ybuf = (float*)(ws + WS_YB);
    const int T = prompt ? 4096 : 16, row0 = prompt ? b * 4096 : NTOK_P + 16 * b, nc = (T + 31) / 32;
#define RW_BAR() do { asm volatile("s_waitcnt lgkmcnt(0)" ::: "memory"); __builtin_amdgcn_s_barrier(); asm volatile("" ::: "memory"); } while (0)
    if (wave >= 4) {
        if (wave == 4) { rwkv_dma_chunk(lds, ws, 0, lane, T, row0, hd, qd); asm volatile("s_waitcnt vmcnt(0)" ::: "memory"); }
        RW_BAR();
        for (int c = 0; c < nc; ++c) {
            if (wave == 4) { if (c + 1 < nc) rwkv_dma_chunk(lds, ws, c + 1, lane, T, row0, hd, qd);
                if (c >= 1) rwkv_flush_y(lds, ybuf, c - 1, lane, T, row0, hd, qd);
                asm volatile("s_waitcnt vmcnt(0)" ::: "memory"); }
            RW_BAR(); }
        if (wave == 4) rwkv_flush_y(lds, ybuf, nc - 1, lane, T, row0, hd, qd);
    } else {
        const int si = lane >> 4, cg = lane & 15, vrow = 16 * qd + 4 * wave + si;
        f32x4 S = {0.f, 0.f, 0.f, 0.f};
        if (!prompt) S = *(const f32x4*)(INP(I_RWS) + (((size_t)(l * 8 + b) * 16 + hd) * 64 + vrow) * 64 + 4 * cg);
        RW_BAR();
        float sa;
        { const f32x4 a0 = *(const LAS f32x4*)(lds + RW_A + 16 * cg); sa = row16_sum((S[0] * a0[0] + S[1] * a0[1]) + (S[2] * a0[2] + S[3] * a0[3])); }
        for (int c = 0; c < nc; ++c) {
            const LAS unsigned char* Lb = lds + (c & 1) * RW_BUF + 16 * cg; const LAS float* Vq = (const LAS float*)(lds + (c & 1) * RW_BUF + RW_V) + 4 * wave + si; const LAS f32x2* CD = (const LAS f32x2*)(lds + (c & 1) * RW_BUF + RW_CD);
            LAS float* ysh = (LAS float*)(lds + RW_YOFF) + (cg == 0 ? (c & 1) * 512 + 4 * wave + si : 1024 + tid); const int ystep = cg == 0 ? 16 : 0;
            const int ns = (T - 32 * c) < 32 ? (T - 32 * c) : 32;
#define RW_LOAD(R_, W_, K_, A_, B_, V_, C_, t_) do { const int tq = (t_) < ns ? (t_) : ns - 1; \
                R_ = *(const LAS f32x4*)(Lb + RW_R + tq * 256); W_ = *(const LAS f32x4*)(Lb + RW_W + tq * 256); K_ = *(const LAS f32x4*)(Lb + RW_K + tq * 256); \
                A_ = *(const LAS f32x4*)(Lb + RW_A + (tq + 1) * 256); B_ = *(const LAS f32x4*)(Lb + RW_B + tq * 256); V_ = Vq[tq * 16]; C_ = CD[tq]; } while (0)
#define RW_DOT(P_, X_) (((f32x2){P_[2], P_[3]} * (f32x2){X_[2], X_[3]} + (f32x2){P_[0], P_[1]} * (f32x2){X_[0], X_[1]}))
#define RW_STEP2(R0, W0, K0, A0, B0, V0, C0, R1, W1, K1, A1, B1, V1, C1, t_) do { \
                const f32x4 P0 = S * W0 + K0 * V0; const f32x4 S0 = P0 + B0 * sa; const f32x4 P1 = S0 * W1 + K1 * V1; \
                const f32x2 e0 = RW_DOT(P0, A0), e1 = RW_DOT(P0, R0), e2 = RW_DOT(P1, A1), e3 = RW_DOT(P1, R1); \
                float q0 = e0.x + e0.y, u0 = e1.x + e1.y, q1 = e2.x + e2.y, u1 = e3.x + e3.y; \
                q0 += dppf<0xB1>(q0); q1 += dppf<0xB1>(q1); u0 += dppf<0xB1>(u0); u1 += dppf<0xB1>(u1); \
                q0 += dppf<0x4E>(q0); q1 += dppf<0x4E>(q1); u0 += dppf<0x4E>(u0); u1 += dppf<0x4E>(u1); \
                q0 += dppf<0x141>(q0); q1 += dppf<0x141>(q1); u0 += dppf<0x141>(u0); u1 += dppf<0x141>(u1); \
                q0 += dppf<0x140>(q0); q1 += dppf<0x140>(q1); u0 += dppf<0x140>(u0); u1 += dppf<0x140>(u1); \
                const float sa1 = q0 + sa * C0.x; ysh[(t_) * ystep] = u0 + sa * C0.y; \
                S = P1 + B1 * sa1; ysh[((t_) + 1) * ystep] = u1 + sa1 * C1.y; sa = q1 + sa1 * C1.x; } while (0)
            f32x4 rA, wA, kA, aA, bA, rB, wB, kB, aB, bB, rC, wC, kC, aC, bC, rD, wD, kD, aD, bD; float vA, vB, vC, vD; f32x2 cA, cB, cC, cD;
            RW_LOAD(rA, wA, kA, aA, bA, vA, cA, 0); RW_LOAD(rB, wB, kB, aB, bB, vB, cB, 1);
            for (int t = 0; t < ns; t += 4) {
                RW_LOAD(rC, wC, kC, aC, bC, vC, cC, t + 2); RW_LOAD(rD, wD, kD, aD, bD, vD, cD, t + 3);
                RW_STEP2(rA, wA, kA, aA, bA, vA, cA, rB, wB, kB, aB, bB, vB, cB, t);
                RW_LOAD(rA, wA, kA, aA, bA, vA, cA, t + 4); RW_LOAD(rB, wB, kB, aB, bB, vB, cB, t + 5);
                RW_STEP2(rC, wC, kC, aC, bC, vC, cC, rD, wD, kD, aD, bD, vD, cD, t + 2); }
#undef RW_DOT
#undef RW_STEP2
#undef RW_LOAD
            RW_BAR(); }
        float* so = out + (prompt ? O_PS + (((size_t)(l * 2 + b) * 16 + hd) * 64 + vrow) * 64 : O_SS + (((size_t)(l * 8 + b) * 16 + hd) * 64 + vrow) * 64) + 4 * cg; *(f32x4*)so = S;
    }
#undef RW_BAR
    __syncthreads();
}
DI void rwkv_post(const Params& P, int l) {
    const int lane = vtid() & 63, gw = sbid() * 8 + (vtid() >> 6), nwv = gridDim.x * 8;
    unsigned char* ws = wsp(P); const float* in_rwsh = INP(I_RWSH); const bf16_t* z = (const bf16_t*)(ws + WS_Z); const float* lout = (const float*)(ws + WS_LOUT); const float* ybuf = (const float*)(ws + WS_YB);
    const float* rkb = (const float*)(ws + WS_RK); bf16_t* oall = (bf16_t*)(ws + WS_OALL);
    const int hd = lane >> 2, c0 = hd * 64 + (lane & 3) * 16;
    f32x4 lg[4], lb[4], muv[4];
#pragma unroll
    for (int i = 0; i < 4; ++i) { lg[i] = *(const f32x4*)(INP(I_LNG) + l * 1024 + c0 + 4 * i); lb[i] = *(const f32x4*)(INP(I_LNB) + l * 1024 + c0 + 4 * i); muv[i] = *(const f32x4*)(INP(I_MU) + (size_t)l * 3328 + 2048 + c0 + 4 * i); }
    for (int row = gw; row < NTOK; row += nwv) {
        const bool pr = row < NTOK_P; const int s = row_stream(row), b = pr ? s : s - 2, t = pr ? (row & 4095) : ((row - NTOK_P) & 15);
        f32x4 y[4]; float sm = 0.f;
#pragma unroll
        for (int i = 0; i < 4; ++i) { y[i] = *(const f32x4*)(ybuf + (size_t)row * 1024 + c0 + 4 * i); sm += (y[i][0] + y[i][1]) + (y[i][2] + y[i][3]); }
        sm += dppf<0xB1>(sm); sm += dppf<0x4E>(sm); const float mean = sm * (1.0f / 64.0f); float q = 0.f;
#pragma unroll
        for (int i = 0; i < 4; ++i) { const f32x4 d = y[i] - mean; q += (d[0] * d[0] + d[1] * d[1]) + (d[2] * d[2] + d[3] * d[3]); }
        q += dppf<0xB1>(q); q += dppf<0x4E>(q); const float rstd = rsqrtf(q * (1.0f / 64.0f) + 64e-5f);
        const float rk = rkb[(size_t)row * 16 + hd];
        const bf16_t* zv = z + (size_t)row * ZLD + ZRV + c0; const float* gp = lout + (size_t)row * 3072 + 2048 + c0;
        u32x4 cw0 = *(const u32x4*)zv, cw1 = *(const u32x4*)(zv + 8), pw0 = {0u, 0u, 0u, 0u}, pw1 = pw0; float pf[16];
        if (t > 0) { pw0 = *(const u32x4*)(zv - ZLD); pw1 = *(const u32x4*)(zv - ZLD + 8); }
        const unsigned cw[8] = {cw0.x, cw0.y, cw0.z, cw0.w, cw1.x, cw1.y, cw1.z, cw1.w}, pw[8] = {pw0.x, pw0.y, pw0.z, pw0.w, pw1.x, pw1.y, pw1.z, pw1.w};
#pragma unroll
        for (int j = 0; j < 8; ++j) { pf[2 * j] = lo16(pw[j]); pf[2 * j + 1] = hi16(pw[j]); }
        if (t == 0 && !pr) { const float* sp = in_rwsh + (size_t)(l * 8 + b) * 3328 + 2048 + c0;
#pragma unroll
            for (int j = 0; j < 16; ++j) pf[j] = sp[j]; }
        unsigned ow[8];
#pragma unroll
        for (int i = 0; i < 4; ++i) { const f32x4 g = *(const f32x4*)(gp + 4 * i); float o[4];
#pragma unroll
            for (int j = 0; j < 4; ++j) { const int e = 4 * i + j; const float zc = (e & 1) ? hi16(cw[e >> 1]) : lo16(cw[e >> 1]); const float xv = zc + (pf[e] - zc) * muv[i][j];
                o[j] = (((y[i][j] - mean) * rstd) * lg[i][j] + lb[i][j] + rk * xv) * g[j]; }
            ow[2 * i] = pack2(o[0], o[1]); ow[2 * i + 1] = pack2(o[2], o[3]); }
        bf16_t* op = oall + (size_t)2 * MP * 1024 + (size_t)row * 1024 + c0;
        *(u32x4*)op = (u32x4){ow[0], ow[1], ow[2], ow[3]}; *(u32x4*)(op + 8) = (u32x4){ow[4], ow[5], ow[6], ow[7]};
    }
}

struct AttnOut { float m, l; f32x16 o[4]; };
DI void attn_wave(AttnOut& R, const bf16_t* __restrict z, const bf16_t* __restrict qR, const bf16_t* __restrict Kn, const bf16_t* __restrict krA, const bf16_t* __restrict Vt,
                  int qrow, int hd, int kbase, int kb_lo, int kb_hi, int nvalid, int lane) {
    const int r = lane & 31, hh = lane >> 5;
    bf16x8 qf[12];
#pragma unroll
    for (int ks = 0; ks < 8; ++ks) qf[ks] = *(const bf16x8*)(z + (size_t)qrow * ZLD + ZQA + hd * 192 + 16 * ks + 8 * hh);
#pragma unroll
    for (int ks = 0; ks < 4; ++ks) qf[8 + ks] = *(const bf16x8*)(qR + (size_t)qrow * 512 + hd * 64 + 16 * ks + 8 * hh);
    float m = -1e30f, l = 0.f; f32x16 o0 = zero16(), o1 = zero16(), o2 = zero16(), o3 = zero16();
    const float sc = 0.07216878364870322f * 1.4426950408889634f;
    for (int kb = kb_lo; kb < kb_hi; ++kb) {
        const size_t key = (size_t)kbase + 32 * kb + r;
        const bf16_t* kp = Kn + key * 1024 + hd * 128 + 8 * hh; const bf16_t* kp2 = krA + key * 64 + 8 * hh;
        f32x16 st = zero16();
#pragma unroll
        for (int ks = 0; ks < 8; ++ks) { const bf16x8 a = *(const bf16x8*)(kp + 16 * ks); st = MFMA32(a, qf[ks], st); }
#pragma unroll
        for (int ks = 0; ks < 4; ++ks) { const bf16x8 a = *(const bf16x8*)(kp2 + 16 * ks); st = MFMA32(a, qf[8 + ks], st); }
        const bool tail = (32 * kb + 32 > nvalid); float mx = -1e30f;
#pragma unroll
        for (int i = 0; i < 16; ++i) { float s = st[i] * sc; if (tail && (32 * kb + crow(i, hh) >= nvalid)) s = -1e30f; st[i] = s; mx = fmaxf(mx, s); }
        mx = fmaxf(mx, __shfl_xor(mx, 32));
        const float mnew = fmaxf(m, mx), alpha = __builtin_amdgcn_exp2f(m - mnew); float ls = 0.f;
#pragma unroll
        for (int i = 0; i < 16; ++i) { const float p = __builtin_amdgcn_exp2f(st[i] - mnew); st[i] = p; ls += p; }
        l = l * alpha + ls; m = mnew;
        o0 *= alpha; o1 *= alpha; o2 *= alpha; o3 *= alpha;
        const bf16_t* vp = Vt + (size_t)(hd * 128 + r) * KEYS + kbase + 32 * kb + 4 * hh;
#pragma unroll
        for (int s2 = 0; s2 < 2; ++s2) {
            u32x4 pw; pw.x = pack2(st[8 * s2 + 0], st[8 * s2 + 1]); pw.y = pack2(st[8 * s2 + 2], st[8 * s2 + 3]); pw.z = pack2(st[8 * s2 + 4], st[8 * s2 + 5]); pw.w = pack2(st[8 * s2 + 6], st[8 * s2 + 7]);
            const bf16x8 pb = __builtin_bit_cast(bf16x8, pw);
            { const s16x4 lo = *(const s16x4*)(vp + 16 * s2), hi = *(const s16x4*)(vp + 16 * s2 + 8); o0 = MFMA32(__builtin_shufflevector(lo, hi, 0, 1, 2, 3, 4, 5, 6, 7), pb, o0); }
            { const s16x4 lo = *(const s16x4*)(vp + (size_t)32 * KEYS + 16 * s2), hi = *(const s16x4*)(vp + (size_t)32 * KEYS + 16 * s2 + 8); o1 = MFMA32(__builtin_shufflevector(lo, hi, 0, 1, 2, 3, 4, 5, 6, 7), pb, o1); }
            { const s16x4 lo = *(const s16x4*)(vp + (size_t)64 * KEYS + 16 * s2), hi = *(const s16x4*)(vp + (size_t)64 * KEYS + 16 * s2 + 8); o2 = MFMA32(__builtin_shufflevector(lo, hi, 0, 1, 2, 3, 4, 5, 6, 7), pb, o2); }
            { const s16x4 lo = *(const s16x4*)(vp + (size_t)96 * KEYS + 16 * s2), hi = *(const s16x4*)(vp + (size_t)96 * KEYS + 16 * s2 + 8); o3 = MFMA32(__builtin_shufflevector(lo, hi, 0, 1, 2, 3, 4, 5, 6, 7), pb, o3); }
        }
    }
    R.m = m; R.l = l; R.o[0] = o0; R.o[1] = o1; R.o[2] = o2; R.o[3] = o3;
}
constexpr int AT_KP = 200, AT_VP = 72, AT_KBYTES = 64 * AT_KP * 2, AT_BUF = AT_KBYTES + 128 * AT_VP * 2;
DI void attn_prompt_item(const Params& P, ldsp_t lds, int item) {
    const int tid = vtid(), lane = tid & 63, wave = tid >> 6; unsigned char* ws = wsp(P);
    const bf16_t* z = (const bf16_t*)(ws + WS_Z); const bf16_t* qR = (const bf16_t*)(ws + WS_QR); bf16_t* oall = (bf16_t*)(ws + WS_OALL);
    const int bh = item >> 4, jb = item & 15, b = bh >> 3, hd = bh & 7;
    const int qblk = wave < 4 ? 4 * jb + wave : 127 - (4 * jb + wave - 4);
    const int r = lane & 31, hh = lane >> 5, qrow = b * 4096 + 32 * qblk + r, mych = (qblk >> 1) + 1, nch = 64 - 2 * jb, kbase = b * 4096;
    bf16x8 qf[12];
#pragma unroll
    for (int ks = 0; ks < 8; ++ks) qf[ks] = *(const bf16x8*)(z + (size_t)qrow * ZLD + ZQA + hd * 192 + 16 * ks + 8 * hh);
#pragma unroll
    for (int ks = 0; ks < 4; ++ks) qf[8 + ks] = *(const bf16x8*)(qR + (size_t)qrow * 512 + hd * 64 + 16 * ks + 8 * hh);
    const bf16_t* gk0 = (const bf16_t*)(ws + WS_KN) + (size_t)(kbase + (tid >> 4)) * 1024 + hd * 128 + 8 * (tid & 15);
    const bf16_t* gk2 = (const bf16_t*)(ws + WS_KRA) + (size_t)(kbase + (tid >> 3)) * 64 + 8 * (tid & 7);
    const bf16_t* gv0 = (const bf16_t*)(ws + WS_VT) + (size_t)(hd * 128 + (tid >> 3)) * KEYS + kbase + 8 * (tid & 7);
    const int lk0 = ((tid >> 4) * AT_KP + 8 * (tid & 15)) * 2, lk1 = lk0 + 32 * AT_KP * 2, lk2 = ((tid >> 3) * AT_KP + 128 + 8 * (tid & 7)) * 2;
    const int lv0 = AT_KBYTES + ((tid >> 3) * AT_VP + 8 * (tid & 7)) * 2, lv1 = lv0 + 64 * AT_VP * 2;
    u32x4 p0 = *(const u32x4*)gk0, p1 = *(const u32x4*)(gk0 + 32 * 1024), p2 = *(const u32x4*)gk2, p3 = *(const u32x4*)gv0, p4 = *(const u32x4*)(gv0 + (size_t)64 * KEYS);
    *(LAS u32x4*)(lds + lk0) = p0; *(LAS u32x4*)(lds + lk1) = p1; *(LAS u32x4*)(lds + lk2) = p2; *(LAS u32x4*)(lds + lv0) = p3; *(LAS u32x4*)(lds + lv1) = p4;
    __syncthreads();
    float m = -1e30f, l = 0.f; f32x16 o0 = zero16(), o1 = zero16(), o2 = zero16(), o3 = zero16();
    const float sc = 0.07216878364870322f * 1.4426950408889634f;
    for (int ch = 0; ch < nch; ++ch) {
        const bool more = ch + 1 < nch;
        if (more) { const size_t c1 = (size_t)(ch + 1) * 64;
            p0 = *(const u32x4*)(gk0 + c1 * 1024); p1 = *(const u32x4*)(gk0 + c1 * 1024 + 32 * 1024); p2 = *(const u32x4*)(gk2 + c1 * 64); p3 = *(const u32x4*)(gv0 + c1); p4 = *(const u32x4*)(gv0 + (size_t)64 * KEYS + c1); }
        if (ch < mych) { const LAS bf16_t* Ks = (const LAS bf16_t*)(lds + (ch & 1) * AT_BUF); const LAS bf16_t* Vs = (const LAS bf16_t*)(lds + (ch & 1) * AT_BUF + AT_KBYTES);
#pragma unroll
            for (int j = 0; j < 2; ++j) {
                const LAS bf16_t* kp = Ks + (32 * j + r) * AT_KP + 8 * hh; f32x16 st = zero16();
#pragma unroll
                for (int ks = 0; ks < 12; ++ks) { const bf16x8 a = *(const LAS bf16x8*)(kp + 16 * ks); st = MFMA32(a, qf[ks], st); }
                float mx = -1e30f;
#pragma unroll
                for (int i = 0; i < 16; ++i) { st[i] *= sc; mx = fmaxf(mx, st[i]); }
                mx = fmaxf(mx, __shfl_xor(mx, 32));
                const float mnew = fmaxf(m, mx), alpha = __builtin_amdgcn_exp2f(m - mnew); float ls = 0.f;
#pragma unroll
                for (int i = 0; i < 16; ++i) { const float p = __builtin_amdgcn_exp2f(st[i] - mnew); st[i] = p; ls += p; }
                l = l * alpha + ls; m = mnew; o0 *= alpha; o1 *= alpha; o2 *= alpha; o3 *= alpha;
                const LAS bf16_t* vp = Vs + r * AT_VP + 32 * j + 4 * hh;
#pragma unroll
                for (int s2 = 0; s2 < 2; ++s2) {
                    u32x4 pw; pw.x = pack2(st[8 * s2 + 0], st[8 * s2 + 1]); pw.y = pack2(st[8 * s2 + 2], st[8 * s2 + 3]); pw.z = pack2(st[8 * s2 + 4], st[8 * s2 + 5]); pw.w = pack2(st[8 * s2 + 6], st[8 * s2 + 7]);
                    const bf16x8 pb = __builtin_bit_cast(bf16x8, pw);
                    { const s16x4 lo = *(const LAS s16x4*)(vp + 16 * s2), hi = *(const LAS s16x4*)(vp + 16 * s2 + 8); o0 = MFMA32(__builtin_shufflevector(lo, hi, 0, 1, 2, 3, 4, 5, 6, 7), pb, o0); }
                    { const s16x4 lo = *(const LAS s16x4*)(vp + 32 * AT_VP + 16 * s2), hi = *(const LAS s16x4*)(vp + 32 * AT_VP + 16 * s2 + 8); o1 = MFMA32(__builtin_shufflevector(lo, hi, 0, 1, 2, 3, 4, 5, 6, 7), pb, o1); }
                    { const s16x4 lo = *(const LAS s16x4*)(vp + 64 * AT_VP + 16 * s2), hi = *(const LAS s16x4*)(vp + 64 * AT_VP + 16 * s2 + 8); o2 = MFMA32(__builtin_shufflevector(lo, hi, 0, 1, 2, 3, 4, 5, 6, 7), pb, o2); }
                    { const s16x4 lo = *(const LAS s16x4*)(vp + 96 * AT_VP + 16 * s2), hi = *(const LAS s16x4*)(vp + 96 * AT_VP + 16 * s2 + 8); o3 = MFMA32(__builtin_shufflevector(lo, hi, 0, 1, 2, 3, 4, 5, 6, 7), pb, o3); }
                } } }
        if (more) { const int bo = ((ch + 1) & 1) * AT_BUF;
            *(LAS u32x4*)(lds + bo + lk0) = p0; *(LAS u32x4*)(lds + bo + lk1) = p1; *(LAS u32x4*)(lds + bo + lk2) = p2; *(LAS u32x4*)(lds + bo + lv0) = p3; *(LAS u32x4*)(lds + bo + lv1) = p4; }
        __syncthreads();
    }
    const float lt = l + __shfl_xor(l, 32), inv = 1.0f / lt;
    bf16_t* op = oall + (size_t)MP * 1024 + (size_t)qrow * 1024 + hd * 128;
#pragma unroll
    for (int g = 0; g < 4; ++g) { u32x2 w;
        w.x = pack2(o0[4 * g] * inv, o0[4 * g + 1] * inv); w.y = pack2(o0[4 * g + 2] * inv, o0[4 * g + 3] * inv); *(u32x2*)(op + 8 * g + 4 * hh) = w;
        w.x = pack2(o1[4 * g] * inv, o1[4 * g + 1] * inv); w.y = pack2(o1[4 * g + 2] * inv, o1[4 * g + 3] * inv); *(u32x2*)(op + 32 + 8 * g + 4 * hh) = w;
        w.x = pack2(o2[4 * g] * inv, o2[4 * g + 1] * inv); w.y = pack2(o2[4 * g + 2] * inv, o2[4 * g + 3] * inv); *(u32x2*)(op + 64 + 8 * g + 4 * hh) = w;
        w.x = pack2(o3[4 * g] * inv, o3[4 * g + 1] * inv); w.y = pack2(o3[4 * g + 2] * inv, o3[4 * g + 3] * inv); *(u32x2*)(op + 96 + 8 * g + 4 * hh) = w; }
}
DI void attn_sample_item(const Params& P, ldsp_t lds, int item) {
    const int tid = vtid(), lane = tid & 63, wave = tid >> 6; unsigned char* ws = wsp(P);
    const bf16_t* z = (const bf16_t*)(ws + WS_Z); bf16_t* oall = (bf16_t*)(ws + WS_OALL);
    const int b = item >> 3, hd = item & 7, r = lane & 31, hh = lane >> 5;
    const int qrow = NTOK_P + 16 * b + (r < 16 ? r : 15);
    const int lo = wave == 0 ? 0 : 9 + 8 * (wave - 1), hi = 9 + 8 * wave;
    AttnOut R;
    attn_wave(R, z, (const bf16_t*)(ws + WS_QR), (const bf16_t*)(ws + WS_KN), (const bf16_t*)(ws + WS_KRA), (const bf16_t*)(ws + WS_VT), qrow, hd, NTOK_P + b * SKEY, lo, hi, 2064, lane);
    LAS float* oW = (LAS float*)lds;
    LAS float* mW = (LAS float*)(lds + LDS_MAIN);
    LAS float* lW = mW + 256;
    const float lt = R.l + __shfl_xor(R.l, 32);
    if (hh == 0) { mW[wave * 32 + r] = R.m; lW[wave * 32 + r] = lt; }
#pragma unroll
    for (int dvb = 0; dvb < 4; ++dvb)
#pragma unroll
        for (int i = 0; i < 16; ++i) oW[(wave * 128 + 32 * dvb + crow(i, hh)) * 32 + r] = R.o[dvb][i];
    __syncthreads();
    for (int e = tid; e < 128 * 16; e += 512) { const int q = e & 15, dv = e >> 4; float M = -1e30f;
#pragma unroll
        for (int w = 0; w < 8; ++w) M = fmaxf(M, mW[w * 32 + q]);
        float L = 0.f, acc = 0.f;
#pragma unroll
        for (int w = 0; w < 8; ++w) { const float f = __builtin_amdgcn_exp2f(mW[w * 32 + q] - M); L += lW[w * 32 + q] * f; acc += oW[(w * 128 + dv) * 32 + q] * f; }
        oall[(size_t)MP * 1024 + (size_t)(NTOK_P + 16 * b + q) * 1024 + hd * 128 + dv] = f2bf(acc / L); }
    __syncthreads();
}

__global__ void __launch_bounds__(512, 2) hybrid_fwd(Params P) {
    extern __shared__ __attribute__((aligned(16))) unsigned char smem[];
    ldsp_t lds = (ldsp_t)smem;
    const int tid = threadIdx.x;
    if (tid < 4) ((LAS unsigned*)(lds + LDS_XB))[tid] = 0u;
    __syncthreads();
    XcdBarrier bar = xcd_barrier_post((unsigned*)(P.ws + WS_BAR), (volatile LAS unsigned*)(lds + LDS_XB));
#define PHASE_PTRS() unsigned char* ws = wsp(P); float* xb = (float*)(ws + WS_X); bf16_t* hb = (bf16_t*)(ws + WS_H); bf16_t* act = (bf16_t*)(ws + WS_ACT); bf16_t* zb = (bf16_t*)(ws + WS_Z); const float* modl = (const float*)(ws + WS_MOD) + (size_t)l * 10 * MODLD; (void)xb; (void)hb; (void)act; (void)zb; (void)modl
#define SEAM2() do { XcdBarrier b_ = bar; { unsigned* q_ = b_.bar; asm volatile("" : "+v"(q_)); b_.bar = q_; } xcd_barrier(b_); } while (0)
#define SEAM() do { XcdBarrier b_ = bar; { unsigned* q_ = b_.bar; asm volatile("" : "+v"(q_)); b_.bar = q_; } xcd_barrier(b_); } while (0)

    prologue_phase(P, lds);
    SEAM();
    { constexpr int l = 0;
        norm_phase(P, l, 0, l == 0);
        SEAM();
        { PHASE_PTRS(); EpiSwiglu E{act}; run_gemm(lds, hb, (const bf16_t*)(ws + WS_WFI + (size_t)(l * 2 + 0) * SZ_WFI), MP, 2 * DFF, D, E); }
        SEAM();
        { PHASE_PTRS(); EpiResid E{xb, modl + 2 * D, 0.5f}; run_gemm(lds, act, (const bf16_t*)(ws + WS_WFO + (size_t)(l * 2 + 0) * SZ_WFO), NTOK_P, D, DFF, E); }
        { PHASE_PTRS(); EpiResidSample E{xb, modl + 2 * D, 0.5f}; run_gemm_splitk(lds, act + (size_t)NTOK_P * DFF, (const bf16_t*)(ws + WS_WFO + (size_t)(l * 2 + 0) * SZ_WFO), D, DFF, 256, E); }
        SEAM();
        norm_phase(P, l, 1, false);
        SEAM();
        { PHASE_PTRS(); EpiBf16Plain E{zb, ZLD}; run_gemm(lds, hb, (const bf16_t*)(ws + WS_WIN + (size_t)l * SZ_WIN), MP, ZLD, D, E); }
        SEAM();
        prep_phase(P, l);
        SEAM();
        { PHASE_PTRS(); EpiLora E{(float*)(ws + WS_LOUT), INP(I_W0) + l * 1024, INP(I_A0) + l * 1024}; run_gemm(lds, (const bf16_t*)(ws + WS_LIN), (const bf16_t*)(ws + WS_WLO + (size_t)l * SZ_WLO), MP, 3072, 256, E); }
        { PHASE_PTRS(); EpiBf16Plain E{(bf16_t*)(ws + WS_KN), 1024}; run_gemm(lds, (const bf16_t*)(ws + WS_LATA), (const bf16_t*)(ws + WS_WKK + (size_t)l * SZ_WKK), KEYS, 1024, 512, E); }
        SEAM();
        { PHASE_PTRS(); EpiBf16Plain E{(bf16_t*)(ws + WS_VT), KEYS}; run_gemm(lds, (const bf16_t*)(ws + WS_WKV + (size_t)l * SZ_WKK), (const bf16_t*)(ws + WS_LATA), 1024, KEYS, 512, E); }
        mlstm_pass_a(P, lds, l);
        rwkv_pre(P, l);
        SEAM();
        { const int G = gridDim.x, nR = G / 2, bx = blockIdx.x;
          if (bx < nR) { for (int i0 = bx; i0 < 128; i0 += nR) { const int it = (nR == 128) ? ((i0 & 7) * 16 + (i0 >> 3)) : i0;
              rwkv_item(P, lds, l, it >> 6, (it >> 2) & 15, it & 3, true); } } }
        { const int G = gridDim.x, nR = G / 2, bx = blockIdx.x; if (bx >= nR) { const int bb = bx - nR, nO = G - nR; for (int it = bb; it < 512; it += nO) rwkv_item(P, lds, l, it >> 6, (it >> 2) & 15, it & 3, false); } }
        { const int G = gridDim.x, nR = G / 2, bx = blockIdx.x; if (bx >= nR) { const int bb = bx - nR, nO = G - nR; for (int i0 = bb; i0 < 256; i0 += nO) { const int it = (nO == 128) ? (((i0 & 7) * 2 + (i0 >> 7)) * 16 + ((i0 >> 3) & 15)) : i0;
              attn_prompt_item(P, lds, it); } } }
        { const int G = gridDim.x, nR = G / 2, bx = blockIdx.x; if (bx >= nR) { const int bb = bx - nR, nO = G - nR; for (int it = bb; it < 64; it += nO) attn_sample_item(P, lds, it); } }
        { const int G = gridDim.x, nR = G / 2, bx = blockIdx.x; if (bx >= nR) mlstm_pass_b(P, l, (bx - nR) * 512 + vtid(), (G - nR) * 512); }
        SEAM();
        mlstm_pass_c(P, lds, l);
        rwkv_post(P, l);
        sample_mix_zero(P);
        SEAM();
        { PHASE_PTRS(); EpiBranchSeq E{zb + ZG, INP(I_BM) + (size_t)l * 3 * D, (float*)(ws + WS_ACT), (bf16_t*)(ws + WS_MIX)};
          pg8::Gemm g{(const bf16_t*)(ws + WS_OALL), (const bf16_t*)(ws + WS_WBR + (size_t)(l * 3) * SZ_WBR), NTOK_P, D, 1024, 1024, 1024, (long)1024 * 512, (long)1024 * 512, 0};
          BranchOrder S{(int)sbid(), 256}; pg8::gemm_phase<EpiBranchSeq, BranchOrder, false>((PG8_LAS unsigned char*)lds, g, S, E, nullptr); }
        for (int n = 0; n < 3; ++n) { PHASE_PTRS(); EpiBranchSample E{zb + ZG + n * D, INP(I_BM) + (size_t)l * 3 * D + n * D, (float*)(ws + WS_ACT)};
            run_gemm_splitk(lds, (const bf16_t*)(ws + WS_OALL) + (size_t)n * MP * 1024 + (size_t)NTOK_P * 1024, (const bf16_t*)(ws + WS_WBR + (size_t)(l * 3 + n) * SZ_WBR), D, 1024, 256, E); }
        SEAM();
        sample_mix_convert(P);
        SEAM();
        { PHASE_PTRS(); EpiResid E{xb, modl + 5 * D, 1.0f}; run_gemm(lds, (const bf16_t*)(ws + WS_MIX), (const bf16_t*)(ws + WS_WO + (size_t)l * SZ_WO), NTOK_P, D, D, E); }
        { PHASE_PTRS(); EpiResidSample E{xb, modl + 5 * D, 1.0f}; run_gemm_splitk(lds, (const bf16_t*)(ws + WS_MIX) + (size_t)NTOK_P * D, (const bf16_t*)(ws + WS_WO + (size_t)l * SZ_WO), D, D, 256, E); }
        SEAM();
        norm_phase(P, l, 2, false);
        SEAM();
        { PHASE_PTRS(); EpiSwiglu E{act}; run_gemm(lds, hb, (const bf16_t*)(ws + WS_WFI + (size_t)(l * 2 + 1) * SZ_WFI), MP, 2 * DFF, D, E); }
        SEAM();
        { PHASE_PTRS(); EpiResid E{xb, modl + 8 * D, 0.5f}; run_gemm(lds, act, (const bf16_t*)(ws + WS_WFO + (size_t)(l * 2 + 1) * SZ_WFO), NTOK_P, D, DFF, E); }
        { PHASE_PTRS(); EpiResidSample E{xb, modl + 8 * D, 0.5f}; run_gemm_splitk(lds, act + (size_t)NTOK_P * DFF, (const bf16_t*)(ws + WS_WFO + (size_t)(l * 2 + 1) * SZ_WFO), D, DFF, 256, E); }
        SEAM();
    }
    { constexpr int l = 1;
        norm_phase(P, l, 0, l == 0);
        SEAM();
        { PHASE_PTRS(); EpiSwiglu E{act}; run_gemm(lds, hb, (const bf16_t*)(ws + WS_WFI + (size_t)(l * 2 + 0) * SZ_WFI), MP, 2 * DFF, D, E); }
        SEAM();
        { PHASE_PTRS(); EpiResid E{xb, modl + 2 * D, 0.5f}; run_gemm(lds, act, (const bf16_t*)(ws + WS_WFO + (size_t)(l * 2 + 0) * SZ_WFO), NTOK_P, D, DFF, E); }
        { PHASE_PTRS(); EpiResidSample E{xb, modl + 2 * D, 0.5f}; run_gemm_splitk(lds, act + (size_t)NTOK_P * DFF, (const bf16_t*)(ws + WS_WFO + (size_t)(l * 2 + 0) * SZ_WFO), D, DFF, 256, E); }
        SEAM();
        norm_phase(P, l, 1, false);
        SEAM();
        { PHASE_PTRS(); EpiBf16Plain E{zb, ZLD}; run_gemm(lds, hb, (const bf16_t*)(ws + WS_WIN + (size_t)l * SZ_WIN), MP, ZLD, D, E); }
        SEAM();
        prep_phase(P, l);
        SEAM();
        { PHASE_PTRS(); EpiLora E{(float*)(ws + WS_LOUT), INP(I_W0) + l * 1024, INP(I_A0) + l * 1024}; run_gemm(lds, (const bf16_t*)(ws + WS_LIN), (const bf16_t*)(ws + WS_WLO + (size_t)l * SZ_WLO), MP, 3072, 256, E); }
        { PHASE_PTRS(); EpiBf16Plain E{(bf16_t*)(ws + WS_KN), 1024}; run_gemm(lds, (const bf16_t*)(ws + WS_LATA), (const bf16_t*)(ws + WS_WKK + (size_t)l * SZ_WKK), KEYS, 1024, 512, E); }
        SEAM();
        { PHASE_PTRS(); EpiBf16Plain E{(bf16_t*)(ws + WS_VT), KEYS}; run_gemm(lds, (const bf16_t*)(ws + WS_WKV + (size_t)l * SZ_WKK), (const bf16_t*)(ws + WS_LATA), 1024, KEYS, 512, E); }
        mlstm_pass_a(P, lds, l);
        rwkv_pre(P, l);
        SEAM();
        { const int G = gridDim.x, nR = G / 2, bx = blockIdx.x;
          if (bx < nR) { for (int i0 = bx; i0 < 128; i0 += nR) { const int it = (nR == 128) ? ((i0 & 7) * 16 + (i0 >> 3)) : i0;
              rwkv_item(P, lds, l, it >> 6, (it >> 2) & 15, it & 3, true); } } }
        { const int G = gridDim.x, nR = G / 2, bx = blockIdx.x; if (bx >= nR) { const int bb = bx - nR, nO = G - nR; for (int it = bb; it < 512; it += nO) rwkv_item(P, lds, l, it >> 6, (it >> 2) & 15, it & 3, false); } }
        { const int G = gridDim.x, nR = G / 2, bx = blockIdx.x; if (bx >= nR) { const int bb = bx - nR, nO = G - nR; for (int i0 = bb; i0 < 256; i0 += nO) { const int it = (nO == 128) ? (((i0 & 7) * 2 + (i0 >> 7)) * 16 + ((i0 >> 3) & 15)) : i0;
              attn_prompt_item(P, lds, it); } } }
        { const int G = gridDim.x, nR = G / 2, bx = blockIdx.x; if (bx >= nR) { const int bb = bx - nR, nO = G - nR; for (int it = bb; it < 64; it += nO) attn_sample_item(P, lds, it); } }
        { const int G = gridDim.x, nR = G / 2, bx = blockIdx.x; if (bx >= nR) mlstm_pass_b(P, l, (bx - nR) * 512 + vtid(), (G - nR) * 512); }
        SEAM();
        mlstm_pass_c(P, lds, l);
        rwkv_post(P, l);
        sample_mix_zero(P);
        SEAM();
        { PHASE_PTRS(); EpiBranchSeq E{zb + ZG, INP(I_BM) + (size_t)l * 3 * D, (float*)(ws + WS_ACT), (bf16_t*)(ws + WS_MIX)};
          pg8::Gemm g{(const bf16_t*)(ws + WS_OALL), (const bf16_t*)(ws + WS_WBR + (size_t)(l * 3) * SZ_WBR), NTOK_P, D, 1024, 1024, 1024, (long)1024 * 512, (long)1024 * 512, 0};
          BranchOrder S{(int)sbid(), 256}; pg8::gemm_phase<EpiBranchSeq, BranchOrder, false>((PG8_LAS unsigned char*)lds, g, S, E, nullptr); }
        for (int n = 0; n < 3; ++n) { PHASE_PTRS(); EpiBranchSample E{zb + ZG + n * D, INP(I_BM) + (size_t)l * 3 * D + n * D, (float*)(ws + WS_ACT)};
            run_gemm_splitk(lds, (const bf16_t*)(ws + WS_OALL) + (size_t)n * MP * 1024 + (size_t)NTOK_P * 1024, (const bf16_t*)(ws + WS_WBR + (size_t)(l * 3 + n) * SZ_WBR), D, 1024, 256, E); }
        SEAM();
        sample_mix_convert(P);
        SEAM();
        { PHASE_PTRS(); EpiResid E{xb, modl + 5 * D, 1.0f}; run_gemm(lds, (const bf16_t*)(ws + WS_MIX), (const bf16_t*)(ws + WS_WO + (size_t)l * SZ_WO), NTOK_P, D, D, E); }
        { PHASE_PTRS(); EpiResidSample E{xb, modl + 5 * D, 1.0f}; run_gemm_splitk(lds, (const bf16_t*)(ws + WS_MIX) + (size_t)NTOK_P * D, (const bf16_t*)(ws + WS_WO + (size_t)l * SZ_WO), D, D, 256, E); }
        SEAM();
        norm_phase(P, l, 2, false);
        SEAM();
        { PHASE_PTRS(); EpiSwiglu E{act}; run_gemm(lds, hb, (const bf16_t*)(ws + WS_WFI + (size_t)(l * 2 + 1) * SZ_WFI), MP, 2 * DFF, D, E); }
        SEAM();
        { PHASE_PTRS(); EpiResid E{xb, modl + 8 * D, 0.5f}; run_gemm(lds, act, (const bf16_t*)(ws + WS_WFO + (size_t)(l * 2 + 1) * SZ_WFO), NTOK_P, D, DFF, E); }
        { PHASE_PTRS(); EpiResidSample E{xb, modl + 8 * D, 0.5f}; run_gemm_splitk(lds, act + (size_t)NTOK_P * DFF, (const bf16_t*)(ws + WS_WFO + (size_t)(l * 2 + 1) * SZ_WFO), D, DFF, 256, E); }
        SEAM();
    }
    final_phase(P);
}

extern "C" void kernel_launch(void* const* d_in, const int* in_sizes, int n_in, void* d_out, int out_size, void* d_ws, size_t ws_size, hipStream_t stream) {
    static int grid = 0;
    if (grid == 0) {
        if (n_in != 37 || (size_t)out_size != O_END || ws_size < WS_END) { fprintf(stderr, "kernel_launch: unexpected shapes: n_in %d out %d ws %zu (need %zu)\n", n_in, out_size, ws_size, (size_t)WS_END); grid = -1; return; }
        int dev = 0, cus = 0;
        if (hipGetDevice(&dev) != hipSuccess || hipDeviceGetAttribute(&cus, hipDeviceAttributeMultiprocessorCount, dev) != hipSuccess) { grid = -1; return; }
        if (hipFuncSetAttribute((const void*)hybrid_fwd, hipFuncAttributeMaxDynamicSharedMemorySize, LDS_BYTES) != hipSuccess) { fprintf(stderr, "kernel_launch: hipFuncSetAttribute failed\n"); grid = -1; return; }
        int per_cu = 0;
        if (hipOccupancyMaxActiveBlocksPerMultiprocessor(&per_cu, (const void*)hybrid_fwd, 512, LDS_BYTES) != hipSuccess || per_cu < 1) { fprintf(stderr, "kernel_launch: occupancy query says %d\n", per_cu); }
        (void)hipGetLastError();
        grid = cus;
    }
    if (grid < 0) return;
    hipMemsetAsync((char*)d_ws + WS_BAR, 0, 16384, stream);
    Params p{};
    for (int i = 0; i < 37; ++i) p.in[i] = (const float*)d_in[i];
    p.out = (float*)d_out; p.ws = (unsigned char*)d_ws;
    hipLaunchKernelGGL(hybrid_fwd, dim3(grid), dim3(512), LDS_BYTES, stream, p);
}
```

```cpp
#include <hip/hip_runtime.h>
#include <stdint.h>
#include <stdio.h>

#define DI __device__ __forceinline__
#define LAS __attribute__((address_space(3)))
typedef LAS unsigned char* ldsp_t;
typedef unsigned short bf16_t;
typedef short bf16x8 __attribute__((ext_vector_type(8)));
typedef short s16x4 __attribute__((ext_vector_type(4)));
typedef float f32x4 __attribute__((ext_vector_type(4)));
typedef float f32x2 __attribute__((ext_vector_type(2)));
typedef float f32x16 __attribute__((ext_vector_type(16)));
typedef unsigned u32x4 __attribute__((ext_vector_type(4)));
typedef unsigned u32x2 __attribute__((ext_vector_type(2)));
typedef __bf16 bfv2 __attribute__((ext_vector_type(2)));

constexpr int D = 2048, DFF = 5632, NTOK_P = 8192, NTOK = 8320, MP = 8448, NLAYER = 2;
constexpr int ZLD = 14848, INCOLS = 14664;
constexpr int ZQM = 0, ZKM = 512, ZVM = 1024, ZOM = 2048, ZIG = 3072, ZFG = 3076;
constexpr int ZQA = 3080, ZLAT = 4616, ZKR = 5128;
constexpr int ZR = 5192, ZRK = 6216, ZRV = 7240, ZWD = 8264;
constexpr int ZG = 8520;
constexpr int SKEY = 2112, KEYS = 8192 + 8 * SKEY;
constexpr int MODLD = 18432;
constexpr int ML_ITEMS = 544, ML_CSZ = 288 * 128;

constexpr size_t O_YP = 0, O_YS = O_YP + 16777216, O_PLAT = O_YS + 262144, O_PKR = O_PLAT + 8388608, O_PC = O_PKR + 1048576, O_PN = O_PC + 524288,
                 O_PM = O_PN + 2048, O_PS = O_PM + 16, O_PSH = O_PS + 262144, O_SLAT = O_PSH + 13312, O_SKR = O_SLAT + 131072, O_SC = O_SKR + 16384,
                 O_SN = O_SC + 2097152, O_SM = O_SN + 8192, O_SS = O_SM + 64, O_SSH = O_SS + 1048576, O_END = O_SSH + 53248;

constexpr size_t al256(size_t x) { return (x + 255) & ~(size_t)255; }
constexpr size_t WS_BAR = 0;
constexpr size_t WS_MOD = WS_BAR + 16384;
constexpr size_t WS_ROPE = WS_MOD + al256((size_t)NLAYER * 10 * MODLD * 4);
constexpr size_t WS_WFI = WS_ROPE + (size_t)4096 * 32 * 8;
constexpr size_t SZ_WFI = (size_t)2 * DFF * D * 2;
constexpr size_t WS_WFO = WS_WFI + 4 * SZ_WFI;
constexpr size_t SZ_WFO = (size_t)D * DFF * 2;
constexpr size_t WS_WIN = WS_WFO + 4 * SZ_WFO;
constexpr size_t SZ_WIN = (size_t)ZLD * D * 2;
constexpr size_t WS_WKK = WS_WIN + 2 * SZ_WIN;
constexpr size_t SZ_WKK = (size_t)1024 * 512 * 2;
constexpr size_t WS_WKV = WS_WKK + 2 * SZ_WKK;
constexpr size_t WS_WLO = WS_WKV + 2 * SZ_WKK;
constexpr size_t SZ_WLO = (size_t)3072 * 256 * 2;
constexpr size_t WS_WBR = WS_WLO + 2 * SZ_WLO;
constexpr size_t SZ_WBR = (size_t)D * 1024 * 2;
constexpr size_t WS_WO = WS_WBR + 6 * SZ_WBR;
constexpr size_t SZ_WO = (size_t)D * D * 2;
constexpr size_t WS_X = WS_WO + 2 * SZ_WO;
constexpr size_t WS_H = WS_X + (size_t)MP * D * 4;
constexpr size_t WS_ACT = WS_H + (size_t)MP * D * 2;
constexpr size_t WS_Z = WS_ACT + (size_t)MP * DFF * 2;
constexpr size_t WS_QR = WS_Z + (size_t)MP * ZLD * 2;
constexpr size_t WS_LATA = WS_QR + (size_t)MP * 512 * 2;
constexpr size_t WS_KRA = WS_LATA + (size_t)KEYS * 512 * 2;
constexpr size_t WS_KN = WS_KRA + (size_t)KEYS * 64 * 2;
constexpr size_t WS_VT = WS_KN + (size_t)KEYS * 1024 * 2;
constexpr size_t WS_LIN = WS_VT + (size_t)KEYS * 1024 * 2;
constexpr size_t WS_LOUT = WS_LIN + (size_t)MP * 256 * 2;
constexpr size_t WS_OALL = WS_LOUT + (size_t)MP * 3072 * 4;
constexpr size_t WS_MIX = WS_OALL + (size_t)MP * 3072 * 2;
constexpr size_t WS_YB = WS_MIX + (size_t)MP * D * 2;
constexpr size_t WS_RK = WS_YB + (size_t)MP * 1024 * 4;
constexpr size_t WS_NUML = WS_RK + (size_t)MP * 16 * 4;
constexpr size_t WS_DENL = WS_NUML + (size_t)ML_ITEMS * 16 * 1024 * 4;
constexpr size_t WS_MLG = WS_DENL + (size_t)NTOK * 4 * 4;
constexpr size_t WS_DC = WS_MLG + (size_t)NTOK * 8 * 4;
constexpr size_t WS_MLI = WS_DC + (size_t)ML_ITEMS * ML_CSZ * 4;
constexpr size_t WS_VV = WS_MLI + al256((size_t)ML_ITEMS * 4 * 4);
constexpr size_t WS_END = WS_VV + (size_t)MP * 1024 * 4;
constexpr size_t WS_VR = WS_ACT, WS_VK = WS_ACT + (size_t)MP * 1024 * 4, WS_VA = WS_H, WS_VB = WS_MIX, WS_CD = WS_LIN;

constexpr int LDS_MAIN = 131072, LDS_XB = LDS_MAIN + 2048, LDS_BYTES = LDS_MAIN + 2048 + 256;

struct Params { const float* in[37]; float* out; unsigned char* ws; };
enum { I_XP = 0, I_XS, I_CP, I_CS, I_CLAT, I_CKR, I_MLC, I_MLN, I_MLM, I_RWS, I_RWSH, I_ADAW, I_ADAB, I_NORMG, I_FWI, I_FWO, I_WIN, I_MLIB, I_MLFB, I_MLHG,
       I_KVG, I_WKVB, I_MU, I_W0, I_W2, I_A0, I_A2, I_G2, I_KK, I_KA, I_RK, I_LNG, I_LNB, I_WBR, I_BM, I_WOUT, I_FNG };

DI int vtid() { int t = threadIdx.x; asm volatile("" : "+v"(t)); return t; }
DI int sbid() { int b = blockIdx.x; asm volatile("" : "+s"(b)); return b; }
DI int opq(int x) { asm volatile("" : "+s"(x)); return x; }
#define INP(i) (P.in[opq(i)])
DI unsigned char* relaunder(const void* p) { unsigned lo = (unsigned)(size_t)p, hi = (unsigned)((size_t)p >> 32); asm volatile("" : "+v"(lo), "+v"(hi));
    lo = __builtin_amdgcn_readfirstlane(lo); hi = __builtin_amdgcn_readfirstlane(hi); return (unsigned char*)(((size_t)hi << 32) | lo); }
DI unsigned char* wsp(const Params& P) { return relaunder(P.ws); }
DI float* outp(const Params& P) { return (float*)relaunder(P.out); }
DI float bf2f(bf16_t b) { return __uint_as_float(((unsigned)b) << 16); }
DI unsigned pack2(float lo, float hi) { f32x2 v = {lo, hi}; return __builtin_bit_cast(unsigned, __builtin_convertvector(v, bfv2)); }
DI bf16_t f2bf(float f) { return (bf16_t)(pack2(f, 0.f) & 0xffffu); }
DI float lo16(unsigned w) { return __uint_as_float(w << 16); }
DI float hi16(unsigned w) { return __uint_as_float(w & 0xffff0000u); }
DI float wave_sum(float v) { for (int o = 32; o >= 1; o >>= 1) v += __shfl_xor(v, o); return v; }
DI float sigmoidf_(float x) { return __builtin_amdgcn_rcpf(1.0f + __expf(-x)); }
DI float siluf_(float x) { return x * __builtin_amdgcn_rcpf(1.0f + __expf(-x)); }
DI float softcap15(float x) { return 15.0f * tanhf(x * (1.0f / 15.0f)); }
DI float logsigmoidf_(float x) { return fminf(x, 0.f) - log1pf(__expf(-fabsf(x))); }
DI int row_stream(int row) { return row < NTOK_P ? (row >> 12) : 2 + ((row - NTOK_P) >> 4); }
template <int CTRL> DI float dppf(float v) { return __builtin_bit_cast(float, __builtin_amdgcn_update_dpp(0, __builtin_bit_cast(int, v), CTRL, 0xF, 0xF, true)); }
DI float row16_sum(float v) { v += dppf<0xB1>(v); v += dppf<0x4E>(v); v += dppf<0x141>(v); v += dppf<0x140>(v); return v; }
DI int crow(int i, int hh) { return (i & 3) + 8 * (i >> 2) + 4 * hh; }
#define MFMA32(a, b, c) __builtin_amdgcn_mfma_f32_32x32x16_bf16((a), (b), (c), 0, 0, 0)


namespace pg8 {
#define PG8_LAS __attribute__((address_space(3)))
typedef unsigned short bf16_t;
typedef short bf16x8 __attribute__((ext_vector_type(8)));
typedef float f32x4 __attribute__((ext_vector_type(4)));
typedef unsigned u32x4 __attribute__((ext_vector_type(4)));
constexpr int BM = 256, BK = 64, HALF = 128, HTB = HALF * BK * 2  , STAGE_BYTES = 8 * HTB, NXCD = 8, WGM = 8;

__host__ __device__ __forceinline__ int lds_byte(int r, int c) { const int st = (r >> 4) * 2 + (c >> 5), rr = r & 15, cc = c & 31, ob = rr * 64 + cc * 2; return st * 1024 + (ob ^ (((ob >> 9) & 1) << 5)); }
__host__ __device__ __forceinline__ void stage_rc(int b, int& R, int& C) { const int st = b / 1024, sb = b % 1024, swz = sb ^ (((sb >> 9) & 1) << 5); R = (st >> 1) * 16 + swz / 64; C = (st & 1) * 32 + (swz % 64) / 2; }
__host__ __device__ __forceinline__ int perm32(int rho) { const int n = rho >> 4, i = rho & 15; return 8 * (i >> 2) + 4 * n + (i & 3); }

struct Unit { int pm, pn; };
struct Gemm { const bf16_t* A; const bf16_t* Bt; int M, N, K; int lda, ldb; long tsA, tsB, ksB; };

struct StaticOrder {
    int nM, nN, nwg, G, c;
    __host__ __device__ void init(int M, int N, int G_, int c_) { nM = M / BM; nN = N / BM; nwg = nM * nN; G = G_; c = c_; }
    __host__ __device__ bool next(int i, Unit& u) const {
        const long L = (long)i * G + c; if (L >= nwg) return false;
        int wgid = (int)L; { const int q = nwg / NXCD, r = nwg % NXCD, xcd = wgid % NXCD, off = wgid / NXCD; wgid = (xcd < r ? xcd * (q + 1) : r * (q + 1) + (xcd - r) * q) + off; }
        const int nig = WGM * nN, gid = wgid / nig, fm = gid * WGM, gsz = (nM - fm) < WGM ? (nM - fm) : WGM;
        u.pm = fm + ((wgid % nig) % gsz); u.pn = (wgid % nig) / gsz; return true;
    }
    __device__ __forceinline__ void a_ready(const Unit&) const {}
    __device__ __forceinline__ void done(const Unit&) const {}
};
__device__ __forceinline__ unsigned cvt_pk_bf16(float lo, float hi) { unsigned r; asm volatile("v_cvt_pk_bf16_f32 %0, %1, %2" : "=v"(r) : "v"(lo), "v"(hi)); return r; }
typedef float f32x2 __attribute__((ext_vector_type(2)));
__device__ __forceinline__ f32x2 gelu_pk(f32x2 v) {
    const f32x2 av = __builtin_elementwise_abs(v), d = av * 0.2316418882f + 1.0f;
    f32x2 t; t.x = __builtin_amdgcn_rcpf(d.x); t.y = __builtin_amdgcn_rcpf(d.y);
    f32x2 q = t * 0.5307027145f + (-0.7265760135f); q = q * t + 0.7107068705f; q = q * t + (-0.142248368f); q = q * t + 0.127414796f; q = q * t;
    const f32x2 s = (v * v) * (-0.72134752044f);
    f32x2 e; e.x = __builtin_amdgcn_exp2f(s.x); e.y = __builtin_amdgcn_exp2f(s.y);
    const f32x2 m = v * (q * e), r = v - m;
    f32x2 o; o.x = v.x < 0.f ? m.x : r.x; o.y = v.y < 0.f ? m.y : r.y; return o;
}

struct EpiF32 {
    static constexpr bool PERM = false, AFTER_DRAIN = false;
    float* C; int ldc; const float* bias;
    __device__ __forceinline__ void operator()(const f32x4 (&acc)[2][2][4][2], const Unit& u, int wr, int wc, int fr, int fq) const {
        const int row0 = u.pm * BM + wr * 64 + fr, col0 = u.pn * BM + wc * 32 + 4 * fq;
        f32x4 bv[2][2];
#pragma unroll
        for (int bj = 0; bj < 2; ++bj)
#pragma unroll
            for (int n = 0; n < 2; ++n) bv[bj][n] = bias ? *(const f32x4*)(bias + col0 + bj * HALF + n * 16) : (f32x4){0.f, 0.f, 0.f, 0.f};
#pragma unroll
        for (int ai = 0; ai < 2; ++ai)
#pragma unroll
            for (int m = 0; m < 4; ++m) { float* rowp = C + (size_t)(row0 + ai * HALF + m * 16) * ldc + col0;
#pragma unroll
                for (int bj = 0; bj < 2; ++bj)
#pragma unroll
                    for (int n = 0; n < 2; ++n) *(f32x4*)(rowp + bj * HALF + n * 16) = acc[ai][bj][m][n] + bv[bj][n]; }
    }
};
template <int ACT  > struct EpiBf16 {
    static constexpr bool PERM = true, AFTER_DRAIN = false;
    bf16_t* O; int ldc; const float* bias; int split_cols; size_t split_stride;
    __device__ __forceinline__ void operator()(const f32x4 (&acc)[2][2][4][2], const Unit& u, int wr, int wc, int fr, int fq) const {
        const int row0 = u.pm * BM + wr * 64 + fr; int colt = u.pn * BM; bf16_t* base = O;
        if (split_cols) { const int t = colt / split_cols; base += (size_t)t * split_stride; colt -= t * split_cols; }
        const int col0 = colt + wc * 32 + 8 * fq, bcol0 = u.pn * BM + wc * 32 + 8 * fq;
        f32x4 bv[2][2];
#pragma unroll
        for (int bj = 0; bj < 2; ++bj)
#pragma unroll
            for (int n = 0; n < 2; ++n) bv[bj][n] = bias ? *(const f32x4*)(bias + bcol0 + bj * HALF + 4 * n) : (f32x4){0.f, 0.f, 0.f, 0.f};
#pragma unroll
        for (int ai = 0; ai < 2; ++ai)
#pragma unroll
            for (int m = 0; m < 4; ++m) { bf16_t* rowp = base + (size_t)(row0 + ai * HALF + m * 16) * ldc + col0;
#pragma unroll
                for (int bj = 0; bj < 2; ++bj) { f32x4 v0 = acc[ai][bj][m][0] + bv[bj][0], v1 = acc[ai][bj][m][1] + bv[bj][1];
                    if (ACT == 1) { f32x2 a = gelu_pk((f32x2){v0[0], v0[1]}), b = gelu_pk((f32x2){v0[2], v0[3]}), c = gelu_pk((f32x2){v1[0], v1[1]}), d = gelu_pk((f32x2){v1[2], v1[3]});
                        v0 = (f32x4){a.x, a.y, b.x, b.y}; v1 = (f32x4){c.x, c.y, d.x, d.y}; }
                    if (ACT == 2) {
#pragma unroll
                        for (int j = 0; j < 4; ++j) { v0[j] = 0.5f * v0[j] * (1.0f + erff(v0[j] * 0.70710678f)); v1[j] = 0.5f * v1[j] * (1.0f + erff(v1[j] * 0.70710678f)); } }
                    u32x4 w; w.x = cvt_pk_bf16(v0[0], v0[1]); w.y = cvt_pk_bf16(v0[2], v0[3]); w.z = cvt_pk_bf16(v1[0], v1[1]); w.w = cvt_pk_bf16(v1[2], v1[3]);
                    *(u32x4*)(rowp + bj * HALF) = w; } }
    }
};

template <class Epi, class Sched, bool STAMP = false>
__device__ __forceinline__ void gemm_phase(PG8_LAS unsigned char* lds, const Gemm g, const Sched& S, const Epi& E, unsigned long long* stamps) {
    const int tid = vtid(), wid = __builtin_amdgcn_readfirstlane(tid >> 6), lane = tid & 63, wr = wid >> 2, wc = wid & 3, fr = lane & 15, fq = lane >> 4;
    const int K = g.K, nt = K / BK;
    int ts_lo = 0, ts_hi = 0, nts = 0; const unsigned long long rt_entry = STAMP ? (unsigned long long)wall_clock64() : 0ull;
#define PG8_STAMP() do { if (STAMP && wid == 0 && nts < 64) { const unsigned long long _c = (unsigned long long)clock64(); \
        ts_lo = (lane == nts) ? (int)(unsigned)_c : ts_lo; ts_hi = (lane == nts) ? (int)(unsigned)(_c >> 32) : ts_hi; ++nts; } } while (0)
    PG8_STAMP();
    unsigned voffA[2], voffB[2];
#pragma unroll
    for (int i = 0; i < 2; ++i) { int R, C; stage_rc(tid * 16 + i * 8192, R, C); const int Rb = Epi::PERM ? ((R & ~31) + perm32(R & 31)) : R;
        voffA[i] = (unsigned)(R * g.lda + C) * 2u; voffB[i] = (unsigned)(Rb * g.ldb + C) * 2u; }
    const size_t kstep = (size_t)(BK * 2);
    const size_t hstepA = (size_t)HALF * g.lda * 2, hstepB = (size_t)HALF * g.ldb * 2;
    const unsigned ldsw = (unsigned)wid * 1024u;
    const int aoff = lds_byte(wr * 64 + fr, fq * 8), boff = lds_byte(wc * 32 + fr, fq * 8);
#define PG8_SA(b, h) (((b) * 2 + (h)) * HTB)
#define PG8_SB(b, h) ((4 + (b) * 2 + (h)) * HTB)
#define PG8_STAGE(bufoff, gbase, voff) do { _Pragma("unroll") for (int _i = 0; _i < 2; ++_i) \
        __builtin_amdgcn_global_load_lds((const unsigned*)((const char*)(gbase) + (voff)[_i]), (PG8_LAS unsigned*)(lds + (bufoff) + ldsw + _i * 8192), 16, 0, 0); } while (0)
#define PG8_LDA(dst, b, h) do { _Pragma("unroll") for (int m = 0; m < 4; ++m) _Pragma("unroll") for (int k = 0; k < 2; ++k) dst[m][k] = *(const PG8_LAS bf16x8*)(lds + PG8_SA(b, h) + aoff + m * 2048 + k * 1024); } while (0)
#define PG8_LDB(dst, b, h) do { _Pragma("unroll") for (int n = 0; n < 2; ++n) _Pragma("unroll") for (int k = 0; k < 2; ++k) dst[n][k] = *(const PG8_LAS bf16x8*)(lds + PG8_SB(b, h) + boff + n * 2048 + k * 1024); } while (0)
#define PG8_MMA(ai, bj, At, Bt) do { __builtin_amdgcn_s_setprio(1); _Pragma("unroll") for (int m = 0; m < 4; ++m) _Pragma("unroll") for (int n = 0; n < 2; ++n) _Pragma("unroll") for (int k = 0; k < 2; ++k) \
        acc[ai][bj][m][n] = __builtin_amdgcn_mfma_f32_16x16x32_bf16(Bt[n][k], At[m][k], acc[ai][bj][m][n], 0, 0, 0); __builtin_amdgcn_s_setprio(0); } while (0)
#define PG8_WAIT_V(n) asm volatile("s_waitcnt vmcnt(" #n ")" ::: "memory")
#define PG8_WAIT_L(n) asm volatile("s_waitcnt lgkmcnt(" #n ")" ::: "memory")
#define PG8_BAR __builtin_amdgcn_s_barrier()
#define PG8_SCHED __builtin_amdgcn_sched_barrier(0)
    Unit cur, nxt; int ui = 0;
    if (!S.next(0, cur)) return;
    f32x4 acc[2][2][4][2];
#pragma unroll
    for (int a = 0; a < 2; ++a)
#pragma unroll
        for (int b = 0; b < 2; ++b)
#pragma unroll
            for (int m = 0; m < 4; ++m)
#pragma unroll
                for (int n = 0; n < 2; ++n) acc[a][b][m][n] = (f32x4){0.f, 0.f, 0.f, 0.f};
    bf16x8 At[4][2], B0[2][2], B1[2][2];
    const char* cA = (const char*)g.A + (size_t)cur.pm * g.tsA; const char* cB = (const char*)g.Bt + (size_t)cur.pn * g.tsB + (size_t)cur.pm * g.ksB;
    S.a_ready(cur);
    PG8_STAGE(PG8_SB(0, 0), cB, voffB); PG8_STAGE(PG8_SA(0, 0), cA, voffA); PG8_STAGE(PG8_SB(0, 1), cB + hstepB, voffB); PG8_STAGE(PG8_SA(0, 1), cA + hstepA, voffA);
    if (wr == 1) PG8_BAR;
    PG8_WAIT_V(4); PG8_BAR;
    PG8_STAGE(PG8_SB(1, 0), cB + kstep, voffB); PG8_STAGE(PG8_SA(1, 0), cA + kstep, voffA); PG8_STAGE(PG8_SB(1, 1), cB + hstepB + kstep, voffB);
    PG8_WAIT_V(6); PG8_BAR;
    PG8_STAMP();
    for (;;) {
        const bool has_next = S.next(ui + 1, nxt);
        const char* nA = has_next ? (const char*)g.A + (size_t)nxt.pm * g.tsA : cA; const char* nB = has_next ? (const char*)g.Bt + (size_t)nxt.pn * g.tsB + (size_t)nxt.pm * g.ksB : cB;
        for (int t = 0; t < nt; t += 2) {
            const bool last = (t == nt - 2);
            const char* a1 = cA + (size_t)(t + 1) * kstep;
            const char* a2 = last ? nA : cA + (size_t)(t + 2) * kstep; const char* b2 = last ? nB : cB + (size_t)(t + 2) * kstep;
            const char* a3 = a2 + kstep; const char* b3 = b2 + kstep;
            if (last && has_next) S.a_ready(nxt);
            PG8_LDB(B0, 0, 0); PG8_SCHED; PG8_LDA(At, 0, 0); PG8_STAGE(PG8_SA(1, 1), a1 + hstepA, voffA);
            PG8_WAIT_L(8); PG8_BAR; PG8_WAIT_L(0); PG8_MMA(0, 0, At, B0); PG8_BAR; PG8_SCHED;
            PG8_LDB(B1, 0, 1); PG8_STAGE(PG8_SB(0, 0), b2, voffB);
            PG8_BAR; PG8_WAIT_L(0); PG8_MMA(0, 1, At, B1); PG8_BAR;
            PG8_LDA(At, 0, 1); PG8_STAGE(PG8_SA(0, 0), a2, voffA);
            PG8_BAR; PG8_WAIT_L(0); PG8_MMA(1, 0, At, B0); PG8_BAR; PG8_SCHED;
            PG8_STAGE(PG8_SB(0, 1), b2 + hstepB, voffB);
            PG8_WAIT_V(6); PG8_BAR; PG8_MMA(1, 1, At, B1); PG8_BAR;
            PG8_LDB(B0, 1, 0); PG8_SCHED; PG8_LDA(At, 1, 0); PG8_STAGE(PG8_SA(0, 1), a2 + hstepA, voffA);
            PG8_WAIT_L(8); PG8_BAR; PG8_WAIT_L(0); PG8_MMA(0, 0, At, B0); PG8_BAR; PG8_SCHED;
            PG8_LDB(B1, 1, 1); PG8_STAGE(PG8_SB(1, 0), b3, voffB);
            PG8_BAR; PG8_WAIT_L(0); PG8_MMA(0, 1, At, B1); PG8_BAR;
            PG8_LDA(At, 1, 1); PG8_STAGE(PG8_SA(1, 0), a3, voffA);
            PG8_BAR; PG8_WAIT_L(0); PG8_MMA(1, 0, At, B0); PG8_BAR; PG8_SCHED;
            PG8_STAGE(PG8_SB(1, 1), b3 + hstepB, voffB);
            PG8_WAIT_V(6); PG8_BAR; PG8_MMA(1, 1, At, B1); PG8_BAR;
        }
        PG8_STAMP();
        if constexpr (!Epi::AFTER_DRAIN) { E(acc, cur, wr, wc, fr, fq); S.done(cur); }
        PG8_STAMP();
        if (!has_next) break;
#pragma unroll
        for (int a = 0; a < 2; ++a)
#pragma unroll
            for (int b = 0; b < 2; ++b)
#pragma unroll
                for (int m = 0; m < 4; ++m)
#pragma unroll
                    for (int n = 0; n < 2; ++n) acc[a][b][m][n] = (f32x4){0.f, 0.f, 0.f, 0.f};
        cur = nxt; cA = nA; cB = nB; ++ui;
    }
    PG8_WAIT_V(0);
    if (wr == 0) PG8_BAR;
    PG8_BAR;
    if constexpr (Epi::AFTER_DRAIN) { E.fused(acc, cur, wr, wc, fr, fq, lds, wid, lane); S.done(cur); }
    PG8_STAMP();
    if (STAMP && wid == 0) { stamps[lane] = lane < nts ? (((unsigned long long)(unsigned)ts_hi << 32) | (unsigned)ts_lo) : 0ull;
        if (lane == 62) stamps[62] = rt_entry; if (lane == 63) stamps[63] = (unsigned long long)wall_clock64(); }
#undef PG8_STAMP
#undef PG8_SA
#undef PG8_SB
#undef PG8_STAGE
#undef PG8_LDA
#undef PG8_LDB
#undef PG8_MMA
#undef PG8_WAIT_V
#undef PG8_WAIT_L
#undef PG8_BAR
#undef PG8_SCHED
}
}

#define XB_TMO      128
#define XB_XCNT(j)  (256  + 64 * (j))
#define XB_XSUB(j)  (1280 + 64 * (j))
#define XB_XGEN(j)  (2304 + 64 * (j))
#define XB_TOP      3328
#define XB_TOPGEN   3392
#define XCD_BAR_WORDS 3456
#define XB_SPIN_CAP (1u << 18)

__device__ __forceinline__ unsigned xb_ld(unsigned* p)              { return __hip_atomic_load(p, __ATOMIC_RELAXED, __HIP_MEMORY_SCOPE_AGENT); }
__device__ __forceinline__ unsigned xb_add(unsigned* p, unsigned v) { return __hip_atomic_fetch_add(p, v, __ATOMIC_RELAXED, __HIP_MEMORY_SCOPE_AGENT); }
__device__ __forceinline__ unsigned xb_xcc_id() { return (unsigned)__builtin_amdgcn_s_getreg((3 << 11) | 20) & 0xFu; }
#define XB_SPIN(cond, bar) do { unsigned _sp = 0; while (cond) { __builtin_amdgcn_s_sleep(1); \
    if ((++_sp & 255u) == 0u) { if (xb_ld(&(bar)[XB_TMO])) break; if (_sp > XB_SPIN_CAP) { atomicAdd(&(bar)[XB_TMO], 1u); break; } } } } while (0)

struct XcdBarrier {
    unsigned* bar; unsigned x;
    volatile LAS unsigned* st;
};

__device__ __forceinline__ XcdBarrier xcd_barrier_post(unsigned* bar, volatile LAS unsigned* st) {
    XcdBarrier b; b.bar = bar; b.x = xb_xcc_id(); b.st = st;
    if (threadIdx.x == 0) (void)xb_add(&bar[XB_XCNT(b.x)], 1u);
    return b;
}
__device__ __forceinline__ void xcd_barrier_complete(unsigned* bar, unsigned x, unsigned& nloc, unsigned& nx) {
    const unsigned G = gridDim.x * gridDim.y * gridDim.z;
    unsigned sum, cnt, mine, sp = 0u;
    for (;;) {
        sum = 0u; cnt = 0u; mine = 0u;
#pragma unroll
        for (unsigned j = 0; j < 16; ++j) { const unsigned c = xb_ld(&bar[XB_XCNT(j)]); sum += c; cnt += (c > 0u) ? 1u : 0u; mine = (j == x) ? c : mine; }
        if (sum == G) break;
        __builtin_amdgcn_s_sleep(1);
        if ((++sp & 255u) == 0u) { if (xb_ld(&bar[XB_TMO])) break; if (sp > XB_SPIN_CAP) { atomicAdd(&bar[XB_TMO], 1u); break; } }
    }
    nloc = mine > 0u ? mine : 1u; nx = cnt > 0u ? cnt : 1u;
}

__device__ __forceinline__ void xcd_barrier(const XcdBarrier& b) {
    asm volatile("s_waitcnt vmcnt(0)" ::: "memory");
    __syncthreads();
    if (threadIdx.x == 0) {
        unsigned* bar = b.bar;
        __builtin_amdgcn_s_waitcnt(0);
        unsigned nloc = b.st[0], nx = b.st[1];
        if (nloc == 0u) { xcd_barrier_complete(bar, b.x, nloc, nx); b.st[0] = nloc; b.st[1] = nx; }
        const unsigned old = xb_add(&bar[XB_XSUB(b.x)], 1u);
        const unsigned gen = old / nloc;
        if (old + 1u == (gen + 1u) * nloc) {
            __builtin_amdgcn_fence(__ATOMIC_RELEASE, "agent");
            asm volatile("s_waitcnt vmcnt(0)" ::: "memory");
            const unsigned og = xb_add(&bar[XB_TOP], 1u);
            const unsigned tg = og / nx;
            if (og + 1u == (tg + 1u) * nx) xb_add(&bar[XB_TOPGEN], 1u);
            else XB_SPIN(xb_ld(&bar[XB_TOPGEN]) == tg, bar);
            __builtin_amdgcn_fence(__ATOMIC_ACQUIRE, "agent");
            xb_add(&bar[XB_XGEN(b.x)], 1u);
            asm volatile("s_waitcnt vmcnt(0)" ::: "memory");
        } else {
            XB_SPIN(xb_ld(&bar[XB_XGEN(b.x)]) == gen, bar);
            __builtin_amdgcn_fence(__ATOMIC_ACQUIRE, "agent");
            asm volatile("s_waitcnt vmcnt(0)" ::: "memory");
        }
    }
    __syncthreads();
}


struct EpiBf16Plain {
    static constexpr bool PERM = true, AFTER_DRAIN = false;
    bf16_t* O; int ldc;
    DI void operator()(const f32x4 (&acc)[2][2][4][2], const pg8::Unit& u, int wr, int wc, int fr, int fq) const {
        const int row0 = u.pm * 256 + wr * 64 + fr, col0 = u.pn * 256 + wc * 32 + 8 * fq;
#pragma unroll
        for (int ai = 0; ai < 2; ++ai)
#pragma unroll
            for (int m = 0; m < 4; ++m) { bf16_t* rowp = O + (size_t)(row0 + ai * 128 + m * 16) * ldc + col0;
#pragma unroll
                for (int bj = 0; bj < 2; ++bj) { const f32x4 v0 = acc[ai][bj][m][0], v1 = acc[ai][bj][m][1];
                    u32x4 w; w.x = pack2(v0[0], v0[1]); w.y = pack2(v0[2], v0[3]); w.z = pack2(v1[0], v1[1]); w.w = pack2(v1[2], v1[3]);
                    *(u32x4*)(rowp + bj * 128) = w; } }
    }
};
struct EpiSwiglu {
    static constexpr bool PERM = true, AFTER_DRAIN = false;
    bf16_t* O;
    DI void operator()(const f32x4 (&acc)[2][2][4][2], const pg8::Unit& u, int wr, int wc, int fr, int fq) const {
        const int row0 = u.pm * 256 + wr * 64 + fr, col0 = u.pn * 128 + wc * 32 + 8 * fq;
#pragma unroll
        for (int ai = 0; ai < 2; ++ai)
#pragma unroll
            for (int m = 0; m < 4; ++m) { bf16_t* rowp = O + (size_t)(row0 + ai * 128 + m * 16) * DFF + col0;
                const f32x4 g0 = acc[ai][0][m][0], g1 = acc[ai][0][m][1], u0 = acc[ai][1][m][0], u1 = acc[ai][1][m][1];
                float v[8];
#pragma unroll
                for (int j = 0; j < 4; ++j) { v[j] = siluf_(g0[j]) * u0[j]; v[4 + j] = siluf_(g1[j]) * u1[j]; }
                u32x4 w; w.x = pack2(v[0], v[1]); w.y = pack2(v[2], v[3]); w.z = pack2(v[4], v[5]); w.w = pack2(v[6], v[7]);
                *(u32x4*)rowp = w; }
    }
};
struct EpiResid {
    static constexpr bool PERM = true, AFTER_DRAIN = false;
    float* X; const float* gate; float scale;
    DI void operator()(const f32x4 (&acc)[2][2][4][2], const pg8::Unit& u, int wr, int wc, int fr, int fq) const {
        const int row0 = u.pm * 256 + wr * 64 + fr, col0 = u.pn * 256 + wc * 32 + 8 * fq;
#pragma unroll
        for (int ai = 0; ai < 2; ++ai)
#pragma unroll
            for (int mh = 0; mh < 2; ++mh) { const int rowa = row0 + ai * 128 + mh * 32;
                if (rowa < NTOK) { f32x4 xv[2][2][2], gv[2][2][2];
#pragma unroll
                    for (int mm = 0; mm < 2; ++mm) { const int row = rowa + mm * 16; const float* gp = gate + (size_t)row_stream(row) * MODLD + col0; const float* xp = X + (size_t)row * D + col0;
#pragma unroll
                        for (int bj = 0; bj < 2; ++bj)
#pragma unroll
                            for (int n = 0; n < 2; ++n) { xv[mm][bj][n] = *(const f32x4*)(xp + bj * 128 + n * 4); gv[mm][bj][n] = *(const f32x4*)(gp + bj * 128 + n * 4); } }
#pragma unroll
                    for (int mm = 0; mm < 2; ++mm) { float* xp = X + (size_t)(rowa + mm * 16) * D + col0;
#pragma unroll
                        for (int bj = 0; bj < 2; ++bj)
#pragma unroll
                            for (int n = 0; n < 2; ++n) *(f32x4*)(xp + bj * 128 + n * 4) = xv[mm][bj][n] + (gv[mm][bj][n] * scale) * acc[ai][bj][2 * mh + mm][n]; } } }
    }
};
struct EpiLora {
    static constexpr bool PERM = false, AFTER_DRAIN = false;
    float* C; const float* w0; const float* a0;
    DI void operator()(const f32x4 (&acc)[2][2][4][2], const pg8::Unit& u, int wr, int wc, int fr, int fq) const {
        const int row0 = u.pm * 256 + wr * 64 + fr, col0 = u.pn * 256 + wc * 32 + 4 * fq; const int kind = u.pn >> 2;
        const float* bp = (kind == 0 ? w0 : a0) + (col0 & 1023);
#pragma unroll
        for (int bj = 0; bj < 2; ++bj)
#pragma unroll
            for (int n = 0; n < 2; ++n) { f32x4 bv = {0.f, 0.f, 0.f, 0.f}; if (kind < 2) bv = *(const f32x4*)(bp + bj * 128 + n * 16);
#pragma unroll
                for (int ai = 0; ai < 2; ++ai)
#pragma unroll
                    for (int m = 0; m < 4; ++m) { f32x4 v = acc[ai][bj][m][n] + bv;
                        if (kind == 0) {
#pragma unroll
                            for (int j = 0; j < 4; ++j) { const float x = v[j]; const float ls = fminf(x, 0.f) - __logf(1.0f + __expf(-fabsf(x))); v[j] = __expf(-__expf(ls - 0.5f)); } }
                        else if (kind == 1) {
#pragma unroll
                            for (int j = 0; j < 4; ++j) v[j] = sigmoidf_(v[j]); }
                        *(f32x4*)(C + (size_t)(row0 + ai * 128 + m * 16) * 3072 + col0 + bj * 128 + n * 16) = v; }
                asm volatile("" ::: "memory"); }
    }
};
struct BranchOrder {
    int c, ntile;
    __device__ __forceinline__ bool next(int i, pg8::Unit& u) const { const int n = i % 3, t = c + (i / 3) * (int)gridDim.x; if (t >= ntile) return false;
        const int x = t & 7, j = t >> 3, rt = 4 * x + (j >> 3), ct = j & 7;     u.pm = n * 33 + rt; u.pn = n * 8 + ct; return true; }
    __device__ __forceinline__ void a_ready(const pg8::Unit&) const {}
    __device__ __forceinline__ void done(const pg8::Unit&) const {}
};
struct EpiBranchSeq {
    static constexpr bool PERM = true, AFTER_DRAIN = false;
    const bf16_t* Z; const float* bm; float* T; bf16_t* O;
    DI void operator()(const f32x4 (&acc)[2][2][4][2], const pg8::Unit& u, int wr, int wc, int fr, int fq) const {
        const int n = u.pn >> 3, ct = u.pn & 7, rt = u.pm - 33 * n;
        const int row0 = rt * 256 + wr * 64 + fr, col0 = ct * 256 + wc * 32 + 8 * fq;
        f32x4 bb[2][2];
#pragma unroll
        for (int bj = 0; bj < 2; ++bj) { bb[bj][0] = *(const f32x4*)(bm + n * D + col0 + bj * 128); bb[bj][1] = *(const f32x4*)(bm + n * D + col0 + bj * 128 + 4); }
#pragma unroll
        for (int ai = 0; ai < 2; ++ai) {
            u32x4 zw[4][2];
#pragma unroll
            for (int m = 0; m < 4; ++m)
#pragma unroll
                for (int bj = 0; bj < 2; ++bj) zw[m][bj] = *(const u32x4*)(Z + (size_t)(row0 + ai * 128 + m * 16) * ZLD + n * D + col0 + bj * 128);
#pragma unroll
            for (int mh = 0; mh < 2; ++mh) { f32x4 tv[2][2][2];
                if (n != 0) {
#pragma unroll
                    for (int mm = 0; mm < 2; ++mm)
#pragma unroll
                        for (int bj = 0; bj < 2; ++bj) { const float* tp = T + (size_t)(row0 + ai * 128 + (2 * mh + mm) * 16) * D + col0 + bj * 128; tv[mm][bj][0] = *(const f32x4*)tp; tv[mm][bj][1] = *(const f32x4*)(tp + 4); } }
#pragma unroll
                for (int mm = 0; mm < 2; ++mm)
#pragma unroll
                    for (int bj = 0; bj < 2; ++bj) { const int m = 2 * mh + mm; const u32x4 w = zw[m][bj]; const size_t o = (size_t)(row0 + ai * 128 + m * 16) * D + col0 + bj * 128;
                        f32x4 g0, g1; g0[0] = sigmoidf_(lo16(w.x) + bb[bj][0][0]); g0[1] = sigmoidf_(hi16(w.x) + bb[bj][0][1]); g0[2] = sigmoidf_(lo16(w.y) + bb[bj][0][2]); g0[3] = sigmoidf_(hi16(w.y) + bb[bj][0][3]);
                        g1[0] = sigmoidf_(lo16(w.z) + bb[bj][1][0]); g1[1] = sigmoidf_(hi16(w.z) + bb[bj][1][1]); g1[2] = sigmoidf_(lo16(w.w) + bb[bj][1][2]); g1[3] = sigmoidf_(hi16(w.w) + bb[bj][1][3]);
                        f32x4 v0 = g0 * acc[ai][bj][m][0], v1 = g1 * acc[ai][bj][m][1];
                        if (n != 0) { v0 += tv[mm][bj][0]; v1 += tv[mm][bj][1]; }
                        if (n != 2) { *(f32x4*)(T + o) = v0; *(f32x4*)(T + o + 4) = v1; }
                        else { u32x4 ow; ow.x = pack2(v0[0], v0[1]); ow.y = pack2(v0[2], v0[3]); ow.z = pack2(v1[0], v1[1]); ow.w = pack2(v1[2], v1[3]); *(u32x4*)(O + o) = ow; } } } }
    }
};
struct EpiSlab {
    static constexpr bool PERM = true, AFTER_DRAIN = false;
    float* slab;
    DI void operator()(const f32x4 (&acc)[2][2][4][2], const pg8::Unit& u, int wr, int wc, int fr, int fq) const {
        float* sp = slab + (size_t)u.pm * 128 * D + (size_t)(wr * 64 + fr) * D + u.pn * 256 + wc * 32 + 8 * fq;
#pragma unroll
        for (int m = 0; m < 4; ++m)
#pragma unroll
            for (int bj = 0; bj < 2; ++bj) { *(f32x4*)(sp + (size_t)m * 16 * D + bj * 128) = acc[0][bj][m][0]; *(f32x4*)(sp + (size_t)m * 16 * D + bj * 128 + 4) = acc[0][bj][m][1]; }
    }
};
struct EpiBranchSlab {
    static constexpr bool PERM = true, AFTER_DRAIN = false;
    const bf16_t* Z; const float* bm; float* slab; int slab0;
    DI void operator()(const f32x4 (&acc)[2][2][4][2], const pg8::Unit& u, int wr, int wc, int fr, int fq) const {
        const int col0 = u.pn * 256 + wc * 32 + 8 * fq; float* sp = slab + (size_t)(slab0 + u.pm) * 128 * D + (size_t)(wr * 64 + fr) * D + col0;
        u32x4 zw[4][2];
#pragma unroll
        for (int m = 0; m < 4; ++m)
#pragma unroll
            for (int bj = 0; bj < 2; ++bj) zw[m][bj] = *(const u32x4*)(Z + (size_t)(NTOK_P + wr * 64 + m * 16 + fr) * ZLD + col0 + bj * 128);
#pragma unroll
        for (int bj = 0; bj < 2; ++bj) { const f32x4 b0 = *(const f32x4*)(bm + col0 + bj * 128), b1 = *(const f32x4*)(bm + col0 + bj * 128 + 4);
#pragma unroll
            for (int m = 0; m < 4; ++m) { const u32x4 w = zw[m][bj];
                f32x4 g0, g1; g0[0] = sigmoidf_(lo16(w.x) + b0[0]); g0[1] = sigmoidf_(hi16(w.x) + b0[1]); g0[2] = sigmoidf_(lo16(w.y) + b0[2]); g0[3] = sigmoidf_(hi16(w.y) + b0[3]);
                g1[0] = sigmoidf_(lo16(w.z) + b1[0]); g1[1] = sigmoidf_(hi16(w.z) + b1[1]); g1[2] = sigmoidf_(lo16(w.w) + b1[2]); g1[3] = sigmoidf_(hi16(w.w) + b1[3]);
                *(f32x4*)(sp + (size_t)m * 16 * D + bj * 128) = g0 * acc[0][bj][m][0]; *(f32x4*)(sp + (size_t)m * 16 * D + bj * 128 + 4) = g1 * acc[0][bj][m][1]; } }
    }
};
template <class Epi> DI void run_gemm_splitk(ldsp_t lds, const bf16_t* Atile, const bf16_t* Bt, int N, int Kfull, int Ks, const Epi& E) {
    const int S = Kfull / Ks;
    pg8::Gemm g{Atile, Bt, S * 256, N, Ks, Kfull, Kfull, (long)Ks * 2, (long)Kfull * 512, (long)Ks * 2}; pg8::StaticOrder So; So.init(S * 256, N, (int)gridDim.x, (int)sbid());
    pg8::gemm_phase<Epi, pg8::StaticOrder, false>((PG8_LAS unsigned char*)lds, g, So, E, nullptr);
}
template <class Epi> DI void run_gemm(ldsp_t lds, const bf16_t* A, const bf16_t* Bt, int M, int N, int K, const Epi& E) {
    pg8::Gemm g{A, Bt, M, N, K, K, K, (long)K * 512, (long)K * 512, 0}; pg8::StaticOrder S; S.init(M, N, (int)gridDim.x, (int)sbid());
    pg8::gemm_phase<Epi, pg8::StaticOrder, false>((PG8_LAS unsigned char*)lds, g, S, E, nullptr);
}

DI void conv_tile(const float* __restrict src, int ldw, int K, bf16_t* __restrict dst, int valid_rows, int mode, int tr, int tk, LAS float* T) {
    const int tid = vtid(), lane = tid & 63, wave = tid >> 6;
    const int j = tr * 64 + lane; const bool valid = j < valid_rows;
    int sc;
    if (mode == 0) sc = j;
    else if (mode == 1) { const int pn = j >> 8, r = j & 255; sc = (r < 128) ? pn * 128 + r : DFF + pn * 128 + (r - 128); }
    else if (mode == 2) sc = (j >> 7) * 256 + (j & 127);
    else sc = (j >> 7) * 256 + 128 + (j & 127);
    const float* sp = src + (size_t)(tk * 256 + wave) * ldw + (valid ? sc : 0);
    float v[32];
#pragma unroll
    for (int i = 0; i < 32; ++i) v[i] = valid ? sp[(size_t)(8 * i) * ldw] : 0.f;
#pragma unroll
    for (int i = 0; i < 32; ++i) T[(wave + 8 * i) * 65 + lane] = v[i];
    __syncthreads();
    const int row = tid >> 3;
#pragma unroll
    for (int c = 0; c < 4; ++c) { const int kc = (tid & 7) * 8 + 64 * c; float f[8];
#pragma unroll
        for (int i = 0; i < 8; ++i) f[i] = T[(kc + i) * 65 + row];
        u32x4 w; w.x = pack2(f[0], f[1]); w.y = pack2(f[2], f[3]); w.z = pack2(f[4], f[5]); w.w = pack2(f[6], f[7]);
        *(u32x4*)(dst + (size_t)(tr * 64 + row) * K + tk * 256 + kc) = w; }
    __syncthreads();
}

DI void prologue_phase(const Params& P, ldsp_t lds) {
    const int tid = vtid(), lane = tid & 63, wave = tid >> 6;
    const int G = gridDim.x, gtid = sbid() * 512 + tid, gsz = G * 512;
    unsigned char* ws = wsp(P);
    const float* in_w2 = INP(I_W2); const float* in_a2 = INP(I_A2); const float* in_g2 = INP(I_G2); const float* in_cp = INP(I_CP); const float* in_cs = INP(I_CS);
    const float* in_adaw = INP(I_ADAW); const float* in_adab = INP(I_ADAB);
    { f32x2* rt = (f32x2*)(ws + WS_ROPE);
      for (int idx = gtid; idx < 4096 * 32; idx += gsz) { const int pos = idx >> 5, i = idx & 31;
          const float inv = exp2f(-(float)i * 0.41524101186092029f);
          const double turns = (double)pos * (double)inv * 0.15915494309189535;
          const float fr = (float)(turns - rint(turns));
          f32x2 cs; cs.x = __builtin_amdgcn_cosf(fr); cs.y = __builtin_amdgcn_sinf(fr); rt[idx] = cs; } }
    for (int idx = gtid; idx < 2 * 3072 * 256; idx += gsz) { const int l = idx / (3072 * 256), e = idx % (3072 * 256), j = e >> 8, k = e & 255; float v = 0.f;
        if (j < 1024) { if (k < 64) v = in_w2[((size_t)l * 64 + k) * 1024 + j]; }
        else if (j < 2048) { if (k >= 64 && k < 128) v = in_a2[((size_t)l * 64 + (k - 64)) * 1024 + (j - 1024)]; }
        else { if (k >= 128) v = in_g2[((size_t)l * 128 + (k - 128)) * 1024 + (j - 2048)]; }
        ((bf16_t*)(ws + WS_WLO))[idx] = f2bf(v); }
    { LAS float* S = (LAS float*)lds;
      LAS float* R = S + 2048 * 12;
      for (int idx = tid; idx < 2048 * 10; idx += 512) { const int s = idx >> 11, k = idx & 2047;
          const float c = s < 2 ? in_cp[s * 2048 + k] : in_cs[(s - 2) * 2048 + k]; S[k * 12 + s] = siluf_(c); }
      for (int idx = tid; idx < 2048; idx += 512) { S[idx * 12 + 10] = 0.f; S[idx * 12 + 11] = 0.f; }
      __syncthreads();
      float* mod = (float*)(ws + WS_MOD);
      for (int item = sbid(); item < 576; item += G) { const int l = item / 288, cgp = item % 288;
          const float* W = in_adaw + (size_t)l * 2048 * MODLD + cgp * 64 + lane; const int k0 = wave * 256;
          float acc[10];
#pragma unroll
          for (int s = 0; s < 10; ++s) acc[s] = 0.f;
          for (int kk = 0; kk < 256; kk += 8) { float w[8];
#pragma unroll
              for (int i = 0; i < 8; ++i) w[i] = W[(size_t)(k0 + kk + i) * MODLD];
#pragma unroll
              for (int i = 0; i < 8; ++i) { const LAS float* sp = S + (k0 + kk + i) * 12; const f32x4 s0 = *(const LAS f32x4*)sp, s1 = *(const LAS f32x4*)(sp + 4), s2 = *(const LAS f32x4*)(sp + 8);
                  acc[0] += w[i] * s0[0]; acc[1] += w[i] * s0[1]; acc[2] += w[i] * s0[2]; acc[3] += w[i] * s0[3]; acc[4] += w[i] * s1[0];
                  acc[5] += w[i] * s1[1]; acc[6] += w[i] * s1[2]; acc[7] += w[i] * s1[3]; acc[8] += w[i] * s2[0]; acc[9] += w[i] * s2[1]; } }
#pragma unroll
          for (int s = 0; s < 10; ++s) R[(wave * 10 + s) * 64 + lane] = acc[s];
          __syncthreads();
          for (int o = tid; o < 640; o += 512) { const int s = o >> 6, c = o & 63; float t = 0.f;
#pragma unroll
              for (int w8 = 0; w8 < 8; ++w8) t += R[(w8 * 10 + s) * 64 + c];
              mod[(size_t)(l * 10 + s) * MODLD + cgp * 64 + c] = t + in_adab[(size_t)l * MODLD + cgp * 64 + c]; }
          __syncthreads(); } }
    { LAS float* T = (LAS float*)lds;
      const float* in_fwi = INP(I_FWI); const float* in_fwo = INP(I_FWO); const float* in_win = INP(I_WIN); const float* in_wkvb = INP(I_WKVB); const float* in_wbr = INP(I_WBR); const float* in_wout = INP(I_WOUT);
      const int PER_LAYER = 1408 + 1408 + 704 + 704 + 1856 + 32 + 32 + 128 + 128 + 128 + 256;
      const int start = (sbid() + 64) % G;
      for (int tile = start; tile < 2 * PER_LAYER; tile += G) {
          const int l = tile / PER_LAYER; int t = tile % PER_LAYER;
          const float* src; bf16_t* dst; int ldw, K, vr, mode, nkt;
          if (t < 2816) { const int f = t / 1408; t %= 1408; src = in_fwi + (size_t)(l * 2 + f) * D * (2 * DFF); dst = (bf16_t*)(ws + WS_WFI + (l * 2 + f) * SZ_WFI); ldw = 2 * DFF; K = D; vr = 2 * DFF; mode = 1; nkt = 8; }
          else if (t < 4224) { t -= 2816; const int f = t / 704; t %= 704; src = in_fwo + (size_t)(l * 2 + f) * DFF * D; dst = (bf16_t*)(ws + WS_WFO + (l * 2 + f) * SZ_WFO); ldw = D; K = DFF; vr = D; mode = 0; nkt = 22; }
          else if (t < 6080) { t -= 4224; src = in_win + (size_t)l * D * INCOLS; dst = (bf16_t*)(ws + WS_WIN + l * SZ_WIN); ldw = INCOLS; K = D; vr = INCOLS; mode = 0; nkt = 8; }
          else if (t < 6112) { t -= 6080; src = in_wkvb + (size_t)l * 512 * 2048; dst = (bf16_t*)(ws + WS_WKK + l * SZ_WKK); ldw = 2048; K = 512; vr = 1024; mode = 2; nkt = 2; }
          else if (t < 6144) { t -= 6112; src = in_wkvb + (size_t)l * 512 * 2048; dst = (bf16_t*)(ws + WS_WKV + l * SZ_WKK); ldw = 2048; K = 512; vr = 1024; mode = 3; nkt = 2; }
          else if (t < 6528) { t -= 6144; const int n = t / 128; t %= 128; src = in_wbr + (size_t)(l * 3 + n) * 1024 * D; dst = (bf16_t*)(ws + WS_WBR + (l * 3 + n) * SZ_WBR); ldw = D; K = 1024; vr = D; mode = 0; nkt = 4; }
          else { t -= 6528; src = in_wout + (size_t)l * D * D; dst = (bf16_t*)(ws + WS_WO + l * SZ_WO); ldw = D; K = D; vr = D; mode = 0; nkt = 8; }
          conv_tile(src, ldw, K, dst, vr, mode, t / nkt, t % nkt, T); } }
}

DI void sample_row_slab_sum(ldsp_t lds, const unsigned char* ws, int j, int pend_s, f32x4 (&a)[8]) {
    const int tid = vtid(), lane = tid & 63, wave = tid >> 6; const float* sl = (const float*)(ws + WS_LOUT) + (size_t)j * D + 4 * lane;
#pragma unroll
    for (int i = 0; i < 8; ++i) a[i] = (f32x4){0.f, 0.f, 0.f, 0.f};
    for (int k = wave; k < pend_s; k += 8) {
#pragma unroll
        for (int i = 0; i < 8; ++i) a[i] += *(const f32x4*)(sl + (size_t)k * 128 * D + 256 * i); }
    LAS f32x4* part = (LAS f32x4*)lds;
#pragma unroll
    for (int i = 0; i < 8; ++i) part[wave * 512 + lane + 64 * i] = a[i];
    __syncthreads();
    if (wave == 0) {
#pragma unroll
        for (int w = 1; w < 8; ++w)
#pragma unroll
            for (int i = 0; i < 8; ++i) a[i] += part[w * 512 + lane + 64 * i]; }
    __syncthreads();
}
DI void norm_phase(const Params& P, ldsp_t lds, int l, int which, bool first, int pend_s = 0, const float* pend_gate = nullptr, float pend_scale = 0.f) {
    unsigned char* ws = wsp(P); const float* in_ng = INP(I_NORMG); const float* in_xp = INP(I_XP); const float* in_xs = INP(I_XS);
    const int lane = vtid() & 63, gw = sbid() * 8 + (vtid() >> 6);
    float* xb = (float*)(ws + WS_X); bf16_t* h = (bf16_t*)(ws + WS_H); const float* mod = (const float*)(ws + WS_MOD);
    const int nwv = gridDim.x * 8, rpw = (MP + nwv - 1) / nwv, r0 = gw * rpw;
    if (pend_s > 0) {
        for (int j = sbid(); j < NTOK - NTOK_P; j += gridDim.x) { const int r = NTOK_P + j, s = row_stream(r); f32x4 a[8];
            sample_row_slab_sum(lds, ws, j, pend_s, a);
            if ((vtid() >> 6) == 0) { const float* gp = pend_gate + (size_t)s * MODLD + 4 * lane; float* xr = xb + (size_t)r * D + 4 * lane; bf16_t* hp = h + (size_t)r * D + 4 * lane;
                const float* ngp = in_ng + (size_t)(l * 3 + which) * D + 4 * lane; const float* mp = mod + (size_t)(l * 10 + s) * MODLD + (which * 3) * D + 4 * lane; float ss = 0.f; f32x4 x[8];
#pragma unroll
                for (int i = 0; i < 8; ++i) { x[i] = *(const f32x4*)(xr + 256 * i) + (*(const f32x4*)(gp + 256 * i) * pend_scale) * a[i]; *(f32x4*)(xr + 256 * i) = x[i]; ss += x[i][0] * x[i][0] + x[i][1] * x[i][1] + x[i][2] * x[i][2] + x[i][3] * x[i][3]; }
                ss = wave_sum(ss); const float rstd = rsqrtf(ss * (1.0f / D) + 1e-6f);
#pragma unroll
                for (int i = 0; i < 8; ++i) { const f32x4 g = *(const f32x4*)(ngp + 256 * i), sc = *(const f32x4*)(mp + D + 256 * i), shv = *(const f32x4*)(mp + 256 * i); const f32x4 y = x[i] * rstd * (g * (sc + 1.0f)) + shv;
                    u32x2 w; w.x = pack2(y[0], y[1]); w.y = pack2(y[2], y[3]); *(u32x2*)(hp + 256 * i) = w; } } } }
    int cur_s = -1; f32x4 gm[8], sh[8];
    for (int r = r0; r < r0 + rpw && r < MP; ++r) {
        if (pend_s > 0 && r >= NTOK_P && r < NTOK) continue;
        bf16_t* hp = h + (size_t)r * D + 4 * lane;
        if (r >= NTOK) {
#pragma unroll
            for (int i = 0; i < 8; ++i) *(u32x2*)(hp + 256 * i) = (u32x2){0u, 0u};
            continue; }
        const int s = row_stream(r);
        if (s != cur_s) { cur_s = s; const float* gp = in_ng + (size_t)(l * 3 + which) * D + 4 * lane; const float* mp = mod + (size_t)(l * 10 + s) * MODLD + (which * 3) * D + 4 * lane;
#pragma unroll
            for (int i = 0; i < 8; ++i) { const f32x4 g = *(const f32x4*)(gp + 256 * i), sc = *(const f32x4*)(mp + D + 256 * i); sh[i] = *(const f32x4*)(mp + 256 * i); gm[i] = g * (sc + 1.0f); } }
        const float* xp = first ? (r < NTOK_P ? in_xp + (size_t)r * D : in_xs + (size_t)(r - NTOK_P) * D) : xb + (size_t)r * D;
        f32x4 x[8]; float ss = 0.f;
#pragma unroll
        for (int i = 0; i < 8; ++i) x[i] = *(const f32x4*)(xp + 4 * lane + 256 * i);
#pragma unroll
        for (int i = 0; i < 8; ++i) ss += x[i][0] * x[i][0] + x[i][1] * x[i][1] + x[i][2] * x[i][2] + x[i][3] * x[i][3];
        ss = wave_sum(ss); const float rstd = rsqrtf(ss * (1.0f / D) + 1e-6f);
        if (first) {
#pragma unroll
            for (int i = 0; i < 8; ++i) *(f32x4*)(xb + (size_t)r * D + 4 * lane + 256 * i) = x[i]; }
#pragma unroll
        for (int i = 0; i < 8; ++i) { const f32x4 y = x[i] * rstd * gm[i] + sh[i]; u32x2 w; w.x = pack2(y[0], y[1]); w.y = pack2(y[2], y[3]); *(u32x2*)(hp + 256 * i) = w; }
    }
}
DI void final_phase(const Params& P, ldsp_t lds, int pend_s, const float* pend_gate, float pend_scale) {
    unsigned char* ws = wsp(P); float* out = outp(P); const float* in_fng = INP(I_FNG);
    const int lane = vtid() & 63, gw = sbid() * 8 + (vtid() >> 6), nwv = gridDim.x * 8;
    const float* xb = (const float*)(ws + WS_X);
    f32x4 g[8];
#pragma unroll
    for (int i = 0; i < 8; ++i) g[i] = *(const f32x4*)(in_fng + 4 * lane + 256 * i);
    for (int j = sbid(); j < NTOK - NTOK_P; j += gridDim.x) { const int r = NTOK_P + j; f32x4 a[8];
        sample_row_slab_sum(lds, ws, j, pend_s, a);
        if ((vtid() >> 6) == 0) { const float* gp = pend_gate + (size_t)row_stream(r) * MODLD + 4 * lane; const float* xr = xb + (size_t)r * D + 4 * lane; float ss = 0.f; f32x4 x[8];
#pragma unroll
            for (int i = 0; i < 8; ++i) { x[i] = *(const f32x4*)(xr + 256 * i) + (*(const f32x4*)(gp + 256 * i) * pend_scale) * a[i]; ss += x[i][0] * x[i][0] + x[i][1] * x[i][1] + x[i][2] * x[i][2] + x[i][3] * x[i][3]; }
            ss = wave_sum(ss); const float rstd = rsqrtf(ss * (1.0f / D) + 1e-6f); float* op = out + O_YS + (size_t)j * D + 4 * lane;
#pragma unroll
            for (int i = 0; i < 8; ++i) *(f32x4*)(op + 256 * i) = x[i] * rstd * g[i]; } }
    for (int r = gw; r < NTOK_P; r += nwv) { const float* xp = xb + (size_t)r * D + 4 * lane; f32x4 x[8]; float ss = 0.f;
#pragma unroll
        for (int i = 0; i < 8; ++i) x[i] = *(const f32x4*)(xp + 256 * i);
#pragma unroll
        for (int i = 0; i < 8; ++i) ss += x[i][0] * x[i][0] + x[i][1] * x[i][1] + x[i][2] * x[i][2] + x[i][3] * x[i][3];
        ss = wave_sum(ss); const float rstd = rsqrtf(ss * (1.0f / D) + 1e-6f);
        float* op = out + (r < NTOK_P ? O_YP + (size_t)r * D : O_YS + (size_t)(r - NTOK_P) * D) + 4 * lane;
#pragma unroll
        for (int i = 0; i < 8; ++i) *(f32x4*)(op + 256 * i) = x[i] * rstd * g[i]; }
}

DI void prep_phase(const Params& P, int l) {
    const int lane = vtid() & 63, gw = sbid() * 8 + (vtid() >> 6), nwv = gridDim.x * 8;
    unsigned char* ws = wsp(P); float* out = outp(P); const float* in_clat = INP(I_CLAT); const float* in_ckr = INP(I_CKR); const float* in_rwsh = INP(I_RWSH);
    const bf16_t* z = (const bf16_t*)(ws + WS_Z); bf16_t* latA = (bf16_t*)(ws + WS_LATA); bf16_t* krA = (bf16_t*)(ws + WS_KRA); bf16_t* qR = (bf16_t*)(ws + WS_QR); bf16_t* lin = (bf16_t*)(ws + WS_LIN);
    const f32x2* rope = (const f32x2*)(ws + WS_ROPE);
    f32x4 kg0 = *(const f32x4*)(INP(I_KVG) + l * 512 + 8 * lane), kg1 = *(const f32x4*)(INP(I_KVG) + l * 512 + 8 * lane + 4);
    const f32x4 mu4 = *(const f32x4*)(INP(I_MU) + (size_t)l * 3328 + 3072 + 4 * lane);
    for (int row = gw; row < MP; row += nwv) {
        if (row >= NTOK) { *(u32x2*)(lin + (size_t)row * 256 + 4 * lane) = (u32x2){0u, 0u}; continue; }
        const bool pr = row < NTOK_P; const int s = row_stream(row), b = pr ? s : s - 2, t = pr ? (row & 4095) : ((row - NTOK_P) & 15), pos = pr ? t : 2048 + t, T = pr ? 4096 : 16;
        const bf16_t* zr = z + (size_t)row * ZLD;
        const int keyrow = pr ? row : NTOK_P + b * SKEY + 2048 + t;
        { const u32x4 lv = *(const u32x4*)(zr + ZLAT + 8 * lane);
          float v[8] = {lo16(lv.x), hi16(lv.x), lo16(lv.y), hi16(lv.y), lo16(lv.z), hi16(lv.z), lo16(lv.w), hi16(lv.w)}; float ss = 0.f;
#pragma unroll
          for (int j = 0; j < 8; ++j) ss += v[j] * v[j];
          ss = wave_sum(ss); const float rstd = rsqrtf(ss * (1.0f / 512.0f) + 1e-6f);
          f32x4 o0, o1;
#pragma unroll
          for (int j = 0; j < 4; ++j) { o0[j] = v[j] * rstd * kg0[j]; o1[j] = v[4 + j] * rstd * kg1[j]; }
          float* op = out + (pr ? O_PLAT + ((size_t)(l * 2 + b) * 4096 + t) * 512 : O_SLAT + ((size_t)(l * 8 + b) * 16 + t) * 512) + 8 * lane;
          *(f32x4*)op = o0; *(f32x4*)(op + 4) = o1;
          u32x4 w; w.x = pack2(o0[0], o0[1]); w.y = pack2(o0[2], o0[3]); w.z = pack2(o1[0], o1[1]); w.w = pack2(o1[2], o1[3]);
          *(u32x4*)(latA + (size_t)keyrow * 512 + 8 * lane) = w; }
        if (lane < 32) { const float x1 = bf2f(zr[ZKR + lane]), x2 = bf2f(zr[ZKR + 32 + lane]); const f32x2 cs = rope[pos * 32 + lane];
            const float o1 = x1 * cs.x - x2 * cs.y, o2 = x2 * cs.x + x1 * cs.y;
            float* op = out + (pr ? O_PKR + ((size_t)(l * 2 + b) * 4096 + t) * 64 : O_SKR + ((size_t)(l * 8 + b) * 16 + t) * 64);
            op[lane] = o1; op[32 + lane] = o2; krA[(size_t)keyrow * 64 + lane] = f2bf(o1); krA[(size_t)keyrow * 64 + 32 + lane] = f2bf(o2); }
#pragma unroll
        for (int i = 0; i < 4; ++i) { const int p = lane + 64 * i, hd = p >> 5, ii = p & 31; const bf16_t* qp = zr + ZQA + hd * 192 + 128;
            const float x1 = bf2f(qp[ii]), x2 = bf2f(qp[32 + ii]); const f32x2 cs = rope[pos * 32 + ii];
            qR[(size_t)row * 512 + hd * 64 + ii] = f2bf(x1 * cs.x - x2 * cs.y); qR[(size_t)row * 512 + hd * 64 + 32 + ii] = f2bf(x2 * cs.x + x1 * cs.y); }
        { const u32x2 cw = *(const u32x2*)(zr + ZWD + 4 * lane); f32x4 cur = {lo16(cw.x), hi16(cw.x), lo16(cw.y), hi16(cw.y)}, prev;
          if (t > 0) { const u32x2 pw = *(const u32x2*)(zr - ZLD + ZWD + 4 * lane); prev = (f32x4){lo16(pw.x), hi16(pw.x), lo16(pw.y), hi16(pw.y)}; }
          else if (pr) prev = (f32x4){0.f, 0.f, 0.f, 0.f};
          else prev = *(const f32x4*)(in_rwsh + (size_t)(l * 8 + b) * 3328 + 3072 + 4 * lane);
          f32x4 xs = cur + (prev - cur) * mu4, o;
#pragma unroll
          for (int j = 0; j < 4; ++j) o[j] = lane < 16 ? tanhf(xs[j]) : (lane < 32 ? xs[j] : sigmoidf_(xs[j]));
          u32x2 w; w.x = pack2(o[0], o[1]); w.y = pack2(o[2], o[3]); *(u32x2*)(lin + (size_t)row * 256 + 4 * lane) = w; }
        if (t == T - 1) { float* op = out + (pr ? O_PSH + (size_t)(l * 2 + b) * 3328 : O_SSH + (size_t)(l * 8 + b) * 3328);
#pragma unroll 2
            for (int c = lane; c < 3328; c += 64) op[c] = bf2f(zr[ZR + c]); }
    }
    for (int idx = gw; idx < 8 * SKEY; idx += nwv) { const int b = idx / SKEY, j = idx % SKEY; const size_t keyrow = NTOK_P + idx;
        if (j < 2048) { const float* cp = in_clat + ((size_t)(l * 8 + b) * 2048 + j) * 512 + 8 * lane; const f32x4 a = *(const f32x4*)cp, c = *(const f32x4*)(cp + 4);
            u32x4 w; w.x = pack2(a[0], a[1]); w.y = pack2(a[2], a[3]); w.z = pack2(c[0], c[1]); w.w = pack2(c[2], c[3]); *(u32x4*)(latA + keyrow * 512 + 8 * lane) = w;
            krA[keyrow * 64 + lane] = f2bf(in_ckr[((size_t)(l * 8 + b) * 2048 + j) * 64 + lane]); }
        else if (j >= 2064) { *(u32x4*)(latA + keyrow * 512 + 8 * lane) = (u32x4){0u, 0u, 0u, 0u}; krA[keyrow * 64 + lane] = 0; } }
}

DI void sample_mix_convert(const Params& P) {
    unsigned char* ws = wsp(P); const f32x4* S = (const f32x4*)(ws + WS_LOUT); u32x2* M = (u32x2*)((bf16_t*)(ws + WS_MIX) + (size_t)NTOK_P * D);
    for (int i = sbid() * 512 + vtid(); i < 128 * D / 4; i += gridDim.x * 512) { f32x4 v = S[i];
#pragma unroll
        for (int k = 1; k < 12; ++k) v += S[(size_t)k * (128 * D / 4) + i];
        u32x2 w; w.x = pack2(v[0], v[1]); w.y = pack2(v[2], v[3]); M[i] = w; }
}

DI f32x16 mma_tile32(const LAS bf16_t* A, int lda, const LAS bf16_t* Bt, int ldb, int K, f32x16 acc, int lane) {
    const int r = lane & 31, hh = lane >> 5;
    const LAS bf16_t* ap = A + r * lda + 8 * hh; const LAS bf16_t* bp = Bt + r * ldb + 8 * hh;
    for (int k = 0; k < K; k += 16) { const bf16x8 a = *(const LAS bf16x8*)(ap + k); const bf16x8 b = *(const LAS bf16x8*)(bp + k); acc = MFMA32(a, b, acc); }
    return acc;
}
DI f32x16 zero16() { f32x16 z; for (int i = 0; i < 16; ++i) z[i] = 0.f; return z; }
struct MlItem { int b, h, row0, L; bool prompt; };
DI MlItem ml_item(int item) { MlItem it; if (item < 512) { const int sh = item >> 6, c = item & 63; it.b = sh >> 2; it.h = sh & 3; it.row0 = it.b * 4096 + 64 * c; it.L = 64; it.prompt = true; }
    else { const int j = item - 512; it.b = j >> 2; it.h = j & 3; it.row0 = NTOK_P + 16 * it.b; it.L = 16; it.prompt = false; } return it; }

constexpr int MLA_QS = 0, MLA_KS = 17408, MLA_KT = 34816, MLA_VT = 53248, MLA_PS = 94720, MLA_G = 103936;
DI void mlstm_pass_a(const Params& P, ldsp_t lds, int l) {
    const int tid = vtid(), lane = tid & 63, wave = tid >> 6;
    unsigned char* ws = wsp(P); const bf16_t* z = (const bf16_t*)(ws + WS_Z);
    float* numl = (float*)(ws + WS_NUML); float* denl = (float*)(ws + WS_DENL); float* mlg = (float*)(ws + WS_MLG); float* dC = (float*)(ws + WS_DC); float* mli = (float*)(ws + WS_MLI);
    LAS bf16_t* Qs = (LAS bf16_t*)(lds + MLA_QS); LAS bf16_t* Ks = (LAS bf16_t*)(lds + MLA_KS); LAS bf16_t* KT = (LAS bf16_t*)(lds + MLA_KT);
    LAS bf16_t* VT = (LAS bf16_t*)(lds + MLA_VT); LAS bf16_t* Ps = (LAS bf16_t*)(lds + MLA_PS); LAS float* Gu = (LAS float*)(lds + MLA_G); LAS float* Gpm = Gu + 64; LAS float* Gwp = Gu + 128;
    const float* in_ib = INP(I_MLIB); const float* in_fb = INP(I_MLFB);
    for (int item = sbid(); item < ML_ITEMS; item += gridDim.x) {
        const MlItem it = ml_item(item); const int L = it.L, h = it.h, row0 = it.row0;
        if (wave == 0) { const int t = lane; const bool valid = t < L; const bf16_t* zr = z + (size_t)(row0 + (valid ? t : 0)) * ZLD;
            const float igr = bf2f(zr[ZIG + h]) + in_ib[l * 4 + h], fgr = bf2f(zr[ZFG + h]) + in_fb[l * 4 + h];
            const float ig = softcap15(igr); float bsum = valid ? logsigmoidf_(softcap15(fgr)) : 0.f;
#pragma unroll
            for (int o = 1; o < 64; o <<= 1) { const float v = __shfl_up(bsum, o); if (lane >= o) bsum += v; }
            const float u = valid ? ig - bsum : -1e30f; float pm = u;
#pragma unroll
            for (int o = 1; o < 64; o <<= 1) { const float v = __shfl_up(pm, o); if (lane >= o) pm = fmaxf(pm, v); }
            const float blast = __shfl(bsum, L - 1), pmlast = __shfl(pm, L - 1);
            Gu[t] = u; Gpm[t] = pm; Gwp[t] = valid ? __expf(u - pmlast) : 0.f;
            if (valid) { float* gp = mlg + ((size_t)(row0 + t) * 4 + h) * 2; gp[0] = bsum; gp[1] = bsum + pm; }
            if (lane == 0) { mli[item * 4 + 0] = blast; mli[item * 4 + 1] = blast + pmlast; } }
#pragma unroll
        for (int i = 0; i < 2; ++i) { const int idx = tid + 512 * i, s = idx >> 4, ch = idx & 15; u32x4 q = {0u, 0u, 0u, 0u}, k = q;
            if (s < L) { const bf16_t* zr = z + (size_t)(row0 + s) * ZLD + h * 128 + 8 * ch; q = *(const u32x4*)(zr + ZQM); k = *(const u32x4*)(zr + ZKM); }
            *(LAS u32x4*)(Qs + s * 136 + 8 * ch) = q; *(LAS u32x4*)(Ks + s * 136 + 8 * ch) = k; }
#pragma unroll
        for (int i = 0; i < 4; ++i) { const int idx = tid + 512 * i, s = idx & 63, ch = idx >> 6; u32x4 v = {0u, 0u, 0u, 0u};
            if (s < L) v = *(const u32x4*)(z + (size_t)(row0 + s) * ZLD + ZVM + h * 256 + 8 * ch);
            LAS bf16_t* vp = VT + (8 * ch) * 72 + s;
            vp[0] = (bf16_t)(v.x & 0xffff); vp[72] = (bf16_t)(v.x >> 16); vp[144] = (bf16_t)(v.y & 0xffff); vp[216] = (bf16_t)(v.y >> 16);
            vp[288] = (bf16_t)(v.z & 0xffff); vp[360] = (bf16_t)(v.z >> 16); vp[432] = (bf16_t)(v.w & 0xffff); vp[504] = (bf16_t)(v.w >> 16); }
        for (int idx = tid; idx < 32 * 64; idx += 512) { const int rr = idx >> 6, s = idx & 63; VT[(256 + rr) * 72 + s] = (rr == 0) ? (bf16_t)0x3F80 : (bf16_t)0; }
        __syncthreads();
        { const int s = tid & 63, dg = tid >> 6; const float wp = Gwp[s];
#pragma unroll
          for (int hf = 0; hf < 2; ++hf) { const u32x4 kv = *(const LAS u32x4*)(Ks + s * 136 + dg * 16 + 8 * hf); LAS bf16_t* kp = KT + (dg * 16 + 8 * hf) * 72 + s;
              kp[0] = f2bf(lo16(kv.x) * wp); kp[72] = f2bf(hi16(kv.x) * wp); kp[144] = f2bf(lo16(kv.y) * wp); kp[216] = f2bf(hi16(kv.y) * wp);
              kp[288] = f2bf(lo16(kv.z) * wp); kp[360] = f2bf(hi16(kv.z) * wp); kp[432] = f2bf(lo16(kv.w) * wp); kp[504] = f2bf(hi16(kv.w) * wp); } }
        if (wave < 4) { const int ti = wave >> 1, si = wave & 1, r = lane & 31, hh = lane >> 5;
            f32x16 acc = mma_tile32(Qs + ti * 32 * 136, 136, Ks + si * 32 * 136, 136, 128, zero16(), lane);
            const int s = si * 32 + r; const float us = Gu[s];
#pragma unroll
            for (int i = 0; i < 16; ++i) { const int t = ti * 32 + crow(i, hh); const float d = (s <= t) ? __expf(us - Gpm[t]) : 0.f;
                Ps[t * 72 + s] = f2bf(acc[i] * 0.08838834764831845f * d); } }
        __syncthreads();
        for (int tl = wave; tl < 54; tl += 8) { const int r = lane & 31, hh = lane >> 5;
            if (tl < 18) { const int ti = tl / 9, vj = tl % 9;
                const f32x16 acc = mma_tile32(Ps + ti * 32 * 72, 72, VT + vj * 32 * 72, 72, 64, zero16(), lane);
                if (vj < 8) { float* np = numl + ((size_t)item * 16 + ti * 8 + vj) * 1024 + lane * 16;
#pragma unroll
                    for (int g = 0; g < 4; ++g) *(f32x4*)(np + 4 * g) = (f32x4){acc[4 * g], acc[4 * g + 1], acc[4 * g + 2], acc[4 * g + 3]}; }
                else if (r == 0) {
#pragma unroll
                    for (int i = 0; i < 16; ++i) { const int t = ti * 32 + crow(i, hh); if (t < L) denl[(size_t)(row0 + t) * 4 + h] = acc[i]; } } }
            else { const int q = tl - 18, vi = q >> 2, kj = q & 3;
                const f32x16 acc = mma_tile32(VT + vi * 32 * 72, 72, KT + kj * 32 * 72, 72, 64, zero16(), lane);
#pragma unroll
                for (int i = 0; i < 16; ++i) { const int dv = vi * 32 + crow(i, hh); if (dv < 257) dC[(size_t)item * ML_CSZ + dv * 128 + kj * 32 + r] = acc[i] * 0.08838834764831845f; } } }
        __syncthreads();
    }
}
DI void mlstm_pass_b(const Params& P, int l, int gtid, int gsz) {
    unsigned char* ws = wsp(P); float* out = outp(P); const float* in_mlm = INP(I_MLM); const float* in_mlc = INP(I_MLC); const float* in_mln = INP(I_MLN); float* dC = (float*)(ws + WS_DC); float* mli = (float*)(ws + WS_MLI);
    constexpr int NV = 257 * 128 / 4;
    for (int v = gtid; v < 40 * NV; v += gsz) { const int seq = v / NV, e = v % NV;
        int b, h, item0, nc; float m; f32x4 st;
        if (seq < 8) { b = seq >> 2; h = seq & 3; item0 = seq * 64; nc = 64; m = 0.f; st = (f32x4){0.f, 0.f, 0.f, 0.f}; }
        else { const int j = seq - 8; b = j >> 2; h = j & 3; item0 = 512 + j; nc = 1; m = in_mlm[(l * 8 + b) * 4 + h];
            st = (e < 8192) ? *(const f32x4*)(in_mlc + ((size_t)(l * 8 + b) * 4 + h) * 32768 + 4 * e) : *(const f32x4*)(in_mln + ((size_t)(l * 8 + b) * 4 + h) * 128 + 4 * (e - 8192)); }
        for (int c = 0; c < nc; ++c) { const int item = item0 + c; const float bl = mli[item * 4 + 0], al = mli[item * 4 + 1];
            const float mn = fmaxf(bl + m, al), cw = __expf(bl + m - mn), be = __expf(al - mn);
            f32x4* p = (f32x4*)(dC + (size_t)item * ML_CSZ) + e; const f32x4 d = *p; *p = st; st = st * cw + d * be;
            if (e == 0) mli[item * 4 + 2] = m;
            m = mn; }
        const bool pr = seq < 8; const size_t sh = (size_t)(l * (pr ? 2 : 8) + b) * 4 + h;
        if (e < 8192) *(f32x4*)(out + (pr ? O_PC : O_SC) + sh * 32768 + 4 * e) = st; else *(f32x4*)(out + (pr ? O_PN : O_SN) + sh * 128 + 4 * (e - 8192)) = st;
        if (e == 0) out[(pr ? O_PM : O_SM) + sh] = m; }
}
constexpr int MLC_QS = 0, MLC_CS = 17408, MLC_HS = 17408, MLC_G = 17408 + 78336;
DI void mlstm_pass_c(const Params& P, ldsp_t lds, int l) {
    const int tid = vtid(), lane = tid & 63, wave = tid >> 6;
    unsigned char* ws = wsp(P); const bf16_t* z = (const bf16_t*)(ws + WS_Z);
    const float* numl = (const float*)(ws + WS_NUML); const float* denl = (const float*)(ws + WS_DENL); const float* mlg = (const float*)(ws + WS_MLG);
    const float* dC = (const float*)(ws + WS_DC); const float* mli = (const float*)(ws + WS_MLI); bf16_t* oall = (bf16_t*)(ws + WS_OALL);
    LAS bf16_t* Qs = (LAS bf16_t*)(lds + MLC_QS); LAS bf16_t* Cs = (LAS bf16_t*)(lds + MLC_CS); LAS float* Hs = (LAS float*)(lds + MLC_HS);
    LAS float* Gel = (LAS float*)(lds + MLC_G); LAS float* Gei = Gel + 64; LAS float* Gcl = Gel + 128; LAS float* Gqn = Gel + 192;
    const float* in_hg = INP(I_MLHG);
    for (int item = sbid(); item < ML_ITEMS; item += gridDim.x) {
        const MlItem it = ml_item(item); const int L = it.L, h = it.h, row0 = it.row0;
#pragma unroll
        for (int i = 0; i < 2; ++i) { const int idx = tid + 512 * i, s = idx >> 4, ch = idx & 15; u32x4 q = {0u, 0u, 0u, 0u};
            if (s < L) q = *(const u32x4*)(z + (size_t)(row0 + s) * ZLD + ZQM + h * 128 + 8 * ch);
            *(LAS u32x4*)(Qs + s * 136 + 8 * ch) = q; }
#pragma unroll 2
        for (int idx = tid; idx < 288 * 32; idx += 512) { const int dv = idx >> 5, c4 = idx & 31; u32x2 w = {0u, 0u};
            if (dv < 257) { const f32x4 c = *(const f32x4*)(dC + (size_t)item * ML_CSZ + dv * 128 + 4 * c4); w.x = pack2(c[0], c[1]); w.y = pack2(c[2], c[3]); }
            *(LAS u32x2*)(Cs + dv * 136 + 4 * c4) = w; }
        if (tid < 64) { const int t = tid; float el = 0.f, ei = 0.f, cl = 1.f, dn = 0.f;
            if (t < L) { const float* gp = mlg + ((size_t)(row0 + t) * 4 + h) * 2; const float bt = gp[0], at = gp[1], mp = mli[item * 4 + 2];
                const float mt = fmaxf(bt + mp, at); el = __expf(at - mt); ei = __expf(bt + mp - mt); cl = __expf(-mt); dn = el * denl[(size_t)(row0 + t) * 4 + h]; }
            Gel[t] = el; Gei[t] = ei; Gcl[t] = cl; Gqn[64 + t] = dn; }
        __syncthreads();
        const int r = lane & 31, hh = lane >> 5;
        if (wave < 2) { const f32x16 aq = mma_tile32(Qs + wave * 32 * 136, 136, Cs + 8 * 32 * 136, 136, 128, zero16(), lane);
            if (r == 0) {
#pragma unroll
                for (int i = 0; i < 16; ++i) Gqn[wave * 32 + crow(i, hh)] = aq[i]; } }
        __syncthreads();
        if (tid < 64) { const int t = tid; const float el = Gel[t], ei = Gei[t]; const float den = Gqn[64 + t] + ei * Gqn[t]; const float md = fmaxf(fabsf(den), Gcl[t]);
            Gel[t] = (t < L) ? el / md : 0.f; Gei[t] = (t < L) ? ei / md : 0.f; }
        __syncthreads();
        f32x16 hv2[2];
#pragma unroll
        for (int k = 0; k < 2; ++k) { const int tl = wave + 8 * k, ti = tl >> 3, vj = tl & 7;
            const f32x16 acc = mma_tile32(Qs + ti * 32 * 136, 136, Cs + vj * 32 * 136, 136, 128, zero16(), lane);
            const float* np = numl + ((size_t)item * 16 + tl) * 1024 + lane * 16;
#pragma unroll
            for (int g = 0; g < 4; ++g) { const f32x4 nv = *(const f32x4*)(np + 4 * g); const f32x4 ca = *(const LAS f32x4*)(Gel + ti * 32 + 8 * g + 4 * hh), cb = *(const LAS f32x4*)(Gei + ti * 32 + 8 * g + 4 * hh);
#pragma unroll
                for (int j = 0; j < 4; ++j) hv2[k][4 * g + j] = ca[j] * nv[j] + cb[j] * acc[4 * g + j]; } }
        __syncthreads();
#pragma unroll
        for (int k = 0; k < 2; ++k) { const int tl = wave + 8 * k, ti = tl >> 3, vj = tl & 7;
#pragma unroll
            for (int i = 0; i < 16; ++i) Hs[(ti * 32 + crow(i, hh)) * 260 + vj * 32 + r] = hv2[k][i]; }
        __syncthreads();
        { const f32x4 hg = *(const f32x4*)(in_hg + l * 1024 + h * 256 + 4 * lane);
#pragma unroll
          for (int i = 0; i < 8; ++i) { const int t = wave * 8 + i;
              if (t < L) { const f32x4 hv = *(const LAS f32x4*)(Hs + t * 260 + 4 * lane); float ss = hv[0] * hv[0] + hv[1] * hv[1] + hv[2] * hv[2] + hv[3] * hv[3];
                  ss = wave_sum(ss); const float rstd = rsqrtf(ss * (1.0f / 256.0f) + 1e-6f);
                  const u32x2 ow = *(const u32x2*)(z + (size_t)(row0 + t) * ZLD + ZOM + h * 256 + 4 * lane);
                  const float o0 = sigmoidf_(lo16(ow.x)) * hv[0] * rstd * hg[0], o1 = sigmoidf_(hi16(ow.x)) * hv[1] * rstd * hg[1], o2 = sigmoidf_(lo16(ow.y)) * hv[2] * rstd * hg[2], o3 = sigmoidf_(hi16(ow.y)) * hv[3] * rstd * hg[3];
                  u32x2 w; w.x = pack2(o0, o1); w.y = pack2(o2, o3); *(u32x2*)(oall + (size_t)(row0 + t) * 1024 + h * 256 + 4 * lane) = w; } } }
        __syncthreads();
    }
}

constexpr int RW_R = 0, RW_W = 8192, RW_K = 16384, RW_A = 24576, RW_B = RW_A + 36 * 256, RW_V = RW_B + 8192, RW_CD = RW_V + 2048, RW_BUF = RW_CD + 1024;
constexpr int RW_YOFF = 2 * RW_BUF;
DI float wave_sum_dpp(float v) { v = row16_sum(v);
    const int iv = __builtin_bit_cast(int, v);
    return (__builtin_bit_cast(float, __builtin_amdgcn_readlane(iv, 0)) + __builtin_bit_cast(float, __builtin_amdgcn_readlane(iv, 16))) + (__builtin_bit_cast(float, __builtin_amdgcn_readlane(iv, 32)) + __builtin_bit_cast(float, __builtin_amdgcn_readlane(iv, 48))); }
DI void rwkv_pre(const Params& P, int l) {
    const int lane = vtid() & 63, gw = sbid() * 8 + (vtid() >> 6), nwv = gridDim.x * 8;
    unsigned char* ws = wsp(P); const bf16_t* z = (const bf16_t*)(ws + WS_Z); const float* lout = (const float*)(ws + WS_LOUT);
    float* VR = (float*)(ws + WS_VR); float* VK = (float*)(ws + WS_VK); float* VA = (float*)(ws + WS_VA); float* VB = (float*)(ws + WS_VB); float* VV = (float*)(ws + WS_VV); float* CD = (float*)(ws + WS_CD); float* rkb = (float*)(ws + WS_RK);
    const float* in_mu = INP(I_MU) + (size_t)l * 3328; const float* in_kk = INP(I_KK) + l * 1024; const float* in_ka = INP(I_KA) + l * 1024; const float* in_rk = INP(I_RK) + l * 1024; const float* in_sh = INP(I_RWSH) + (size_t)l * 8 * 3328;
    for (int item = gw; item < 16640; item += nwv) {
        int b, run, hd, T, row0; bool prompt;
        if (item < 16384) { prompt = true; hd = item & 15; run = (item >> 4) & 511; b = item >> 13; T = 4096; row0 = b * 4096; }
        else { const int j = item - 16384; prompt = false; hd = j & 15; run = (j >> 4) & 1; b = j >> 5; T = 16; row0 = NTOK_P + 16 * b; }
        const int col = hd * 64 + lane, t0 = 8 * run;
        const float mu_r = in_mu[col], mu_k = in_mu[1024 + col], mu_v = in_mu[2048 + col], k_k = in_kk[col], k_a = in_ka[col], r_k = in_rk[col];
        float pr, pk, pv;
        if (t0 > 0) { const bf16_t* zp = z + (size_t)(row0 + t0 - 1) * ZLD + ZR + col; pr = bf2f(zp[0]); pk = bf2f(zp[1024]); pv = bf2f(zp[2048]); }
        else if (prompt) { pr = 0.f; pk = 0.f; pv = 0.f; }
        else { const float* sp = in_sh + (size_t)b * 3328 + col; pr = sp[0]; pk = sp[1024]; pv = sp[2048]; }
        float zr[8], zk[9], zv[8], aa[8];
#pragma unroll
        for (int j = 0; j < 8; ++j) { const bf16_t* zp = z + (size_t)(row0 + t0 + j) * ZLD + ZR + col; zr[j] = bf2f(zp[0]); zk[j] = bf2f(zp[1024]); zv[j] = bf2f(zp[2048]); aa[j] = lout[(size_t)(row0 + t0 + j) * 3072 + 1024 + col]; }
        { const int t = t0 + 8 < T ? t0 + 8 : T - 1; zk[8] = bf2f(z[(size_t)(row0 + t) * ZLD + ZR + 1024 + col]); }
        float xk[9], kkn[9];
#pragma unroll
        for (int j = 0; j < 9; ++j) { xk[j] = zk[j] + (pk - zk[j]) * mu_k; pk = zk[j]; const float kk = xk[j] * k_k; const float ss = wave_sum_dpp(kk * kk); kkn[j] = (t0 + j < T) ? kk / fmaxf(sqrtf(ss), 1e-12f) : 0.f; }
#pragma unroll
        for (int j = 0; j < 8; ++j) { const size_t row = (size_t)(row0 + t0 + j);
            const float xr = zr[j] + (pr - zr[j]) * mu_r, xv = zv[j] + (pv - zv[j]) * mu_v; pr = zr[j]; pv = zv[j];
            const float a = aa[j], km = xk[j] * (1.0f + (a - 1.0f) * k_a), bq = kkn[j] * a;
            const float cc = wave_sum_dpp(bq * -kkn[j + 1]), dd = wave_sum_dpp(bq * xr), rk = wave_sum_dpp(xr * km * r_k);
            VR[row * 1024 + col] = xr; VK[row * 1024 + col] = km; VA[row * 1024 + col] = -kkn[j]; VB[row * 1024 + col] = bq; VV[row * 1024 + col] = xv;
            if (lane == 0) { *(f32x2*)(CD + ((size_t)hd * MP + row) * 2) = (f32x2){cc, dd}; rkb[row * 16 + hd] = rk; } }
    }
}
DI void rwkv_flush_y(ldsp_t lds, float* __restrict ybuf, int c, int lane, int T, int row0, int hd, int qd) {
    const LAS float* ysh = (const LAS float*)(lds + RW_YOFF) + (c & 1) * 512;
#pragma unroll
    for (int i = 0; i < 8; ++i) { const int e = lane + 64 * i, tl = e >> 4, rr = e & 15, t = 32 * c + tl; if (t < T) ybuf[(size_t)(row0 + t) * 1024 + hd * 64 + 16 * qd + rr] = ysh[e]; }
}
DI void rwkv_dma_chunk(ldsp_t lds, const unsigned char* __restrict ws, int c, int lane, int T, int row0, int hd, int qd) {
    const int buf = (c & 1) * RW_BUF, t0 = 32 * c, l4 = lane >> 4, c4 = 4 * (lane & 15);
    const float* VR = (const float*)(ws + WS_VR); const float* VK = (const float*)(ws + WS_VK); const float* VA = (const float*)(ws + WS_VA); const float* VB = (const float*)(ws + WS_VB);
    const float* VV = (const float*)(ws + WS_VV); const float* CD = (const float*)(ws + WS_CD); const float* W = (const float*)(ws + WS_LOUT);
#pragma unroll
    for (int i = 0; i < 8; ++i) { const int t = t0 + 4 * i + l4 < T ? t0 + 4 * i + l4 : T - 1; const size_t off = (size_t)(row0 + t) * 1024 + hd * 64 + c4;
        __builtin_amdgcn_global_load_lds((const unsigned*)(VR + off), (LAS unsigned*)(lds + buf + RW_R + i * 1024), 16, 0, 0);
        __builtin_amdgcn_global_load_lds((const unsigned*)(W + (size_t)(row0 + t) * 3072 + hd * 64 + c4), (LAS unsigned*)(lds + buf + RW_W + i * 1024), 16, 0, 0);
        __builtin_amdgcn_global_load_lds((const unsigned*)(VK + off), (LAS unsigned*)(lds + buf + RW_K + i * 1024), 16, 0, 0);
        __builtin_amdgcn_global_load_lds((const unsigned*)(VB + off), (LAS unsigned*)(lds + buf + RW_B + i * 1024), 16, 0, 0); }
#pragma unroll
    for (int i = 0; i < 9; ++i) { const int t = t0 + 4 * i + l4 < T ? t0 + 4 * i + l4 : T - 1;
        __builtin_amdgcn_global_load_lds((const unsigned*)(VA + (size_t)(row0 + t) * 1024 + hd * 64 + c4), (LAS unsigned*)(lds + buf + RW_A + i * 1024), 16, 0, 0); }
#pragma unroll
    for (int i = 0; i < 2; ++i) { const int t = t0 + 16 * i + (lane >> 2) < T ? t0 + 16 * i + (lane >> 2) : T - 1;
        __builtin_amdgcn_global_load_lds((const unsigned*)(VV + (size_t)(row0 + t) * 1024 + hd * 64 + 16 * qd + 4 * (lane & 3)), (LAS unsigned*)(lds + buf + RW_V + i * 1024), 16, 0, 0); }
    { const int t = t0 + 2 * lane < T - 1 ? t0 + 2 * lane : T - 2;
      __builtin_amdgcn_global_load_lds((const unsigned*)(CD + ((size_t)hd * MP + row0 + t) * 2), (LAS unsigned*)(lds + buf + RW_CD), 16, 0, 0); }
}
DI void rwkv_item(const Params& P, ldsp_t lds, int l, int b, int hd, int qd, bool prompt) {
    const int tid = vtid(), lane = tid & 63, wave = __builtin_amdgcn_readfirstlane(tid >> 6);
    unsigned char* ws = wsp(P); float* out = outp(P); float* ybuf = (float*)(ws + WS_YB);
    const int T = prompt ? 4096 : 16, row0 = prompt ? b * 4096 : NTOK_P + 16 * b, nc = (T + 31) / 32;
#define RW_BAR() do { asm volatile("s_waitcnt lgkmcnt(0)" ::: "memory"); __builtin_amdgcn_s_barrier(); asm volatile("" ::: "memory"); } while (0)
    if (wave >= 4) {
        if (wave == 4) { rwkv_dma_chunk(lds, ws, 0, lane, T, row0, hd, qd); asm volatile("s_waitcnt vmcnt(0)" ::: "memory"); }
        RW_BAR();
        for (int c = 0; c < nc; ++c) {
            if (wave == 4) { if (c + 1 < nc) rwkv_dma_chunk(lds, ws, c + 1, lane, T, row0, hd, qd);
                if (c >= 1) rwkv_flush_y(lds, ybuf, c - 1, lane, T, row0, hd, qd);
                asm volatile("s_waitcnt vmcnt(0)" ::: "memory"); }
            RW_BAR(); }
        if (wave == 4) rwkv_flush_y(lds, ybuf, nc - 1, lane, T, row0, hd, qd);
    } else {
        const int si = lane >> 4, cg = lane & 15, vrow = 16 * qd + 4 * wave + si;
        f32x4 S = {0.f, 0.f, 0.f, 0.f};
        if (!prompt) S = *(const f32x4*)(INP(I_RWS) + (((size_t)(l * 8 + b) * 16 + hd) * 64 + vrow) * 64 + 4 * cg);
        RW_BAR();
        float sa;
        { const f32x4 a0 = *(const LAS f32x4*)(lds + RW_A + 16 * cg); sa = row16_sum((S[0] * a0[0] + S[1] * a0[1]) + (S[2] * a0[2] + S[3] * a0[3])); }
        for (int c = 0; c < nc; ++c) {
            const LAS unsigned char* Lb = lds + (c & 1) * RW_BUF + 16 * cg; const LAS float* Vq = (const LAS float*)(lds + (c & 1) * RW_BUF + RW_V) + 4 * wave + si; const LAS f32x2* CD = (const LAS f32x2*)(lds + (c & 1) * RW_BUF + RW_CD);
            LAS float* ysh = (LAS float*)(lds + RW_YOFF) + (cg == 0 ? (c & 1) * 512 + 4 * wave + si : 1024 + tid); const int ystep = cg == 0 ? 16 : 0;
            const int ns = (T - 32 * c) < 32 ? (T - 32 * c) : 32;
#define RW_LOAD(R_, W_, K_, A_, B_, V_, C_, t_) do { const int tq = (t_) < ns ? (t_) : ns - 1; \
                R_ = *(const LAS f32x4*)(Lb + RW_R + tq * 256); W_ = *(const LAS f32x4*)(Lb + RW_W + tq * 256); K_ = *(const LAS f32x4*)(Lb + RW_K + tq * 256); \
                A_ = *(const LAS f32x4*)(Lb + RW_A + (tq + 1) * 256); B_ = *(const LAS f32x4*)(Lb + RW_B + tq * 256); V_ = Vq[tq * 16]; C_ = CD[tq]; } while (0)
#define RW_DOT(P_, X_) (((f32x2){P_[2], P_[3]} * (f32x2){X_[2], X_[3]} + (f32x2){P_[0], P_[1]} * (f32x2){X_[0], X_[1]}))
#define RW_STEP2(R0, W0, K0, A0, B0, V0, C0, R1, W1, K1, A1, B1, V1, C1, t_) do { \
                const f32x4 P0 = S * W0 + K0 * V0; const f32x4 S0 = P0 + B0 * sa; const f32x4 P1 = S0 * W1 + K1 * V1; \
                const f32x2 e0 = RW_DOT(P0, A0), e1 = RW_DOT(P0, R0), e2 = RW_DOT(P1, A1), e3 = RW_DOT(P1, R1); \
                float q0 = e0.x + e0.y, u0 = e1.x + e1.y, q1 = e2.x + e2.y, u1 = e3.x + e3.y; \
                q0 += dppf<0xB1>(q0); q1 += dppf<0xB1>(q1); u0 += dppf<0xB1>(u0); u1 += dppf<0xB1>(u1); \
                q0 += dppf<0x4E>(q0); q1 += dppf<0x4E>(q1); u0 += dppf<0x4E>(u0); u1 += dppf<0x4E>(u1); \
                q0 += dppf<0x141>(q0); q1 += dppf<0x141>(q1); u0 += dppf<0x141>(u0); u1 += dppf<0x141>(u1); \
                q0 += dppf<0x140>(q0); q1 += dppf<0x140>(q1); u0 += dppf<0x140>(u0); u1 += dppf<0x140>(u1); \
                const float sa1 = q0 + sa * C0.x; ysh[(t_) * ystep] = u0 + sa * C0.y; \
                S = P1 + B1 * sa1; ysh[((t_) + 1) * ystep] = u1 + sa1 * C1.y; sa = q1 + sa1 * C1.x; } while (0)
            f32x4 rA, wA, kA, aA, bA, rB, wB, kB, aB, bB, rC, wC, kC, aC, bC, rD, wD, kD, aD, bD; float vA, vB, vC, vD; f32x2 cA, cB, cC, cD;
            RW_LOAD(rA, wA, kA, aA, bA, vA, cA, 0); RW_LOAD(rB, wB, kB, aB, bB, vB, cB, 1);
            for (int t = 0; t < ns; t += 4) {
                RW_LOAD(rC, wC, kC, aC, bC, vC, cC, t + 2); RW_LOAD(rD, wD, kD, aD, bD, vD, cD, t + 3);
                RW_STEP2(rA, wA, kA, aA, bA, vA, cA, rB, wB, kB, aB, bB, vB, cB, t);
                RW_LOAD(rA, wA, kA, aA, bA, vA, cA, t + 4); RW_LOAD(rB, wB, kB, aB, bB, vB, cB, t + 5);
                RW_STEP2(rC, wC, kC, aC, bC, vC, cC, rD, wD, kD, aD, bD, vD, cD, t + 2); }
#undef RW_DOT
#undef RW_STEP2
#undef RW_LOAD
            RW_BAR(); }
        float* so = out + (prompt ? O_PS + (((size_t)(l * 2 + b) * 16 + hd) * 64 + vrow) * 64 : O_SS + (((size_t)(l * 8 + b) * 16 + hd) * 64 + vrow) * 64) + 4 * cg; *(f32x4*)so = S;
    }
#undef RW_BAR
    __syncthreads();
}
DI void rwkv_post(const Params& P, int l) {
    const int lane = vtid() & 63, gw = sbid() * 8 + (vtid() >> 6), nwv = gridDim.x * 8;
    unsigned char* ws = wsp(P); const float* in_rwsh = INP(I_RWSH); const bf16_t* z = (const bf16_t*)(ws + WS_Z); const float* lout = (const float*)(ws + WS_LOUT); const float* ybuf = (const float*)(ws + WS_YB);
    const float* rkb = (const float*)(ws + WS_RK); bf16_t* oall = (bf16_t*)(ws + WS_OALL);
    const int hd = lane >> 2, c0 = hd * 64 + (lane & 3) * 16;
    f32x4 lg[4], lb[4], muv[4];
#pragma unroll
    for (int i = 0; i < 4; ++i) { lg[i] = *(const f32x4*)(INP(I_LNG) + l * 1024 + c0 + 4 * i); lb[i] = *(const f32x4*)(INP(I_LNB) + l * 1024 + c0 + 4 * i); muv[i] = *(const f32x4*)(INP(I_MU) + (size_t)l * 3328 + 2048 + c0 + 4 * i); }
    for (int row = gw; row < NTOK; row += nwv) {
        const bool pr = row < NTOK_P; const int s = row_stream(row), b = pr ? s : s - 2, t = pr ? (row & 4095) : ((row - NTOK_P) & 15);
        f32x4 y[4]; float sm = 0.f;
#pragma unroll
        for (int i = 0; i < 4; ++i) { y[i] = *(const f32x4*)(ybuf + (size_t)row * 1024 + c0 + 4 * i); sm += (y[i][0] + y[i][1]) + (y[i][2] + y[i][3]); }
        sm += dppf<0xB1>(sm); sm += dppf<0x4E>(sm); const float mean = sm * (1.0f / 64.0f); float q = 0.f;
#pragma unroll
        for (int i = 0; i < 4; ++i) { const f32x4 d = y[i] - mean; q += (d[0] * d[0] + d[1] * d[1]) + (d[2] * d[2] + d[3] * d[3]); }
        q += dppf<0xB1>(q); q += dppf<0x4E>(q); const float rstd = rsqrtf(q * (1.0f / 64.0f) + 64e-5f);
        const float rk = rkb[(size_t)row * 16 + hd];
        const bf16_t* zv = z + (size_t)row * ZLD + ZRV + c0; const float* gp = lout + (size_t)row * 3072 + 2048 + c0;
        u32x4 cw0 = *(const u32x4*)zv, cw1 = *(const u32x4*)(zv + 8), pw0 = {0u, 0u, 0u, 0u}, pw1 = pw0; float pf[16];
        if (t > 0) { pw0 = *(const u32x4*)(zv - ZLD); pw1 = *(const u32x4*)(zv - ZLD + 8); }
        const unsigned cw[8] = {cw0.x, cw0.y, cw0.z, cw0.w, cw1.x, cw1.y, cw1.z, cw1.w}, pw[8] = {pw0.x, pw0.y, pw0.z, pw0.w, pw1.x, pw1.y, pw1.z, pw1.w};
#pragma unroll
        for (int j = 0; j < 8; ++j) { pf[2 * j] = lo16(pw[j]); pf[2 * j + 1] = hi16(pw[j]); }
        if (t == 0 && !pr) { const float* sp = in_rwsh + (size_t)(l * 8 + b) * 3328 + 2048 + c0;
#pragma unroll
            for (int j = 0; j < 16; ++j) pf[j] = sp[j]; }
        unsigned ow[8];
#pragma unroll
        for (int i = 0; i < 4; ++i) { const f32x4 g = *(const f32x4*)(gp + 4 * i); float o[4];
#pragma unroll
            for (int j = 0; j < 4; ++j) { const int e = 4 * i + j; const float zc = (e & 1) ? hi16(cw[e >> 1]) : lo16(cw[e >> 1]); const float xv = zc + (pf[e] - zc) * muv[i][j];
                o[j] = (((y[i][j] - mean) * rstd) * lg[i][j] + lb[i][j] + rk * xv) * g[j]; }
            ow[2 * i] = pack2(o[0], o[1]); ow[2 * i + 1] = pack2(o[2], o[3]); }
        bf16_t* op = oall + (size_t)2 * MP * 1024 + (size_t)row * 1024 + c0;
        *(u32x4*)op = (u32x4){ow[0], ow[1], ow[2], ow[3]}; *(u32x4*)(op + 8) = (u32x4){ow[4], ow[5], ow[6], ow[7]};
    }
}

struct AttnOut { float m, l; f32x16 o[4]; };
DI void attn_wave(AttnOut& R, const bf16_t* __restrict z, const bf16_t* __restrict qR, const bf16_t* __restrict Kn, const bf16_t* __restrict krA, const bf16_t* __restrict Vt,
                  int qrow, int hd, int kbase, int kb_lo, int kb_hi, int nvalid, int lane) {
    const int r = lane & 31, hh = lane >> 5;
    bf16x8 qf[12];
#pragma unroll
    for (int ks = 0; ks < 8; ++ks) qf[ks] = *(const bf16x8*)(z + (size_t)qrow * ZLD + ZQA + hd * 192 + 16 * ks + 8 * hh);
#pragma unroll
    for (int ks = 0; ks < 4; ++ks) qf[8 + ks] = *(const bf16x8*)(qR + (size_t)qrow * 512 + hd * 64 + 16 * ks + 8 * hh);
    float m = -1e30f, l = 0.f; f32x16 o0 = zero16(), o1 = zero16(), o2 = zero16(), o3 = zero16();
    const float sc = 0.07216878364870322f * 1.4426950408889634f;
    for (int kb = kb_lo; kb < kb_hi; ++kb) {
        const size_t key = (size_t)kbase + 32 * kb + r;
        const bf16_t* kp = Kn + key * 1024 + hd * 128 + 8 * hh; const bf16_t* kp2 = krA + key * 64 + 8 * hh;
        f32x16 st = zero16();
#pragma unroll
        for (int ks = 0; ks < 8; ++ks) { const bf16x8 a = *(const bf16x8*)(kp + 16 * ks); st = MFMA32(a, qf[ks], st); }
#pragma unroll
        for (int ks = 0; ks < 4; ++ks) { const bf16x8 a = *(const bf16x8*)(kp2 + 16 * ks); st = MFMA32(a, qf[8 + ks], st); }
        const bool tail = (32 * kb + 32 > nvalid); float mx = -1e30f;
#pragma unroll
        for (int i = 0; i < 16; ++i) { float s = st[i] * sc; if (tail && (32 * kb + crow(i, hh) >= nvalid)) s = -1e30f; st[i] = s; mx = fmaxf(mx, s); }
        mx = fmaxf(mx, __shfl_xor(mx, 32));
        const float mnew = fmaxf(m, mx), alpha = __builtin_amdgcn_exp2f(m - mnew); float ls = 0.f;
#pragma unroll
        for (int i = 0; i < 16; ++i) { const float p = __builtin_amdgcn_exp2f(st[i] - mnew); st[i] = p; ls += p; }
        l = l * alpha + ls; m = mnew;
        o0 *= alpha; o1 *= alpha; o2 *= alpha; o3 *= alpha;
        const bf16_t* vp = Vt + (size_t)(hd * 128 + r) * KEYS + kbase + 32 * kb + 4 * hh;
#pragma unroll
        for (int s2 = 0; s2 < 2; ++s2) {
            u32x4 pw; pw.x = pack2(st[8 * s2 + 0], st[8 * s2 + 1]); pw.y = pack2(st[8 * s2 + 2], st[8 * s2 + 3]); pw.z = pack2(st[8 * s2 + 4], st[8 * s2 + 5]); pw.w = pack2(st[8 * s2 + 6], st[8 * s2 + 7]);
            const bf16x8 pb = __builtin_bit_cast(bf16x8, pw);
            { const s16x4 lo = *(const s16x4*)(vp + 16 * s2), hi = *(const s16x4*)(vp + 16 * s2 + 8); o0 = MFMA32(__builtin_shufflevector(lo, hi, 0, 1, 2, 3, 4, 5, 6, 7), pb, o0); }
            { const s16x4 lo = *(const s16x4*)(vp + (size_t)32 * KEYS + 16 * s2), hi = *(const s16x4*)(vp + (size_t)32 * KEYS + 16 * s2 + 8); o1 = MFMA32(__builtin_shufflevector(lo, hi, 0, 1, 2, 3, 4, 5, 6, 7), pb, o1); }
            { const s16x4 lo = *(const s16x4*)(vp + (size_t)64 * KEYS + 16 * s2), hi = *(const s16x4*)(vp + (size_t)64 * KEYS + 16 * s2 + 8); o2 = MFMA32(__builtin_shufflevector(lo, hi, 0, 1, 2, 3, 4, 5, 6, 7), pb, o2); }
            { const s16x4 lo = *(const s16x4*)(vp + (size_t)96 * KEYS + 16 * s2), hi = *(const s16x4*)(vp + (size_t)96 * KEYS + 16 * s2 + 8); o3 = MFMA32(__builtin_shufflevector(lo, hi, 0, 1, 2, 3, 4, 5, 6, 7), pb, o3); }
        }
    }
    R.m = m; R.l = l; R.o[0] = o0; R.o[1] = o1; R.o[2] = o2; R.o[3] = o3;
}
constexpr int AT_KP = 200, AT_VP = 72, AT_KBYTES = 64 * AT_KP * 2, AT_BUF = AT_KBYTES + 128 * AT_VP * 2;
DI void attn_prompt_item(const Params& P, ldsp_t lds, int item) {
    const int tid = vtid(), lane = tid & 63, wave = tid >> 6; unsigned char* ws = wsp(P);
    const bf16_t* z = (const bf16_t*)(ws + WS_Z); const bf16_t* qR = (const bf16_t*)(ws + WS_QR); bf16_t* oall = (bf16_t*)(ws + WS_OALL);
    const int bh = item >> 4, jb = item & 15, b = bh >> 3, hd = bh & 7;
    const int qblk = wave < 4 ? 4 * jb + wave : 127 - (4 * jb + wave - 4);
    const int r = lane & 31, hh = lane >> 5, qrow = b * 4096 + 32 * qblk + r, mych = (qblk >> 1) + 1, nch = 64 - 2 * jb, kbase = b * 4096;
    bf16x8 qf[12];
#pragma unroll
    for (int ks = 0; ks < 8; ++ks) qf[ks] = *(const bf16x8*)(z + (size_t)qrow * ZLD + ZQA + hd * 192 + 16 * ks + 8 * hh);
#pragma unroll
    for (int ks = 0; ks < 4; ++ks) qf[8 + ks] = *(const bf16x8*)(qR + (size_t)qrow * 512 + hd * 64 + 16 * ks + 8 * hh);
    const bf16_t* gk0 = (const bf16_t*)(ws + WS_KN) + (size_t)(kbase + (tid >> 4)) * 1024 + hd * 128 + 8 * (tid & 15);
    const bf16_t* gk2 = (const bf16_t*)(ws + WS_KRA) + (size_t)(kbase + (tid >> 3)) * 64 + 8 * (tid & 7);
    const bf16_t* gv0 = (const bf16_t*)(ws + WS_VT) + (size_t)(hd * 128 + (tid >> 3)) * KEYS + kbase + 8 * (tid & 7);
    const int lk0 = ((tid >> 4) * AT_KP + 8 * (tid & 15)) * 2, lk1 = lk0 + 32 * AT_KP * 2, lk2 = ((tid >> 3) * AT_KP + 128 + 8 * (tid & 7)) * 2;
    const int lv0 = AT_KBYTES + ((tid >> 3) * AT_VP + 8 * (tid & 7)) * 2, lv1 = lv0 + 64 * AT_VP * 2;
    u32x4 p0 = *(const u32x4*)gk0, p1 = *(const u32x4*)(gk0 + 32 * 1024), p2 = *(const u32x4*)gk2, p3 = *(const u32x4*)gv0, p4 = *(const u32x4*)(gv0 + (size_t)64 * KEYS);
    *(LAS u32x4*)(lds + lk0) = p0; *(LAS u32x4*)(lds + lk1) = p1; *(LAS u32x4*)(lds + lk2) = p2; *(LAS u32x4*)(lds + lv0) = p3; *(LAS u32x4*)(lds + lv1) = p4;
    __syncthreads();
    float m = -1e30f, l = 0.f; f32x16 o0 = zero16(), o1 = zero16(), o2 = zero16(), o3 = zero16();
    const float sc = 0.07216878364870322f * 1.4426950408889634f;
    for (int ch = 0; ch < nch; ++ch) {
        const bool more = ch + 1 < nch;
        if (more) { const size_t c1 = (size_t)(ch + 1) * 64;
            p0 = *(const u32x4*)(gk0 + c1 * 1024); p1 = *(const u32x4*)(gk0 + c1 * 1024 + 32 * 1024); p2 = *(const u32x4*)(gk2 + c1 * 64); p3 = *(const u32x4*)(gv0 + c1); p4 = *(const u32x4*)(gv0 + (size_t)64 * KEYS + c1); }
        if (ch < mych) { const LAS bf16_t* Ks = (const LAS bf16_t*)(lds + (ch & 1) * AT_BUF); const LAS bf16_t* Vs = (const LAS bf16_t*)(lds + (ch & 1) * AT_BUF + AT_KBYTES);
#pragma unroll
            for (int j = 0; j < 2; ++j) {
                const LAS bf16_t* kp = Ks + (32 * j + r) * AT_KP + 8 * hh; f32x16 st = zero16();
#pragma unroll
                for (int ks = 0; ks < 12; ++ks) { const bf16x8 a = *(const LAS bf16x8*)(kp + 16 * ks); st = MFMA32(a, qf[ks], st); }
                float mx = -1e30f;
#pragma unroll
                for (int i = 0; i < 16; ++i) { st[i] *= sc; mx = fmaxf(mx, st[i]); }
                mx = fmaxf(mx, __shfl_xor(mx, 32));
                const float mnew = fmaxf(m, mx), alpha = __builtin_amdgcn_exp2f(m - mnew); float ls = 0.f;
#pragma unroll
                for (int i = 0; i < 16; ++i) { const float p = __builtin_amdgcn_exp2f(st[i] - mnew); st[i] = p; ls += p; }
                l = l * alpha + ls; m = mnew; o0 *= alpha; o1 *= alpha; o2 *= alpha; o3 *= alpha;
                const LAS bf16_t* vp = Vs + r * AT_VP + 32 * j + 4 * hh;
#pragma unroll
                for (int s2 = 0; s2 < 2; ++s2) {
                    u32x4 pw; pw.x = pack2(st[8 * s2 + 0], st[8 * s2 + 1]); pw.y = pack2(st[8 * s2 + 2], st[8 * s2 + 3]); pw.z = pack2(st[8 * s2 + 4], st[8 * s2 + 5]); pw.w = pack2(st[8 * s2 + 6], st[8 * s2 + 7]);
                    const bf16x8 pb = __builtin_bit_cast(bf16x8, pw);
                    { const s16x4 lo = *(const LAS s16x4*)(vp + 16 * s2), hi = *(const LAS s16x4*)(vp + 16 * s2 + 8); o0 = MFMA32(__builtin_shufflevector(lo, hi, 0, 1, 2, 3, 4, 5, 6, 7), pb, o0); }
                    { const s16x4 lo = *(const LAS s16x4*)(vp + 32 * AT_VP + 16 * s2), hi = *(const LAS s16x4*)(vp + 32 * AT_VP + 16 * s2 + 8); o1 = MFMA32(__builtin_shufflevector(lo, hi, 0, 1, 2, 3, 4, 5, 6, 7), pb, o1); }
                    { const s16x4 lo = *(const LAS s16x4*)(vp + 64 * AT_VP + 16 * s2), hi = *(const LAS s16x4*)(vp + 64 * AT_VP + 16 * s2 + 8); o2 = MFMA32(__builtin_shufflevector(lo, hi, 0, 1, 2, 3, 4, 5, 6, 7), pb, o2); }
                    { const s16x4 lo = *(const LAS s16x4*)(vp + 96 * AT_VP + 16 * s2), hi = *(const LAS s16x4*)(vp + 96 * AT_VP + 16 * s2 + 8); o3 = MFMA32(__builtin_shufflevector(lo, hi, 0, 1, 2, 3, 4, 5, 6, 7), pb, o3); }
                } } }
        if (more) { const int bo = ((ch + 1) & 1) * AT_BUF;
            *(LAS u32x4*)(lds + bo + lk0) = p0; *(LAS u32x4*)(lds + bo + lk1) = p1; *(LAS u32x4*)(lds + bo + lk2) = p2; *(LAS u32x4*)(lds + bo + lv0) = p3; *(LAS u32x4*)(lds + bo + lv1) = p4; }
        __syncthreads();
    }
    const float lt = l + __shfl_xor(l, 32), inv = 1.0f / lt;
    bf16_t* op = oall + (size_t)MP * 1024 + (size_t)qrow * 1024 + hd * 128;
#pragma unroll
    for (int g = 0; g < 4; ++g) { u32x2 w;
        w.x = pack2(o0[4 * g] * inv, o0[4 * g + 1] * inv); w.y = pack2(o0[4 * g + 2] * inv, o0[4 * g + 3] * inv); *(u32x2*)(op + 8 * g + 4 * hh) = w;
        w.x = pack2(o1[4 * g] * inv, o1[4 * g + 1] * inv); w.y = pack2(o1[4 * g + 2] * inv, o1[4 * g + 3] * inv); *(u32x2*)(op + 32 + 8 * g + 4 * hh) = w;
        w.x = pack2(o2[4 * g] * inv, o2[4 * g + 1] * inv); w.y = pack2(o2[4 * g + 2] * inv, o2[4 * g + 3] * inv); *(u32x2*)(op + 64 + 8 * g + 4 * hh) = w;
        w.x = pack2(o3[4 * g] * inv, o3[4 * g + 1] * inv); w.y = pack2(o3[4 * g + 2] * inv, o3[4 * g + 3] * inv); *(u32x2*)(op + 96 + 8 * g + 4 * hh) = w; }
}
DI void attn_sample_item(const Params& P, ldsp_t lds, int item) {
    const int tid = vtid(), lane = tid & 63, wave = tid >> 6; unsigned char* ws = wsp(P);
    const bf16_t* z = (const bf16_t*)(ws + WS_Z); bf16_t* oall = (bf16_t*)(ws + WS_OALL);
    const int b = item >> 3, hd = item & 7, r = lane & 31, hh = lane >> 5;
    const int qrow = NTOK_P + 16 * b + (r < 16 ? r : 15);
    const int lo = wave == 0 ? 0 : 9 + 8 * (wave - 1), hi = 9 + 8 * wave;
    AttnOut R;
    attn_wave(R, z, (const bf16_t*)(ws + WS_QR), (const bf16_t*)(ws + WS_KN), (const bf16_t*)(ws + WS_KRA), (const bf16_t*)(ws + WS_VT), qrow, hd, NTOK_P + b * SKEY, lo, hi, 2064, lane);
    LAS float* oW = (LAS float*)lds;
    LAS float* mW = (LAS float*)(lds + LDS_MAIN);
    LAS float* lW = mW + 256;
    const float lt = R.l + __shfl_xor(R.l, 32);
    if (hh == 0) { mW[wave * 32 + r] = R.m; lW[wave * 32 + r] = lt; }
#pragma unroll
    for (int dvb = 0; dvb < 4; ++dvb)
#pragma unroll
        for (int i = 0; i < 16; ++i) oW[(wave * 128 + 32 * dvb + crow(i, hh)) * 32 + r] = R.o[dvb][i];
    __syncthreads();
    for (int e = tid; e < 128 * 16; e += 512) { const int q = e & 15, dv = e >> 4; float M = -1e30f;
#pragma unroll
        for (int w = 0; w < 8; ++w) M = fmaxf(M, mW[w * 32 + q]);
        float L = 0.f, acc = 0.f;
#pragma unroll
        for (int w = 0; w < 8; ++w) { const float f = __builtin_amdgcn_exp2f(mW[w * 32 + q] - M); L += lW[w * 32 + q] * f; acc += oW[(w * 128 + dv) * 32 + q] * f; }
        oall[(size_t)MP * 1024 + (size_t)(NTOK_P + 16 * b + q) * 1024 + hd * 128 + dv] = f2bf(acc / L); }
    __syncthreads();
}

__global__ void __launch_bounds__(512, 2) hybrid_fwd(Params P) {
    extern __shared__ __attribute__((aligned(16))) unsigned char smem[];
    ldsp_t lds = (ldsp_t)smem;
    const int tid = threadIdx.x;
    if (tid < 4) ((LAS unsigned*)(lds + LDS_XB))[tid] = 0u;
    __syncthreads();
    XcdBarrier bar = xcd_barrier_post((unsigned*)(P.ws + WS_BAR), (volatile LAS unsigned*)(lds + LDS_XB));
#define PHASE_PTRS() unsigned char* ws = wsp(P); float* xb = (float*)(ws + WS_X); bf16_t* hb = (bf16_t*)(ws + WS_H); bf16_t* act = (bf16_t*)(ws + WS_ACT); bf16_t* zb = (bf16_t*)(ws + WS_Z); const float* modl = (const float*)(ws + WS_MOD) + (size_t)l * 10 * MODLD; (void)xb; (void)hb; (void)act; (void)zb; (void)modl
#define SEAM2() do { XcdBarrier b_ = bar; { unsigned* q_ = b_.bar; asm volatile("" : "+v"(q_)); b_.bar = q_; } xcd_barrier(b_); } while (0)
#define SEAM() do { XcdBarrier b_ = bar; { unsigned* q_ = b_.bar; asm volatile("" : "+v"(q_)); b_.bar = q_; } xcd_barrier(b_); } while (0)

    prologue_phase(P, lds);
    SEAM();
    { constexpr int l = 0;
        if (l == 0) norm_phase(P, lds, l, 0, true); else norm_phase(P, lds, l, 0, false, 22, (const float*)(wsp(P) + WS_MOD) + (size_t)(l - 1) * 10 * MODLD + 8 * D, 0.5f);
        SEAM();
        { PHASE_PTRS(); EpiSwiglu E{act}; run_gemm(lds, hb, (const bf16_t*)(ws + WS_WFI + (size_t)(l * 2 + 0) * SZ_WFI), MP, 2 * DFF, D, E); }
        SEAM();
        { PHASE_PTRS(); EpiResid E{xb, modl + 2 * D, 0.5f}; run_gemm(lds, act, (const bf16_t*)(ws + WS_WFO + (size_t)(l * 2 + 0) * SZ_WFO), NTOK_P, D, DFF, E); }
        { PHASE_PTRS(); EpiSlab E{(float*)(ws + WS_LOUT)}; run_gemm_splitk(lds, act + (size_t)NTOK_P * DFF, (const bf16_t*)(ws + WS_WFO + (size_t)(l * 2 + 0) * SZ_WFO), D, DFF, 256, E); }
        SEAM();
        norm_phase(P, lds, l, 1, false, 22, (const float*)(wsp(P) + WS_MOD) + (size_t)l * 10 * MODLD + 2 * D, 0.5f);
        SEAM();
        { PHASE_PTRS(); EpiBf16Plain E{zb, ZLD}; run_gemm(lds, hb, (const bf16_t*)(ws + WS_WIN + (size_t)l * SZ_WIN), MP, ZLD, D, E); }
        SEAM();
        prep_phase(P, l);
        SEAM();
        { PHASE_PTRS(); EpiLora E{(float*)(ws + WS_LOUT), INP(I_W0) + l * 1024, INP(I_A0) + l * 1024}; run_gemm(lds, (const bf16_t*)(ws + WS_LIN), (const bf16_t*)(ws + WS_WLO + (size_t)l * SZ_WLO), MP, 3072, 256, E); }
        { PHASE_PTRS(); EpiBf16Plain E{(bf16_t*)(ws + WS_KN), 1024}; run_gemm(lds, (const bf16_t*)(ws + WS_LATA), (const bf16_t*)(ws + WS_WKK + (size_t)l * SZ_WKK), KEYS, 1024, 512, E); }
        SEAM();
        { PHASE_PTRS(); EpiBf16Plain E{(bf16_t*)(ws + WS_VT), KEYS}; run_gemm(lds, (const bf16_t*)(ws + WS_WKV + (size_t)l * SZ_WKK), (const bf16_t*)(ws + WS_LATA), 1024, KEYS, 512, E); }
        mlstm_pass_a(P, lds, l);
        rwkv_pre(P, l);
        SEAM();
        { const int G = gridDim.x, nR = G / 2, bx = blockIdx.x;
          if (bx < nR) { for (int i0 = bx; i0 < 128; i0 += nR) { const int it = (nR == 128) ? ((i0 & 7) * 16 + (i0 >> 3)) : i0;
              rwkv_item(P, lds, l, it >> 6, (it >> 2) & 15, it & 3, true); } } }
        { const int G = gridDim.x, nR = G / 2, bx = blockIdx.x; if (bx >= nR) { const int bb = bx - nR, nO = G - nR; for (int it = bb; it < 512; it += nO) rwkv_item(P, lds, l, it >> 6, (it >> 2) & 15, it & 3, false); } }
        { const int G = gridDim.x, nR = G / 2, bx = blockIdx.x; if (bx >= nR) { const int bb = bx - nR, nO = G - nR; for (int i0 = bb; i0 < 256; i0 += nO) { const int it = (nO == 128) ? (((i0 & 7) * 2 + (i0 >> 7)) * 16 + ((i0 >> 3) & 15)) : i0;
              attn_prompt_item(P, lds, it); } } }
        { const int G = gridDim.x, nR = G / 2, bx = blockIdx.x; if (bx >= nR) { const int bb = bx - nR, nO = G - nR; for (int it = bb; it < 64; it += nO) attn_sample_item(P, lds, it); } }
        { const int G = gridDim.x, nR = G / 2, bx = blockIdx.x; if (bx >= nR) mlstm_pass_b(P, l, (bx - nR) * 512 + vtid(), (G - nR) * 512); }
        SEAM();
        mlstm_pass_c(P, lds, l);
        rwkv_post(P, l);
        SEAM();
        { PHASE_PTRS(); EpiBranchSeq E{zb + ZG, INP(I_BM) + (size_t)l * 3 * D, (float*)(ws + WS_ACT), (bf16_t*)(ws + WS_MIX)};
          pg8::Gemm g{(const bf16_t*)(ws + WS_OALL), (const bf16_t*)(ws + WS_WBR + (size_t)(l * 3) * SZ_WBR), NTOK_P, D, 1024, 1024, 1024, (long)1024 * 512, (long)1024 * 512, 0};
          BranchOrder S{(int)sbid(), 256}; pg8::gemm_phase<EpiBranchSeq, BranchOrder, false>((PG8_LAS unsigned char*)lds, g, S, E, nullptr); }
        for (int n = 0; n < 3; ++n) { PHASE_PTRS(); EpiBranchSlab E{zb + ZG + n * D, INP(I_BM) + (size_t)l * 3 * D + n * D, (float*)(ws + WS_LOUT), 4 * n};
            run_gemm_splitk(lds, (const bf16_t*)(ws + WS_OALL) + (size_t)n * MP * 1024 + (size_t)NTOK_P * 1024, (const bf16_t*)(ws + WS_WBR + (size_t)(l * 3 + n) * SZ_WBR), D, 1024, 256, E); }
        SEAM();
        sample_mix_convert(P);
        SEAM();
        { PHASE_PTRS(); EpiResid E{xb, modl + 5 * D, 1.0f}; run_gemm(lds, (const bf16_t*)(ws + WS_MIX), (const bf16_t*)(ws + WS_WO + (size_t)l * SZ_WO), NTOK_P, D, D, E); }
        { PHASE_PTRS(); EpiSlab E{(float*)(ws + WS_LOUT)}; run_gemm_splitk(lds, (const bf16_t*)(ws + WS_MIX) + (size_t)NTOK_P * D, (const bf16_t*)(ws + WS_WO + (size_t)l * SZ_WO), D, D, 256, E); }
        SEAM();
        norm_phase(P, lds, l, 2, false, 8, (const float*)(wsp(P) + WS_MOD) + (size_t)l * 10 * MODLD + 5 * D, 1.0f);
        SEAM();
        { PHASE_PTRS(); EpiSwiglu E{act}; run_gemm(lds, hb, (const bf16_t*)(ws + WS_WFI + (size_t)(l * 2 + 1) * SZ_WFI), MP, 2 * DFF, D, E); }
        SEAM();
        { PHASE_PTRS(); EpiResid E{xb, modl + 8 * D, 0.5f}; run_gemm(lds, act, (const bf16_t*)(ws + WS_WFO + (size_t)(l * 2 + 1) * SZ_WFO), NTOK_P, D, DFF, E); }
        { PHASE_PTRS(); EpiSlab E{(float*)(ws + WS_LOUT)}; run_gemm_splitk(lds, act + (size_t)NTOK_P * DFF, (const bf16_t*)(ws + WS_WFO + (size_t)(l * 2 + 1) * SZ_WFO), D, DFF, 256, E); }
        SEAM();
    }
    { constexpr int l = 1;
        if (l == 0) norm_phase(P, lds, l, 0, true); else norm_phase(P, lds, l, 0, false, 22, (const float*)(wsp(P) + WS_MOD) + (size_t)(l - 1) * 10 * MODLD + 8 * D, 0.5f);
        SEAM();
        { PHASE_PTRS(); EpiSwiglu E{act}; run_gemm(lds, hb, (const bf16_t*)(ws + WS_WFI + (size_t)(l * 2 + 0) * SZ_WFI), MP, 2 * DFF, D, E); }
        SEAM();
        { PHASE_PTRS(); EpiResid E{xb, modl + 2 * D, 0.5f}; run_gemm(lds, act, (const bf16_t*)(ws + WS_WFO + (size_t)(l * 2 + 0) * SZ_WFO), NTOK_P, D, DFF, E); }
        { PHASE_PTRS(); EpiSlab E{(float*)(ws + WS_LOUT)}; run_gemm_splitk(lds, act + (size_t)NTOK_P * DFF, (const bf16_t*)(ws + WS_WFO + (size_t)(l * 2 + 0) * SZ_WFO), D, DFF, 256, E); }
        SEAM();
        norm_phase(P, lds, l, 1, false, 22, (const float*)(wsp(P) + WS_MOD) + (size_t)l * 10 * MODLD + 2 * D, 0.5f);
        SEAM();
        { PHASE_PTRS(); EpiBf16Plain E{zb, ZLD}; run_gemm(lds, hb, (const bf16_t*)(ws + WS_WIN + (size_t)l * SZ_WIN), MP, ZLD, D, E); }
        SEAM();
        prep_phase(P, l);
        SEAM();
        { PHASE_PTRS(); EpiLora E{(float*)(ws + WS_LOUT), INP(I_W0) + l * 1024, INP(I_A0) + l * 1024}; run_gemm(lds, (const bf16_t*)(ws + WS_LIN), (const bf16_t*)(ws + WS_WLO + (size_t)l * SZ_WLO), MP, 3072, 256, E); }
        { PHASE_PTRS(); EpiBf16Plain E{(bf16_t*)(ws + WS_KN), 1024}; run_gemm(lds, (const bf16_t*)(ws + WS_LATA), (const bf16_t*)(ws + WS_WKK + (size_t)l * SZ_WKK), KEYS, 1024, 512, E); }
        SEAM();
        { PHASE_PTRS(); EpiBf16Plain E{(bf16_t*)(ws + WS_VT), KEYS}; run_gemm(lds, (const bf16_t*)(ws + WS_WKV + (size_t)l * SZ_WKK), (const bf16_t*)(ws + WS_LATA), 1024, KEYS, 512, E); }
        mlstm_pass_a(P, lds, l);
        rwkv_pre(P, l);
        SEAM();
        { const int G = gridDim.x, nR = G / 2, bx = blockIdx.x;
          if (bx < nR) { for (int i0 = bx; i0 < 128; i0 += nR) { const int it = (nR == 128) ? ((i0 & 7) * 16 + (i0 >> 3)) : i0;
              rwkv_item(P, lds, l, it >> 6, (it >> 2) & 15, it & 3, true); } } }
        { const int G = gridDim.x, nR = G / 2, bx = blockIdx.x; if (bx >= nR) { const int bb = bx - nR, nO = G - nR; for (int it = bb; it < 512; it += nO) rwkv_item(P, lds, l, it >> 6, (it >> 2) & 15, it & 3, false); } }
        { const int G = gridDim.x, nR = G / 2, bx = blockIdx.x; if (bx >= nR) { const int bb = bx - nR, nO = G - nR; for (int i0 = bb; i0 < 256; i0 += nO) { const int it = (nO == 128) ? (((i0 & 7) * 2 + (i0 >> 7)) * 16 + ((i0 >> 3) & 15)) : i0;
              attn_prompt_item(P, lds, it); } } }
        { const int G = gridDim.x, nR = G / 2, bx = blockIdx.x; if (bx >= nR) { const int bb = bx - nR, nO = G - nR; for (int it = bb; it < 64; it += nO) attn_sample_item(P, lds, it); } }
        { const int G = gridDim.x, nR = G / 2, bx = blockIdx.x; if (bx >= nR) mlstm_pass_b(P, l, (bx - nR) * 512 + vtid(), (G - nR) * 512); }
        SEAM();
        mlstm_pass_c(P, lds, l);
        rwkv_post(P, l);
        SEAM();
        { PHASE_PTRS(); EpiBranchSeq E{zb + ZG, INP(I_BM) + (size_t)l * 3 * D, (float*)(ws + WS_ACT), (bf16_t*)(ws + WS_MIX)};
          pg8::Gemm g{(const bf16_t*)(ws + WS_OALL), (const bf16_t*)(ws + WS_WBR + (size_t)(l * 3) * SZ_WBR), NTOK_P, D, 1024, 1024, 1024, (long)1024 * 512, (long)1024 * 512, 0};
          BranchOrder S{(int)sbid(), 256}; pg8::gemm_phase<EpiBranchSeq, BranchOrder, false>((PG8_LAS unsigned char*)lds, g, S, E, nullptr); }
        for (int n = 0; n < 3; ++n) { PHASE_PTRS(); EpiBranchSlab E{zb + ZG + n * D, INP(I_BM) + (size_t)l * 3 * D + n * D, (float*)(ws + WS_LOUT), 4 * n};
            run_gemm_splitk(lds, (const bf16_t*)(ws + WS_OALL) + (size_t)n * MP * 1024 + (size_t)NTOK_P * 1024, (const bf16_t*)(ws + WS_WBR + (size_t)(l * 3 + n) * SZ_WBR), D, 1024, 256, E); }
        SEAM();
        sample_mix_convert(P);
        SEAM();
        { PHASE_PTRS(); EpiResid E{xb, modl + 5 * D, 1.0f}; run_gemm(lds, (const bf16_t*)(ws + WS_MIX), (const bf16_t*)(ws + WS_WO + (size_t)l * SZ_WO), NTOK_P, D, D, E); }
        { PHASE_PTRS(); EpiSlab E{(float*)(ws + WS_LOUT)}; run_gemm_splitk(lds, (const bf16_t*)(ws + WS_MIX) + (size_t)NTOK_P * D, (const bf16_t*)(ws + WS_WO + (size_t)l * SZ_WO), D, D, 256, E); }
        SEAM();
        norm_phase(P, lds, l, 2, false, 8, (const float*)(wsp(P) + WS_MOD) + (size_t)l * 10 * MODLD + 5 * D, 1.0f);
        SEAM();
        { PHASE_PTRS(); EpiSwiglu E{act}; run_gemm(lds, hb, (const bf16_t*)(ws + WS_WFI + (size_t)(l * 2 + 1) * SZ_WFI), MP, 2 * DFF, D, E); }
        SEAM();
        { PHASE_PTRS(); EpiResid E{xb, modl + 8 * D, 0.5f}; run_gemm(lds, act, (const bf16_t*)(ws + WS_WFO + (size_t)(l * 2 + 1) * SZ_WFO), NTOK_P, D, DFF, E); }
        { PHASE_PTRS(); EpiSlab E{(float*)(ws + WS_LOUT)}; run_gemm_splitk(lds, act + (size_t)NTOK_P * DFF, (const bf16_t*)(ws + WS_WFO + (size_t)(l * 2 + 1) * SZ_WFO), D, DFF, 256, E); }
        SEAM();
    }
    final_phase(P, lds, 22, (const float*)(wsp(P) + WS_MOD) + (size_t)(NLAYER - 1) * 10 * MODLD + 8 * D, 0.5f);
}

extern "C" void kernel_launch(void* const* d_in, const int* in_sizes, int n_in, void* d_out, int out_size, void* d_ws, size_t ws_size, hipStream_t stream) {
    static int grid = 0;
    if (grid == 0) {
        if (n_in != 37 || (size_t)out_size != O_END || ws_size < WS_END) { fprintf(stderr, "kernel_launch: unexpected shapes: n_in %d out %d ws %zu (need %zu)\n", n_in, out_size, ws_size, (size_t)WS_END); grid = -1; return; }
        int dev = 0, cus = 0;
        if (hipGetDevice(&dev) != hipSuccess || hipDeviceGetAttribute(&cus, hipDeviceAttributeMultiprocessorCount, dev) != hipSuccess) { grid = -1; return; }
        if (hipFuncSetAttribute((const void*)hybrid_fwd, hipFuncAttributeMaxDynamicSharedMemorySize, LDS_BYTES) != hipSuccess) { fprintf(stderr, "kernel_launch: hipFuncSetAttribute failed\n"); grid = -1; return; }
        int per_cu = 0;
        if (hipOccupancyMaxActiveBlocksPerMultiprocessor(&per_cu, (const void*)hybrid_fwd, 512, LDS_BYTES) != hipSuccess || per_cu < 1) { fprintf(stderr, "kernel_launch: occupancy query says %d\n", per_cu); }
        (void)hipGetLastError();
        grid = cus;
    }
    if (grid < 0) return;
    hipMemsetAsync((char*)d_ws + WS_BAR, 0, 16384, stream);
    Params p{};
    for (int i = 0; i < 37; ++i) p.in[i] = (const float*)d_in[i];
    p.out = (float*)d_out; p.ws = (unsigned char*)d_ws;
    hipLaunchKernelGGL(hybrid_fwd, dim3(grid), dim3(512), LDS_BYTES, stream, p);
}
```

```cpp
#include <hip/hip_runtime.h>
#include <stdint.h>
#include <stdio.h>

#define DI __device__ __forceinline__
#define LAS __attribute__((address_space(3)))
typedef LAS unsigned char* ldsp_t;
typedef unsigned short bf16_t;
typedef short bf16x8 __attribute__((ext_vector_type(8)));
typedef short s16x4 __attribute__((ext_vector_type(4)));
typedef float f32x4 __attribute__((ext_vector_type(4)));
typedef float f32x2 __attribute__((ext_vector_type(2)));
typedef float f32x16 __attribute__((ext_vector_type(16)));
typedef unsigned u32x4 __attribute__((ext_vector_type(4)));
typedef unsigned u32x2 __attribute__((ext_vector_type(2)));
typedef __bf16 bfv2 __attribute__((ext_vector_type(2)));

constexpr int D = 2048, DFF = 5632, NTOK_P = 8192, NTOK = 8320, MP = 8448, NLAYER = 2;
constexpr int ZLD = 14848, INCOLS = 14664;
constexpr int ZQM = 0, ZKM = 512, ZVM = 1024, ZOM = 2048, ZIG = 3072, ZFG = 3076;
constexpr int ZQA = 3080, ZLAT = 4616, ZKR = 5128;
constexpr int ZR = 5192, ZRK = 6216, ZRV = 7240, ZWD = 8264;
constexpr int ZG = 8520;
constexpr int SKEY = 2112, KEYS = 8192 + 8 * SKEY;
constexpr int MODLD = 18432;
constexpr int ML_ITEMS = 544, ML_CSZ = 288 * 128;

constexpr size_t O_YP = 0, O_YS = O_YP + 16777216, O_PLAT = O_YS + 262144, O_PKR = O_PLAT + 8388608, O_PC = O_PKR + 1048576, O_PN = O_PC + 524288,
                 O_PM = O_PN + 2048, O_PS = O_PM + 16, O_PSH = O_PS + 262144, O_SLAT = O_PSH + 13312, O_SKR = O_SLAT + 131072, O_SC = O_SKR + 16384,
                 O_SN = O_SC + 2097152, O_SM = O_SN + 8192, O_SS = O_SM + 64, O_SSH = O_SS + 1048576, O_END = O_SSH + 53248;

constexpr size_t al256(size_t x) { return (x + 255) & ~(size_t)255; }
constexpr size_t WS_BAR = 0;
constexpr size_t WS_MOD = WS_BAR + 16384;
constexpr size_t WS_ROPE = WS_MOD + al256((size_t)NLAYER * 10 * MODLD * 4);
constexpr size_t WS_WFI = WS_ROPE + (size_t)4096 * 32 * 8;
constexpr size_t SZ_WFI = (size_t)2 * DFF * D * 2;
constexpr size_t WS_WFO = WS_WFI + 4 * SZ_WFI;
constexpr size_t SZ_WFO = (size_t)D * DFF * 2;
constexpr size_t WS_WIN = WS_WFO + 4 * SZ_WFO;
constexpr size_t SZ_WIN = (size_t)ZLD * D * 2;
constexpr size_t WS_WKK = WS_WIN + 2 * SZ_WIN;
constexpr size_t SZ_WKK = (size_t)1024 * 512 * 2;
constexpr size_t WS_WKV = WS_WKK + 2 * SZ_WKK;
constexpr size_t WS_WLO = WS_WKV + 2 * SZ_WKK;
constexpr size_t SZ_WLO = (size_t)3072 * 256 * 2;
constexpr size_t WS_WBR = WS_WLO + 2 * SZ_WLO;
constexpr size_t SZ_WBR = (size_t)D * 1024 * 2;
constexpr size_t WS_WO = WS_WBR + 6 * SZ_WBR;
constexpr size_t SZ_WO = (size_t)D * D * 2;
constexpr size_t WS_X = WS_WO + 2 * SZ_WO;
constexpr size_t WS_H = WS_X + (size_t)MP * D * 4;
constexpr size_t WS_ACT = WS_H + (size_t)MP * D * 2;
constexpr size_t WS_Z = WS_ACT + (size_t)MP * DFF * 2;
constexpr size_t WS_QR = WS_Z + (size_t)MP * ZLD * 2;
constexpr size_t WS_LATA = WS_QR + (size_t)MP * 512 * 2;
constexpr size_t WS_KRA = WS_LATA + (size_t)KEYS * 512 * 2;
constexpr size_t WS_KN = WS_KRA + (size_t)KEYS * 64 * 2;
constexpr size_t WS_VT = WS_KN + (size_t)KEYS * 1024 * 2;
constexpr size_t WS_LIN = WS_VT + (size_t)KEYS * 1024 * 2;
constexpr size_t WS_LOUT = WS_LIN + (size_t)MP * 256 * 2;
constexpr size_t WS_OALL = WS_LOUT + (size_t)MP * 3072 * 4;
constexpr size_t WS_MIX = WS_OALL + (size_t)MP * 3072 * 2;
constexpr size_t WS_YB = WS_MIX + (size_t)MP * D * 2;
constexpr size_t WS_RK = WS_YB + (size_t)MP * 1024 * 4;
constexpr size_t WS_NUML = WS_RK + (size_t)MP * 16 * 4;
constexpr size_t WS_DENL = WS_NUML + (size_t)ML_ITEMS * 16 * 1024 * 4;
constexpr size_t WS_MLG = WS_DENL + (size_t)NTOK * 4 * 4;
constexpr size_t WS_DC = WS_MLG + (size_t)NTOK * 8 * 4;
constexpr size_t WS_MLI = WS_DC + (size_t)ML_ITEMS * ML_CSZ * 4;
constexpr size_t WS_VV = WS_MLI + al256((size_t)ML_ITEMS * 4 * 4);
constexpr size_t WS_END = WS_VV + (size_t)MP * 1024 * 4;
constexpr size_t WS_VR = WS_ACT, WS_VK = WS_ACT + (size_t)MP * 1024 * 4, WS_VA = WS_H, WS_VB = WS_MIX, WS_CD = WS_LIN;

constexpr int LDS_MAIN = 131072, LDS_XB = LDS_MAIN + 2048, LDS_WSLOT = LDS_MAIN + 2048 + 256, LDS_BYTES = LDS_WSLOT + 256;

struct Params { const float* in[37]; float* out; unsigned char* ws; };
enum { I_XP = 0, I_XS, I_CP, I_CS, I_CLAT, I_CKR, I_MLC, I_MLN, I_MLM, I_RWS, I_RWSH, I_ADAW, I_ADAB, I_NORMG, I_FWI, I_FWO, I_WIN, I_MLIB, I_MLFB, I_MLHG,
       I_KVG, I_WKVB, I_MU, I_W0, I_W2, I_A0, I_A2, I_G2, I_KK, I_KA, I_RK, I_LNG, I_LNB, I_WBR, I_BM, I_WOUT, I_FNG };

DI int hw_slot() { int id; asm volatile("s_getreg_b32 %0, hwreg(HW_REG_HW_ID, 0, 6)" : "=s"(id)); return id; }
DI int vtid() { extern __shared__ __attribute__((aligned(16))) unsigned char smem[];
    int w = ((const LAS int*)((ldsp_t)smem + LDS_WSLOT))[hw_slot()]; w = __builtin_amdgcn_readfirstlane(w);
    int z = 0; asm volatile("" : "+s"(z));
    int t = (w << 6) | (int)__builtin_amdgcn_mbcnt_hi(~0u, __builtin_amdgcn_mbcnt_lo(~0u, (unsigned)z)); asm volatile("" : "+v"(t)); return t; }
DI int sbid() { int b = blockIdx.x; asm volatile("" : "+s"(b)); return b; }
DI int opq(int x) { asm volatile("" : "+s"(x)); return x; }
#define INP(i) (P.in[opq(i)])
DI unsigned char* relaunder(const void* p) { unsigned lo = (unsigned)(size_t)p, hi = (unsigned)((size_t)p >> 32); asm volatile("" : "+v"(lo), "+v"(hi));
    lo = __builtin_amdgcn_readfirstlane(lo); hi = __builtin_amdgcn_readfirstlane(hi); return (unsigned char*)(((size_t)hi << 32) | lo); }
DI unsigned char* wsp(const Params& P) { return relaunder(P.ws); }
DI float* outp(const Params& P) { return (float*)relaunder(P.out); }
DI float bf2f(bf16_t b) { return __uint_as_float(((unsigned)b) << 16); }
DI unsigned pack2(float lo, float hi) { f32x2 v = {lo, hi}; return __builtin_bit_cast(unsigned, __builtin_convertvector(v, bfv2)); }
DI bf16_t f2bf(float f) { return (bf16_t)(pack2(f, 0.f) & 0xffffu); }
DI float lo16(unsigned w) { return __uint_as_float(w << 16); }
DI float hi16(unsigned w) { return __uint_as_float(w & 0xffff0000u); }
DI float sigmoidf_(float x) { return __builtin_amdgcn_rcpf(1.0f + __expf(-x)); }
DI float siluf_(float x) { return x * __builtin_amdgcn_rcpf(1.0f + __expf(-x)); }
DI float softcap15(float x) { return 15.0f * tanhf(x * (1.0f / 15.0f)); }
DI float logsigmoidf_(float x) { return fminf(x, 0.f) - log1pf(__expf(-fabsf(x))); }
DI int row_stream(int row) { return row < NTOK_P ? (row >> 12) : 2 + ((row - NTOK_P) >> 4); }
template <int CTRL> DI float dppf(float v) { return __builtin_bit_cast(float, __builtin_amdgcn_update_dpp(0, __builtin_bit_cast(int, v), CTRL, 0xF, 0xF, true)); }
DI float row16_sum(float v) { v += dppf<0xB1>(v); v += dppf<0x4E>(v); v += dppf<0x141>(v); v += dppf<0x140>(v); return v; }
DI float wave_sum(float v) { v = row16_sum(v);
    const int iv = __builtin_bit_cast(int, v);
    return (__builtin_bit_cast(float, __builtin_amdgcn_readlane(iv, 0)) + __builtin_bit_cast(float, __builtin_amdgcn_readlane(iv, 16))) + (__builtin_bit_cast(float, __builtin_amdgcn_readlane(iv, 32)) + __builtin_bit_cast(float, __builtin_amdgcn_readlane(iv, 48))); }
DI int crow(int i, int hh) { return (i & 3) + 8 * (i >> 2) + 4 * hh; }
#define MFMA32(a, b, c) __builtin_amdgcn_mfma_f32_32x32x16_bf16((a), (b), (c), 0, 0, 0)


namespace pg8 {
#define PG8_LAS __attribute__((address_space(3)))
typedef unsigned short bf16_t;
typedef short bf16x8 __attribute__((ext_vector_type(8)));
typedef float f32x4 __attribute__((ext_vector_type(4)));
typedef unsigned u32x4 __attribute__((ext_vector_type(4)));
constexpr int BM = 256, BK = 64, HALF = 128, HTB = HALF * BK * 2  , STAGE_BYTES = 8 * HTB, NXCD = 8, WGM = 8;

__host__ __device__ __forceinline__ int lds_byte(int r, int c) { const int st = (r >> 4) * 2 + (c >> 5), rr = r & 15, cc = c & 31, ob = rr * 64 + cc * 2; return st * 1024 + (ob ^ (((ob >> 9) & 1) << 5)); }
__host__ __device__ __forceinline__ void stage_rc(int b, int& R, int& C) { const int st = b / 1024, sb = b % 1024, swz = sb ^ (((sb >> 9) & 1) << 5); R = (st >> 1) * 16 + swz / 64; C = (st & 1) * 32 + (swz % 64) / 2; }
__host__ __device__ __forceinline__ int perm32(int rho) { const int n = rho >> 4, i = rho & 15; return 8 * (i >> 2) + 4 * n + (i & 3); }

struct Unit { int pm, pn; };
struct Gemm { const bf16_t* A; const bf16_t* Bt; int M, N, K; int lda, ldb; long tsA, tsB, ksB; };

struct StaticOrder {
    int nM, nN, nwg, G, c;
    __host__ __device__ void init(int M, int N, int G_, int c_) { nM = M / BM; nN = N / BM; nwg = nM * nN; G = G_; c = c_; }
    __host__ __device__ bool next(int i, Unit& u) const {
        const long L = (long)i * G + c; if (L >= nwg) return false;
        int wgid = (int)L; { const int q = nwg / NXCD, r = nwg % NXCD, xcd = wgid % NXCD, off = wgid / NXCD; wgid = (xcd < r ? xcd * (q + 1) : r * (q + 1) + (xcd - r) * q) + off; }
        const int nig = WGM * nN, gid = wgid / nig, fm = gid * WGM, gsz = (nM - fm) < WGM ? (nM - fm) : WGM;
        u.pm = fm + ((wgid % nig) % gsz); u.pn = (wgid % nig) / gsz; return true;
    }
    __device__ __forceinline__ void a_ready(const Unit&) const {}
    __device__ __forceinline__ void done(const Unit&) const {}
};
__device__ __forceinline__ unsigned cvt_pk_bf16(float lo, float hi) { unsigned r; asm volatile("v_cvt_pk_bf16_f32 %0, %1, %2" : "=v"(r) : "v"(lo), "v"(hi)); return r; }
typedef float f32x2 __attribute__((ext_vector_type(2)));
__device__ __forceinline__ f32x2 gelu_pk(f32x2 v) {
    const f32x2 av = __builtin_elementwise_abs(v), d = av * 0.2316418882f + 1.0f;
    f32x2 t; t.x = __builtin_amdgcn_rcpf(d.x); t.y = __builtin_amdgcn_rcpf(d.y);
    f32x2 q = t * 0.5307027145f + (-0.7265760135f); q = q * t + 0.7107068705f; q = q * t + (-0.142248368f); q = q * t + 0.127414796f; q = q * t;
    const f32x2 s = (v * v) * (-0.72134752044f);
    f32x2 e; e.x = __builtin_amdgcn_exp2f(s.x); e.y = __builtin_amdgcn_exp2f(s.y);
    const f32x2 m = v * (q * e), r = v - m;
    f32x2 o; o.x = v.x < 0.f ? m.x : r.x; o.y = v.y < 0.f ? m.y : r.y; return o;
}

struct EpiF32 {
    static constexpr bool PERM = false, AFTER_DRAIN = false;
    float* C; int ldc; const float* bias;
    __device__ __forceinline__ void operator()(const f32x4 (&acc)[2][2][4][2], const Unit& u, int wr, int wc, int fr, int fq) const {
        const int row0 = u.pm * BM + wr * 64 + fr, col0 = u.pn * BM + wc * 32 + 4 * fq;
        f32x4 bv[2][2];
#pragma unroll
        for (int bj = 0; bj < 2; ++bj)
#pragma unroll
            for (int n = 0; n < 2; ++n) bv[bj][n] = bias ? *(const f32x4*)(bias + col0 + bj * HALF + n * 16) : (f32x4){0.f, 0.f, 0.f, 0.f};
#pragma unroll
        for (int ai = 0; ai < 2; ++ai)
#pragma unroll
            for (int m = 0; m < 4; ++m) { float* rowp = C + (size_t)(row0 + ai * HALF + m * 16) * ldc + col0;
#pragma unroll
                for (int bj = 0; bj < 2; ++bj)
#pragma unroll
                    for (int n = 0; n < 2; ++n) *(f32x4*)(rowp + bj * HALF + n * 16) = acc[ai][bj][m][n] + bv[bj][n]; }
    }
};
template <int ACT  > struct EpiBf16 {
    static constexpr bool PERM = true, AFTER_DRAIN = false;
    bf16_t* O; int ldc; const float* bias; int split_cols; size_t split_stride;
    __device__ __forceinline__ void operator()(const f32x4 (&acc)[2][2][4][2], const Unit& u, int wr, int wc, int fr, int fq) const {
        const int row0 = u.pm * BM + wr * 64 + fr; int colt = u.pn * BM; bf16_t* base = O;
        if (split_cols) { const int t = colt / split_cols; base += (size_t)t * split_stride; colt -= t * split_cols; }
        const int col0 = colt + wc * 32 + 8 * fq, bcol0 = u.pn * BM + wc * 32 + 8 * fq;
        f32x4 bv[2][2];
#pragma unroll
        for (int bj = 0; bj < 2; ++bj)
#pragma unroll
            for (int n = 0; n < 2; ++n) bv[bj][n] = bias ? *(const f32x4*)(bias + bcol0 + bj * HALF + 4 * n) : (f32x4){0.f, 0.f, 0.f, 0.f};
#pragma unroll
        for (int ai = 0; ai < 2; ++ai)
#pragma unroll
            for (int m = 0; m < 4; ++m) { bf16_t* rowp = base + (size_t)(row0 + ai * HALF + m * 16) * ldc + col0;
#pragma unroll
                for (int bj = 0; bj < 2; ++bj) { f32x4 v0 = acc[ai][bj][m][0] + bv[bj][0], v1 = acc[ai][bj][m][1] + bv[bj][1];
                    if (ACT == 1) { f32x2 a = gelu_pk((f32x2){v0[0], v0[1]}), b = gelu_pk((f32x2){v0[2], v0[3]}), c = gelu_pk((f32x2){v1[0], v1[1]}), d = gelu_pk((f32x2){v1[2], v1[3]});
                        v0 = (f32x4){a.x, a.y, b.x, b.y}; v1 = (f32x4){c.x, c.y, d.x, d.y}; }
                    if (ACT == 2) {
#pragma unroll
                        for (int j = 0; j < 4; ++j) { v0[j] = 0.5f * v0[j] * (1.0f + erff(v0[j] * 0.70710678f)); v1[j] = 0.5f * v1[j] * (1.0f + erff(v1[j] * 0.70710678f)); } }
                    u32x4 w; w.x = cvt_pk_bf16(v0[0], v0[1]); w.y = cvt_pk_bf16(v0[2], v0[3]); w.z = cvt_pk_bf16(v1[0], v1[1]); w.w = cvt_pk_bf16(v1[2], v1[3]);
                    *(u32x4*)(rowp + bj * HALF) = w; } }
    }
};

template <class Epi, class Sched, bool STAMP = false>
__device__ __forceinline__ void gemm_phase(PG8_LAS unsigned char* lds, const Gemm g, const Sched& S, const Epi& E, unsigned long long* stamps) {
    const int tid = vtid(), wid = __builtin_amdgcn_readfirstlane(tid >> 6), lane = tid & 63, wr = wid >> 2, wc = wid & 3, fr = lane & 15, fq = lane >> 4;
    const int K = g.K, nt = K / BK;
    int ts_lo = 0, ts_hi = 0, nts = 0; const unsigned long long rt_entry = STAMP ? (unsigned long long)wall_clock64() : 0ull;
#define PG8_STAMP() do { if (STAMP && wid == 0 && nts < 64) { const unsigned long long _c = (unsigned long long)clock64(); \
        ts_lo = (lane == nts) ? (int)(unsigned)_c : ts_lo; ts_hi = (lane == nts) ? (int)(unsigned)(_c >> 32) : ts_hi; ++nts; } } while (0)
    PG8_STAMP();
    unsigned voffA[2], voffB[2];
#pragma unroll
    for (int i = 0; i < 2; ++i) { int R, C; stage_rc(tid * 16 + i * 8192, R, C); const int Rb = Epi::PERM ? ((R & ~31) + perm32(R & 31)) : R;
        voffA[i] = (unsigned)(R * g.lda + C) * 2u; voffB[i] = (unsigned)(Rb * g.ldb + C) * 2u; }
    const size_t kstep = (size_t)(BK * 2);
    const size_t hstepA = (size_t)HALF * g.lda * 2, hstepB = (size_t)HALF * g.ldb * 2;
    const unsigned ldsw = (unsigned)wid * 1024u;
    const int aoff = lds_byte(wr * 64 + fr, fq * 8), boff = lds_byte(wc * 32 + fr, fq * 8);
#define PG8_SA(b, h) (((b) * 2 + (h)) * HTB)
#define PG8_SB(b, h) ((4 + (b) * 2 + (h)) * HTB)
#define PG8_STAGE(bufoff, gbase, voff) do { _Pragma("unroll") for (int _i = 0; _i < 2; ++_i) \
        __builtin_amdgcn_global_load_lds((const unsigned*)((const char*)(gbase) + (voff)[_i]), (PG8_LAS unsigned*)(lds + (bufoff) + ldsw + _i * 8192), 16, 0, 0); } while (0)
#define PG8_LDA(dst, b, h) do { _Pragma("unroll") for (int m = 0; m < 4; ++m) _Pragma("unroll") for (int k = 0; k < 2; ++k) dst[m][k] = *(const PG8_LAS bf16x8*)(lds + PG8_SA(b, h) + aoff + m * 2048 + k * 1024); } while (0)
#define PG8_LDB(dst, b, h) do { _Pragma("unroll") for (int n = 0; n < 2; ++n) _Pragma("unroll") for (int k = 0; k < 2; ++k) dst[n][k] = *(const PG8_LAS bf16x8*)(lds + PG8_SB(b, h) + boff + n * 2048 + k * 1024); } while (0)
#define PG8_MMA(ai, bj, At, Bt) do { __builtin_amdgcn_s_setprio(1); _Pragma("unroll") for (int m = 0; m < 4; ++m) _Pragma("unroll") for (int n = 0; n < 2; ++n) _Pragma("unroll") for (int k = 0; k < 2; ++k) \
        acc[ai][bj][m][n] = __builtin_amdgcn_mfma_f32_16x16x32_bf16(Bt[n][k], At[m][k], acc[ai][bj][m][n], 0, 0, 0); __builtin_amdgcn_s_setprio(0); } while (0)
#define PG8_WAIT_V(n) asm volatile("s_waitcnt vmcnt(" #n ")" ::: "memory")
#define PG8_WAIT_L(n) asm volatile("s_waitcnt lgkmcnt(" #n ")" ::: "memory")
#define PG8_BAR __builtin_amdgcn_s_barrier()
#define PG8_SCHED __builtin_amdgcn_sched_barrier(0)
    Unit cur, nxt; int ui = 0;
    if (!S.next(0, cur)) return;
    f32x4 acc[2][2][4][2];
#pragma unroll
    for (int a = 0; a < 2; ++a)
#pragma unroll
        for (int b = 0; b < 2; ++b)
#pragma unroll
            for (int m = 0; m < 4; ++m)
#pragma unroll
                for (int n = 0; n < 2; ++n) acc[a][b][m][n] = (f32x4){0.f, 0.f, 0.f, 0.f};
    bf16x8 At[4][2], B0[2][2], B1[2][2];
    const char* cA = (const char*)g.A + (size_t)cur.pm * g.tsA; const char* cB = (const char*)g.Bt + (size_t)cur.pn * g.tsB + (size_t)cur.pm * g.ksB;
    S.a_ready(cur);
    PG8_STAGE(PG8_SB(0, 0), cB, voffB); PG8_STAGE(PG8_SA(0, 0), cA, voffA); PG8_STAGE(PG8_SB(0, 1), cB + hstepB, voffB); PG8_STAGE(PG8_SA(0, 1), cA + hstepA, voffA);
    if (wr == 1) PG8_BAR;
    PG8_WAIT_V(4); PG8_BAR;
    PG8_STAGE(PG8_SB(1, 0), cB + kstep, voffB); PG8_STAGE(PG8_SA(1, 0), cA + kstep, voffA); PG8_STAGE(PG8_SB(1, 1), cB + hstepB + kstep, voffB);
    PG8_WAIT_V(6); PG8_BAR;
    PG8_STAMP();
    for (;;) {
        const bool has_next = S.next(ui + 1, nxt);
        const char* nA = has_next ? (const char*)g.A + (size_t)nxt.pm * g.tsA : cA; const char* nB = has_next ? (const char*)g.Bt + (size_t)nxt.pn * g.tsB + (size_t)nxt.pm * g.ksB : cB;
        for (int t = 0; t < nt; t += 2) {
            const bool last = (t == nt - 2);
            const char* a1 = cA + (size_t)(t + 1) * kstep;
            const char* a2 = last ? nA : cA + (size_t)(t + 2) * kstep; const char* b2 = last ? nB : cB + (size_t)(t + 2) * kstep;
            const char* a3 = a2 + kstep; const char* b3 = b2 + kstep;
            if (last && has_next) S.a_ready(nxt);
            PG8_LDB(B0, 0, 0); PG8_SCHED; PG8_LDA(At, 0, 0); PG8_STAGE(PG8_SA(1, 1), a1 + hstepA, voffA);
            PG8_WAIT_L(8); PG8_BAR; PG8_WAIT_L(0); PG8_MMA(0, 0, At, B0); PG8_BAR; PG8_SCHED;
            PG8_LDB(B1, 0, 1); PG8_STAGE(PG8_SB(0, 0), b2, voffB);
            PG8_BAR; PG8_WAIT_L(0); PG8_MMA(0, 1, At, B1); PG8_BAR;
            PG8_LDA(At, 0, 1); PG8_STAGE(PG8_SA(0, 0), a2, voffA);
            PG8_BAR; PG8_WAIT_L(0); PG8_MMA(1, 0, At, B0); PG8_BAR; PG8_SCHED;
            PG8_STAGE(PG8_SB(0, 1), b2 + hstepB, voffB);
            PG8_WAIT_V(6); PG8_BAR; PG8_MMA(1, 1, At, B1); PG8_BAR;
            PG8_LDB(B0, 1, 0); PG8_SCHED; PG8_LDA(At, 1, 0); PG8_STAGE(PG8_SA(0, 1), a2 + hstepA, voffA);
            PG8_WAIT_L(8); PG8_BAR; PG8_WAIT_L(0); PG8_MMA(0, 0, At, B0); PG8_BAR; PG8_SCHED;
            PG8_LDB(B1, 1, 1); PG8_STAGE(PG8_SB(1, 0), b3, voffB);
            PG8_BAR; PG8_WAIT_L(0); PG8_MMA(0, 1, At, B1); PG8_BAR;
            PG8_LDA(At, 1, 1); PG8_STAGE(PG8_SA(1, 0), a3, voffA);
            PG8_BAR; PG8_WAIT_L(0); PG8_MMA(1, 0, At, B0); PG8_BAR; PG8_SCHED;
            PG8_STAGE(PG8_SB(1, 1), b3 + hstepB, voffB);
            PG8_WAIT_V(6); PG8_BAR; PG8_MMA(1, 1, At, B1); PG8_BAR;
        }
        PG8_STAMP();
        if constexpr (!Epi::AFTER_DRAIN) { const int t2 = vtid(), w2 = __builtin_amdgcn_readfirstlane(t2 >> 6), l2 = t2 & 63; E(acc, cur, w2 >> 2, w2 & 3, l2 & 15, l2 >> 4); S.done(cur); }
        PG8_STAMP();
        if (!has_next) break;
#pragma unroll
        for (int a = 0; a < 2; ++a)
#pragma unroll
            for (int b = 0; b < 2; ++b)
#pragma unroll
                for (int m = 0; m < 4; ++m)
#pragma unroll
                    for (int n = 0; n < 2; ++n) acc[a][b][m][n] = (f32x4){0.f, 0.f, 0.f, 0.f};
        cur = nxt; cA = nA; cB = nB; ++ui;
    }
    PG8_WAIT_V(0);
    if (wr == 0) PG8_BAR;
    PG8_BAR;
    if constexpr (Epi::AFTER_DRAIN) { E.fused(acc, cur, wr, wc, fr, fq, lds, wid, lane); S.done(cur); }
    PG8_STAMP();
    if (STAMP && wid == 0) { stamps[lane] = lane < nts ? (((unsigned long long)(unsigned)ts_hi << 32) | (unsigned)ts_lo) : 0ull;
        if (lane == 62) stamps[62] = rt_entry; if (lane == 63) stamps[63] = (unsigned long long)wall_clock64(); }
#undef PG8_STAMP
#undef PG8_SA
#undef PG8_SB
#undef PG8_STAGE
#undef PG8_LDA
#undef PG8_LDB
#undef PG8_MMA
#undef PG8_WAIT_V
#undef PG8_WAIT_L
#undef PG8_BAR
#undef PG8_SCHED
}
}

#define XB_TMO      128
#define XB_XCNT(j)  (256  + 64 * (j))
#define XB_XSUB(j)  (1280 + 64 * (j))
#define XB_XGEN(j)  (2304 + 64 * (j))
#define XB_TOP      3328
#define XB_TOPGEN   3392
#define XCD_BAR_WORDS 3456
#define XB_SPIN_CAP (1u << 18)

__device__ __forceinline__ unsigned xb_ld(unsigned* p)              { return __hip_atomic_load(p, __ATOMIC_RELAXED, __HIP_MEMORY_SCOPE_AGENT); }
__device__ __forceinline__ unsigned xb_add(unsigned* p, unsigned v) { return __hip_atomic_fetch_add(p, v, __ATOMIC_RELAXED, __HIP_MEMORY_SCOPE_AGENT); }
__device__ __forceinline__ unsigned xb_xcc_id() { return (unsigned)__builtin_amdgcn_s_getreg((3 << 11) | 20) & 0xFu; }
#define XB_SPIN(cond, bar) do { unsigned _sp = 0; while (cond) { __builtin_amdgcn_s_sleep(1); \
    if ((++_sp & 255u) == 0u) { if (xb_ld(&(bar)[XB_TMO])) break; if (_sp > XB_SPIN_CAP) { atomicAdd(&(bar)[XB_TMO], 1u); break; } } } } while (0)

struct XcdBarrier {
    unsigned* bar; unsigned x;
    volatile LAS unsigned* st;
};

__device__ __forceinline__ XcdBarrier xcd_barrier_post(unsigned* bar, volatile LAS unsigned* st) {
    XcdBarrier b; b.bar = bar; b.x = xb_xcc_id(); b.st = st;
    if (threadIdx.x == 0) (void)xb_add(&bar[XB_XCNT(b.x)], 1u);
    return b;
}
__device__ __forceinline__ void xcd_barrier_complete(unsigned* bar, unsigned x, unsigned& nloc, unsigned& nx) {
    const unsigned G = gridDim.x * gridDim.y * gridDim.z;
    unsigned sum, cnt, mine, sp = 0u;
    for (;;) {
        sum = 0u; cnt = 0u; mine = 0u;
#pragma unroll
        for (unsigned j = 0; j < 16; ++j) { const unsigned c = xb_ld(&bar[XB_XCNT(j)]); sum += c; cnt += (c > 0u) ? 1u : 0u; mine = (j == x) ? c : mine; }
        if (sum == G) break;
        __builtin_amdgcn_s_sleep(1);
        if ((++sp & 255u) == 0u) { if (xb_ld(&bar[XB_TMO])) break; if (sp > XB_SPIN_CAP) { atomicAdd(&bar[XB_TMO], 1u); break; } }
    }
    nloc = mine > 0u ? mine : 1u; nx = cnt > 0u ? cnt : 1u;
}

__device__ __forceinline__ void xcd_barrier(const XcdBarrier& b) {
    asm volatile("s_waitcnt vmcnt(0)" ::: "memory");
    __syncthreads();
    if (vtid() == 0) {
        unsigned* bar = b.bar;
        __builtin_amdgcn_s_waitcnt(0);
        unsigned nloc = b.st[0], nx = b.st[1];
        if (nloc == 0u) { xcd_barrier_complete(bar, b.x, nloc, nx); b.st[0] = nloc; b.st[1] = nx; }
        const unsigned old = xb_add(&bar[XB_XSUB(b.x)], 1u);
        const unsigned gen = old / nloc;
        if (old + 1u == (gen + 1u) * nloc) {
            __builtin_amdgcn_fence(__ATOMIC_RELEASE, "agent");
            asm volatile("s_waitcnt vmcnt(0)" ::: "memory");
            const unsigned og = xb_add(&bar[XB_TOP], 1u);
            const unsigned tg = og / nx;
            if (og + 1u == (tg + 1u) * nx) xb_add(&bar[XB_TOPGEN], 1u);
            else XB_SPIN(xb_ld(&bar[XB_TOPGEN]) == tg, bar);
            __builtin_amdgcn_fence(__ATOMIC_ACQUIRE, "agent");
            xb_add(&bar[XB_XGEN(b.x)], 1u);
            asm volatile("s_waitcnt vmcnt(0)" ::: "memory");
        } else {
            XB_SPIN(xb_ld(&bar[XB_XGEN(b.x)]) == gen, bar);
            __builtin_amdgcn_fence(__ATOMIC_ACQUIRE, "agent");
            asm volatile("s_waitcnt vmcnt(0)" ::: "memory");
        }
    }
    __syncthreads();
}


struct EpiBf16Plain {
    static constexpr bool PERM = true, AFTER_DRAIN = false;
    bf16_t* O; int ldc;
    DI void operator()(const f32x4 (&acc)[2][2][4][2], const pg8::Unit& u, int wr, int wc, int fr, int fq) const {
        const int row0 = u.pm * 256 + wr * 64 + fr, col0 = u.pn * 256 + wc * 32 + 8 * fq;
#pragma unroll
        for (int ai = 0; ai < 2; ++ai)
#pragma unroll
            for (int m = 0; m < 4; ++m) { bf16_t* rowp = O + (size_t)(row0 + ai * 128 + m * 16) * ldc + col0;
#pragma unroll
                for (int bj = 0; bj < 2; ++bj) { const f32x4 v0 = acc[ai][bj][m][0], v1 = acc[ai][bj][m][1];
                    u32x4 w; w.x = pack2(v0[0], v0[1]); w.y = pack2(v0[2], v0[3]); w.z = pack2(v1[0], v1[1]); w.w = pack2(v1[2], v1[3]);
                    *(u32x4*)(rowp + bj * 128) = w; } }
    }
};
struct EpiSwiglu {
    static constexpr bool PERM = true, AFTER_DRAIN = false;
    bf16_t* O;
    DI void operator()(const f32x4 (&acc)[2][2][4][2], const pg8::Unit& u, int wr, int wc, int fr, int fq) const {
        const int row0 = u.pm * 256 + wr * 64 + fr, col0 = u.pn * 128 + wc * 32 + 8 * fq;
#pragma unroll
        for (int ai = 0; ai < 2; ++ai)
#pragma unroll
            for (int m = 0; m < 4; ++m) { bf16_t* rowp = O + (size_t)(row0 + ai * 128 + m * 16) * DFF + col0;
                const f32x4 g0 = acc[ai][0][m][0], g1 = acc[ai][0][m][1], u0 = acc[ai][1][m][0], u1 = acc[ai][1][m][1];
                float v[8];
#pragma unroll
                for (int j = 0; j < 4; ++j) { v[j] = siluf_(g0[j]) * u0[j]; v[4 + j] = siluf_(g1[j]) * u1[j]; }
                u32x4 w; w.x = pack2(v[0], v[1]); w.y = pack2(v[2], v[3]); w.z = pack2(v[4], v[5]); w.w = pack2(v[6], v[7]);
                *(u32x4*)rowp = w; }
    }
};
struct EpiResid {
    static constexpr bool PERM = true, AFTER_DRAIN = false;
    const float* Xin; float* X; const float* gate; float scale;
    DI void operator()(const f32x4 (&acc)[2][2][4][2], const pg8::Unit& u, int wr, int wc, int fr, int fq) const {
        const int row0 = u.pm * 256 + wr * 64 + fr, col0 = u.pn * 256 + wc * 32 + 8 * fq;
#pragma unroll
        for (int ai = 0; ai < 2; ++ai)
#pragma unroll
            for (int mh = 0; mh < 2; ++mh) { const int rowa = row0 + ai * 128 + mh * 32;
                if (rowa < NTOK) { f32x4 xv[2][2][2], gv[2][2][2];
#pragma unroll
                    for (int mm = 0; mm < 2; ++mm) { const int row = rowa + mm * 16; const float* gp = gate + (size_t)row_stream(row) * MODLD + col0; const float* xp = Xin + (size_t)row * D + col0;
#pragma unroll
                        for (int bj = 0; bj < 2; ++bj)
#pragma unroll
                            for (int n = 0; n < 2; ++n) { xv[mm][bj][n] = *(const f32x4*)(xp + bj * 128 + n * 4); gv[mm][bj][n] = *(const f32x4*)(gp + bj * 128 + n * 4); } }
#pragma unroll
                    for (int mm = 0; mm < 2; ++mm) { float* xp = X + (size_t)(rowa + mm * 16) * D + col0;
#pragma unroll
                        for (int bj = 0; bj < 2; ++bj)
#pragma unroll
                            for (int n = 0; n < 2; ++n) *(f32x4*)(xp + bj * 128 + n * 4) = xv[mm][bj][n] + (gv[mm][bj][n] * scale) * acc[ai][bj][2 * mh + mm][n]; } } }
    }
};
struct EpiLora {
    static constexpr bool PERM = false, AFTER_DRAIN = false;
    float* C; const float* w0; const float* a0;
    DI void operator()(const f32x4 (&acc)[2][2][4][2], const pg8::Unit& u, int wr, int wc, int fr, int fq) const {
        const int row0 = u.pm * 256 + wr * 64 + fr, col0 = u.pn * 256 + wc * 32 + 4 * fq; const int kind = u.pn >> 2;
        const float* bp = (kind == 0 ? w0 : a0) + (col0 & 1023);
#pragma unroll
        for (int bj = 0; bj < 2; ++bj)
#pragma unroll
            for (int n = 0; n < 2; ++n) { f32x4 bv = {0.f, 0.f, 0.f, 0.f}; if (kind < 2) bv = *(const f32x4*)(bp + bj * 128 + n * 16);
#pragma unroll
                for (int ai = 0; ai < 2; ++ai)
#pragma unroll
                    for (int m = 0; m < 4; ++m) { f32x4 v = acc[ai][bj][m][n] + bv;
                        if (kind == 0) {
#pragma unroll
                            for (int j = 0; j < 4; ++j) { const float x = v[j]; const float ls = fminf(x, 0.f) - __logf(1.0f + __expf(-fabsf(x))); v[j] = __expf(-__expf(ls - 0.5f)); } }
                        else if (kind == 1) {
#pragma unroll
                            for (int j = 0; j < 4; ++j) v[j] = sigmoidf_(v[j]); }
                        *(f32x4*)(C + (size_t)(row0 + ai * 128 + m * 16) * 3072 + col0 + bj * 128 + n * 16) = v; }
                asm volatile("" ::: "memory"); }
    }
};
struct BranchOrder {
    int c, ntile;
    __device__ __forceinline__ bool next(int i, pg8::Unit& u) const { const int n = i % 3, t = c + (i / 3) * (int)gridDim.x; if (t >= ntile) return false;
        const int x = t & 7, j = t >> 3, rt = 4 * x + (j >> 3), ct = j & 7;     u.pm = n * 33 + rt; u.pn = n * 8 + ct; return true; }
    __device__ __forceinline__ void a_ready(const pg8::Unit&) const {}
    __device__ __forceinline__ void done(const pg8::Unit&) const {}
};
struct EpiBranchSeq {
    static constexpr bool PERM = true, AFTER_DRAIN = false;
    const bf16_t* Z; const float* bm; float* T; bf16_t* O;
    DI void operator()(const f32x4 (&acc)[2][2][4][2], const pg8::Unit& u, int wr, int wc, int fr, int fq) const {
        const int n = u.pn >> 3, ct = u.pn & 7, rt = u.pm - 33 * n;
        const int row0 = rt * 256 + wr * 64 + fr, col0 = ct * 256 + wc * 32 + 8 * fq;
        f32x4 bb[2][2];
#pragma unroll
        for (int bj = 0; bj < 2; ++bj) { bb[bj][0] = *(const f32x4*)(bm + n * D + col0 + bj * 128); bb[bj][1] = *(const f32x4*)(bm + n * D + col0 + bj * 128 + 4); }
#pragma unroll
        for (int ai = 0; ai < 2; ++ai) {
            u32x4 zw[4][2];
#pragma unroll
            for (int m = 0; m < 4; ++m)
#pragma unroll
                for (int bj = 0; bj < 2; ++bj) zw[m][bj] = *(const u32x4*)(Z + (size_t)(row0 + ai * 128 + m * 16) * ZLD + n * D + col0 + bj * 128);
#pragma unroll
            for (int mh = 0; mh < 2; ++mh) { f32x4 tv[2][2][2];
                if (n != 0) {
#pragma unroll
                    for (int mm = 0; mm < 2; ++mm)
#pragma unroll
                        for (int bj = 0; bj < 2; ++bj) { const float* tp = T + (size_t)(row0 + ai * 128 + (2 * mh + mm) * 16) * D + col0 + bj * 128; tv[mm][bj][0] = *(const f32x4*)tp; tv[mm][bj][1] = *(const f32x4*)(tp + 4); } }
#pragma unroll
                for (int mm = 0; mm < 2; ++mm)
#pragma unroll
                    for (int bj = 0; bj < 2; ++bj) { const int m = 2 * mh + mm; const u32x4 w = zw[m][bj]; const size_t o = (size_t)(row0 + ai * 128 + m * 16) * D + col0 + bj * 128;
                        f32x4 g0, g1; g0[0] = sigmoidf_(lo16(w.x) + bb[bj][0][0]); g0[1] = sigmoidf_(hi16(w.x) + bb[bj][0][1]); g0[2] = sigmoidf_(lo16(w.y) + bb[bj][0][2]); g0[3] = sigmoidf_(hi16(w.y) + bb[bj][0][3]);
                        g1[0] = sigmoidf_(lo16(w.z) + bb[bj][1][0]); g1[1] = sigmoidf_(hi16(w.z) + bb[bj][1][1]); g1[2] = sigmoidf_(lo16(w.w) + bb[bj][1][2]); g1[3] = sigmoidf_(hi16(w.w) + bb[bj][1][3]);
                        f32x4 v0 = g0 * acc[ai][bj][m][0], v1 = g1 * acc[ai][bj][m][1];
                        if (n != 0) { v0 += tv[mm][bj][0]; v1 += tv[mm][bj][1]; }
                        if (n != 2) { *(f32x4*)(T + o) = v0; *(f32x4*)(T + o + 4) = v1; }
                        else { u32x4 ow; ow.x = pack2(v0[0], v0[1]); ow.y = pack2(v0[2], v0[3]); ow.z = pack2(v1[0], v1[1]); ow.w = pack2(v1[2], v1[3]); *(u32x4*)(O + o) = ow; } } } }
    }
};
struct EpiSlab {
    static constexpr bool PERM = true, AFTER_DRAIN = false;
    float* slab;
    DI void operator()(const f32x4 (&acc)[2][2][4][2], const pg8::Unit& u, int wr, int wc, int fr, int fq) const {
        float* sp = slab + (size_t)u.pm * 128 * D + (size_t)(wr * 64 + fr) * D + u.pn * 256 + wc * 32 + 8 * fq;
#pragma unroll
        for (int m = 0; m < 4; ++m)
#pragma unroll
            for (int bj = 0; bj < 2; ++bj) { *(f32x4*)(sp + (size_t)m * 16 * D + bj * 128) = acc[0][bj][m][0]; *(f32x4*)(sp + (size_t)m * 16 * D + bj * 128 + 4) = acc[0][bj][m][1]; }
    }
};
struct EpiBranchSlab {
    static constexpr bool PERM = true, AFTER_DRAIN = false;
    const bf16_t* Z; const float* bm; float* slab; int slab0;
    DI void operator()(const f32x4 (&acc)[2][2][4][2], const pg8::Unit& u, int wr, int wc, int fr, int fq) const {
        const int col0 = u.pn * 256 + wc * 32 + 8 * fq; float* sp = slab + (size_t)(slab0 + u.pm) * 128 * D + (size_t)(wr * 64 + fr) * D + col0;
        u32x4 zw[4][2];
#pragma unroll
        for (int m = 0; m < 4; ++m)
#pragma unroll
            for (int bj = 0; bj < 2; ++bj) zw[m][bj] = *(const u32x4*)(Z + (size_t)(NTOK_P + wr * 64 + m * 16 + fr) * ZLD + col0 + bj * 128);
#pragma unroll
        for (int bj = 0; bj < 2; ++bj) { const f32x4 b0 = *(const f32x4*)(bm + col0 + bj * 128), b1 = *(const f32x4*)(bm + col0 + bj * 128 + 4);
#pragma unroll
            for (int m = 0; m < 4; ++m) { const u32x4 w = zw[m][bj];
                f32x4 g0, g1; g0[0] = sigmoidf_(lo16(w.x) + b0[0]); g0[1] = sigmoidf_(hi16(w.x) + b0[1]); g0[2] = sigmoidf_(lo16(w.y) + b0[2]); g0[3] = sigmoidf_(hi16(w.y) + b0[3]);
                g1[0] = sigmoidf_(lo16(w.z) + b1[0]); g1[1] = sigmoidf_(hi16(w.z) + b1[1]); g1[2] = sigmoidf_(lo16(w.w) + b1[2]); g1[3] = sigmoidf_(hi16(w.w) + b1[3]);
                *(f32x4*)(sp + (size_t)m * 16 * D + bj * 128) = g0 * acc[0][bj][m][0]; *(f32x4*)(sp + (size_t)m * 16 * D + bj * 128 + 4) = g1 * acc[0][bj][m][1]; } }
    }
};
template <class Epi> DI void run_gemm_splitk(ldsp_t lds, const bf16_t* Atile, const bf16_t* Bt, int N, int Kfull, int Ks, const Epi& E, int crot = 0) {
    const int S = Kfull / Ks;
    pg8::Gemm g{Atile, Bt, S * 256, N, Ks, Kfull, Kfull, (long)Ks * 2, (long)Kfull * 512, (long)Ks * 2}; pg8::StaticOrder So; So.init(S * 256, N, (int)gridDim.x, (int)((sbid() + gridDim.x - crot) % gridDim.x));
    pg8::gemm_phase<Epi, pg8::StaticOrder, false>((PG8_LAS unsigned char*)lds, g, So, E, nullptr);
}
template <class Epi> DI void run_gemm_sub(ldsp_t lds, const bf16_t* A, const bf16_t* Bt, int M, int N, int K, const Epi& E, int gsub, int csub) {
    pg8::Gemm g{A, Bt, M, N, K, K, K, (long)K * 512, (long)K * 512, 0}; pg8::StaticOrder S; S.init(M, N, gsub, csub);
    pg8::gemm_phase<Epi, pg8::StaticOrder, false>((PG8_LAS unsigned char*)lds, g, S, E, nullptr);
}
DI void sub_barrier(unsigned* cnt, unsigned* tmo, unsigned n, unsigned k) {
    asm volatile("s_waitcnt vmcnt(0)" ::: "memory");
    __syncthreads();
    if (vtid() == 0) {
        __builtin_amdgcn_fence(__ATOMIC_RELEASE, "agent");
        asm volatile("s_waitcnt vmcnt(0)" ::: "memory");
        (void)__hip_atomic_fetch_add(cnt, 1u, __ATOMIC_RELAXED, __HIP_MEMORY_SCOPE_AGENT);
        const unsigned target = n * (k + 1u); unsigned sp = 0u;
        while (__hip_atomic_load(cnt, __ATOMIC_RELAXED, __HIP_MEMORY_SCOPE_AGENT) < target) { __builtin_amdgcn_s_sleep(2);
            if ((++sp & 1023u) == 0u) { if (__hip_atomic_load(tmo, __ATOMIC_RELAXED, __HIP_MEMORY_SCOPE_AGENT)) break; if (sp > (1u << 21)) { atomicAdd(tmo, 1u); break; } } }
        __builtin_amdgcn_fence(__ATOMIC_ACQUIRE, "agent");
        asm volatile("s_waitcnt vmcnt(0)" ::: "memory");
    }
    __syncthreads();
}
template <class Epi> DI void run_gemm(ldsp_t lds, const bf16_t* A, const bf16_t* Bt, int M, int N, int K, const Epi& E) {
    pg8::Gemm g{A, Bt, M, N, K, K, K, (long)K * 512, (long)K * 512, 0}; pg8::StaticOrder S; S.init(M, N, (int)gridDim.x, (int)sbid());
    pg8::gemm_phase<Epi, pg8::StaticOrder, false>((PG8_LAS unsigned char*)lds, g, S, E, nullptr);
}

DI void conv_tile(const float* __restrict src, int ldw, int K, bf16_t* __restrict dst, int valid_rows, int mode, int tr, int tk, LAS float* T) {
    const int tid = vtid(), lane = tid & 63, wave = tid >> 6;
    const int j = tr * 64 + lane; const bool valid = j < valid_rows;
    int sc;
    if (mode == 0) sc = j;
    else if (mode == 1) { const int pn = j >> 8, r = j & 255; sc = (r < 128) ? pn * 128 + r : DFF + pn * 128 + (r - 128); }
    else if (mode == 2) sc = (j >> 7) * 256 + (j & 127);
    else sc = (j >> 7) * 256 + 128 + (j & 127);
    const float* sp = src + (size_t)(tk * 256 + wave) * ldw + (valid ? sc : 0);
    float v[32];
#pragma unroll
    for (int i = 0; i < 32; ++i) v[i] = valid ? sp[(size_t)(8 * i) * ldw] : 0.f;
#pragma unroll
    for (int i = 0; i < 32; ++i) T[(wave + 8 * i) * 65 + lane] = v[i];
    __syncthreads();
    const int row = tid >> 3;
#pragma unroll
    for (int c = 0; c < 4; ++c) { const int kc = (tid & 7) * 8 + 64 * c; float f[8];
#pragma unroll
        for (int i = 0; i < 8; ++i) f[i] = T[(kc + i) * 65 + row];
        u32x4 w; w.x = pack2(f[0], f[1]); w.y = pack2(f[2], f[3]); w.z = pack2(f[4], f[5]); w.w = pack2(f[6], f[7]);
        *(u32x4*)(dst + (size_t)(tr * 64 + row) * K + tk * 256 + kc) = w; }
    __syncthreads();
}

DI void prologue_phase(const Params& P, ldsp_t lds) {
    const int tid = vtid(), lane = tid & 63, wave = tid >> 6;
    const int G = gridDim.x, gtid = sbid() * 512 + tid, gsz = G * 512;
    unsigned char* ws = wsp(P);
    const float* in_w2 = INP(I_W2); const float* in_a2 = INP(I_A2); const float* in_g2 = INP(I_G2); const float* in_cp = INP(I_CP); const float* in_cs = INP(I_CS);
    const float* in_adaw = INP(I_ADAW); const float* in_adab = INP(I_ADAB);
    { f32x2* rt = (f32x2*)(ws + WS_ROPE);
      for (int idx = gtid; idx < 4096 * 32; idx += gsz) { const int pos = idx >> 5, i = idx & 31;
          const float inv = exp2f(-(float)i * 0.41524101186092029f);
          const double turns = (double)pos * (double)inv * 0.15915494309189535;
          const float fr = (float)(turns - rint(turns));
          f32x2 cs; cs.x = __builtin_amdgcn_cosf(fr); cs.y = __builtin_amdgcn_sinf(fr); rt[idx] = cs; } }
    for (int idx = gtid; idx < 2 * 3072 * 256; idx += gsz) { const int l = idx / (3072 * 256), e = idx % (3072 * 256), j = e >> 8, k = e & 255; float v = 0.f;
        if (j < 1024) { if (k < 64) v = in_w2[((size_t)l * 64 + k) * 1024 + j]; }
        else if (j < 2048) { if (k >= 64 && k < 128) v = in_a2[((size_t)l * 64 + (k - 64)) * 1024 + (j - 1024)]; }
        else { if (k >= 128) v = in_g2[((size_t)l * 128 + (k - 128)) * 1024 + (j - 2048)]; }
        ((bf16_t*)(ws + WS_WLO))[idx] = f2bf(v); }
    { LAS float* S = (LAS float*)lds;
      LAS float* R = S + 2048 * 12;
      for (int idx = tid; idx < 2048 * 10; idx += 512) { const int s = idx >> 11, k = idx & 2047;
          const float c = s < 2 ? in_cp[s * 2048 + k] : in_cs[(s - 2) * 2048 + k]; S[k * 12 + s] = siluf_(c); }
      for (int idx = tid; idx < 2048; idx += 512) { S[idx * 12 + 10] = 0.f; S[idx * 12 + 11] = 0.f; }
      __syncthreads();
      float* mod = (float*)(ws + WS_MOD);
      for (int item = sbid(); item < 576; item += G) { const int l = item / 288, cgp = item % 288;
          const float* W = in_adaw + (size_t)l * 2048 * MODLD + cgp * 64 + lane; const int k0 = wave * 256;
          float acc[10];
#pragma unroll
          for (int s = 0; s < 10; ++s) acc[s] = 0.f;
          for (int kk = 0; kk < 256; kk += 8) { float w[8];
#pragma unroll
              for (int i = 0; i < 8; ++i) w[i] = W[(size_t)(k0 + kk + i) * MODLD];
#pragma unroll
              for (int i = 0; i < 8; ++i) { const LAS float* sp = S + (k0 + kk + i) * 12; const f32x4 s0 = *(const LAS f32x4*)sp, s1 = *(const LAS f32x4*)(sp + 4), s2 = *(const LAS f32x4*)(sp + 8);
                  acc[0] += w[i] * s0[0]; acc[1] += w[i] * s0[1]; acc[2] += w[i] * s0[2]; acc[3] += w[i] * s0[3]; acc[4] += w[i] * s1[0];
                  acc[5] += w[i] * s1[1]; acc[6] += w[i] * s1[2]; acc[7] += w[i] * s1[3]; acc[8] += w[i] * s2[0]; acc[9] += w[i] * s2[1]; } }
#pragma unroll
          for (int s = 0; s < 10; ++s) R[(wave * 10 + s) * 64 + lane] = acc[s];
          __syncthreads();
          for (int o = tid; o < 640; o += 512) { const int s = o >> 6, c = o & 63; float t = 0.f;
#pragma unroll
              for (int w8 = 0; w8 < 8; ++w8) t += R[(w8 * 10 + s) * 64 + c];
              mod[(size_t)(l * 10 + s) * MODLD + cgp * 64 + c] = t + in_adab[(size_t)l * MODLD + cgp * 64 + c]; }
          __syncthreads(); } }
    { LAS float* T = (LAS float*)lds;
      const float* in_fwi = INP(I_FWI); const float* in_fwo = INP(I_FWO); const float* in_win = INP(I_WIN); const float* in_wkvb = INP(I_WKVB); const float* in_wbr = INP(I_WBR); const float* in_wout = INP(I_WOUT);
      const int PER_LAYER = 1408 + 1408 + 704 + 704 + 1856 + 32 + 32 + 128 + 128 + 128 + 256;
      const int start = (sbid() + 64) % G;
      for (int tile = start; tile < 2 * PER_LAYER; tile += G) {
          const int l = tile / PER_LAYER; int t = tile % PER_LAYER;
          if (l == 1 && (t >= 1408 && t < 4224)) continue;
          const float* src; bf16_t* dst; int ldw, K, vr, mode, nkt;
          if (t < 2816) { const int f = t / 1408; t %= 1408; src = in_fwi + (size_t)(l * 2 + f) * D * (2 * DFF); dst = (bf16_t*)(ws + WS_WFI + (l * 2 + f) * SZ_WFI); ldw = 2 * DFF; K = D; vr = 2 * DFF; mode = 1; nkt = 8; }
          else if (t < 4224) { t -= 2816; const int f = t / 704; t %= 704; src = in_fwo + (size_t)(l * 2 + f) * DFF * D; dst = (bf16_t*)(ws + WS_WFO + (l * 2 + f) * SZ_WFO); ldw = D; K = DFF; vr = D; mode = 0; nkt = 22; }
          else if (t < 6080) { t -= 4224; src = in_win + (size_t)l * D * INCOLS; dst = (bf16_t*)(ws + WS_WIN + l * SZ_WIN); ldw = INCOLS; K = D; vr = INCOLS; mode = 0; nkt = 8; }
          else if (t < 6112) { t -= 6080; src = in_wkvb + (size_t)l * 512 * 2048; dst = (bf16_t*)(ws + WS_WKK + l * SZ_WKK); ldw = 2048; K = 512; vr = 1024; mode = 2; nkt = 2; }
          else if (t < 6144) { t -= 6112; src = in_wkvb + (size_t)l * 512 * 2048; dst = (bf16_t*)(ws + WS_WKV + l * SZ_WKK); ldw = 2048; K = 512; vr = 1024; mode = 3; nkt = 2; }
          else if (t < 6528) { t -= 6144; const int n = t / 128; t %= 128; src = in_wbr + (size_t)(l * 3 + n) * 1024 * D; dst = (bf16_t*)(ws + WS_WBR + (l * 3 + n) * SZ_WBR); ldw = D; K = 1024; vr = D; mode = 0; nkt = 4; }
          else { t -= 6528; src = in_wout + (size_t)l * D * D; dst = (bf16_t*)(ws + WS_WO + l * SZ_WO); ldw = D; K = D; vr = D; mode = 0; nkt = 8; }
          conv_tile(src, ldw, K, dst, vr, mode, t / nkt, t % nkt, T); } }
}

DI void conv_deferred(const Params& P, ldsp_t lds, int d0, int d1, int b0) {
    unsigned char* ws = wsp(P); LAS float* T = (LAS float*)lds; const float* in_fwi = INP(I_FWI); const float* in_fwo = INP(I_FWO);
    for (int d = d0 + ((int)sbid() - b0); d < d1; d += (int)gridDim.x - b0) {
        if (d < 1408) conv_tile(in_fwi + (size_t)3 * D * (2 * DFF), 2 * DFF, D, (bf16_t*)(ws + WS_WFI + 3 * SZ_WFI), 2 * DFF, 1, d / 8, d % 8, T);
        else { const int t = d - 1408; conv_tile(in_fwo + (size_t)3 * DFF * D, D, DFF, (bf16_t*)(ws + WS_WFO + 3 * SZ_WFO), D, 0, t / 22, t % 22, T); } }
}

DI void conv_deferred_fo(const Params& P, ldsp_t lds, int c, int n) {
    unsigned char* ws = wsp(P); LAS float* T = (LAS float*)lds; const float* in_fwo = INP(I_FWO);
    for (int d = c; d < 704; d += n)
        conv_tile(in_fwo + (size_t)2 * DFF * D, D, DFF, (bf16_t*)(ws + WS_WFO + 2 * SZ_WFO), D, 0, d / 22, d % 22, T);
}

DI void sample_row_slab_sum(ldsp_t lds, const unsigned char* ws, int j, int pend_s, f32x4 (&a)[8]) {
    const int tid = vtid(), lane = tid & 63, wave = tid >> 6; const float* sl = (const float*)(ws + WS_LOUT) + (size_t)j * D + 4 * lane;
#pragma unroll
    for (int i = 0; i < 8; ++i) a[i] = (f32x4){0.f, 0.f, 0.f, 0.f};
    for (int k = wave; k < pend_s; k += 8) {
#pragma unroll
        for (int i = 0; i < 8; ++i) a[i] += *(const f32x4*)(sl + (size_t)k * 128 * D + 256 * i); }
    LAS f32x4* part = (LAS f32x4*)lds;
#pragma unroll
    for (int i = 0; i < 8; ++i) part[wave * 512 + lane + 64 * i] = a[i];
    __syncthreads();
    if (wave == 0) {
#pragma unroll
        for (int w = 1; w < 8; ++w)
#pragma unroll
            for (int i = 0; i < 8; ++i) a[i] += part[w * 512 + lane + 64 * i]; }
    __syncthreads();
}
DI void norm_phase(const Params& P, ldsp_t lds, int l, int which, bool first, int pend_s = 0, const float* pend_gate = nullptr, float pend_scale = 0.f) {
    unsigned char* ws = wsp(P); const float* in_ng = INP(I_NORMG); const float* in_xp = INP(I_XP); const float* in_xs = INP(I_XS);
    const int lane = vtid() & 63, gw = sbid() * 8 + (vtid() >> 6);
    float* xb = (float*)(ws + WS_X); bf16_t* h = (bf16_t*)(ws + WS_H); const float* mod = (const float*)(ws + WS_MOD);
    if (pend_s > 0) {
        for (int j = sbid(); j < NTOK - NTOK_P; j += gridDim.x) { const int r = NTOK_P + j, s = row_stream(r); f32x4 a[8];
            sample_row_slab_sum(lds, ws, j, pend_s, a);
            if ((vtid() >> 6) == 0) { const float* gp = pend_gate + (size_t)s * MODLD + 4 * lane; float* xr = xb + (size_t)r * D + 4 * lane; bf16_t* hp = h + (size_t)r * D + 4 * lane;
                const float* ngp = in_ng + (size_t)(l * 3 + which) * D + 4 * lane; const float* mp = mod + (size_t)(l * 10 + s) * MODLD + (which * 3) * D + 4 * lane; float ss = 0.f; f32x4 x[8];
#pragma unroll
                for (int i = 0; i < 8; ++i) { x[i] = *(const f32x4*)(xr + 256 * i) + (*(const f32x4*)(gp + 256 * i) * pend_scale) * a[i]; *(f32x4*)(xr + 256 * i) = x[i]; ss += x[i][0] * x[i][0] + x[i][1] * x[i][1] + x[i][2] * x[i][2] + x[i][3] * x[i][3]; }
                ss = wave_sum(ss); const float rstd = rsqrtf(ss * (1.0f / D) + 1e-6f);
#pragma unroll
                for (int i = 0; i < 8; ++i) { const f32x4 g = *(const f32x4*)(ngp + 256 * i), sc = *(const f32x4*)(mp + D + 256 * i), shv = *(const f32x4*)(mp + 256 * i); const f32x4 y = x[i] * rstd * (g * (sc + 1.0f)) + shv;
                    u32x2 w; w.x = pack2(y[0], y[1]); w.y = pack2(y[2], y[3]); *(u32x2*)(hp + 256 * i) = w; } } } }
    { const int rb = gw * 4, s = row_stream(rb); f32x4 gm[8], sh[8];
      const float* gp = in_ng + (size_t)(l * 3 + which) * D + 4 * lane; const float* mp = mod + (size_t)(l * 10 + s) * MODLD + (which * 3) * D + 4 * lane;
#pragma unroll
      for (int i = 0; i < 8; ++i) { const f32x4 g = *(const f32x4*)(gp + 256 * i), sc = *(const f32x4*)(mp + D + 256 * i); sh[i] = *(const f32x4*)(mp + 256 * i); gm[i] = g * (sc + 1.0f); }
      const float* xp0 = (first ? in_xp : (const float*)xb) + (size_t)rb * D + 4 * lane; bf16_t* hp0 = h + (size_t)rb * D + 4 * lane;
      f32x4 x[2][8];
#pragma unroll
      for (int i = 0; i < 8; ++i) x[0][i] = *(const f32x4*)(xp0 + 256 * i);
#pragma unroll
      for (int k = 0; k < 4; ++k) {
          if (k < 3) {
#pragma unroll
              for (int i = 0; i < 8; ++i) x[(k + 1) & 1][i] = *(const f32x4*)(xp0 + (size_t)(k + 1) * D + 256 * i); }
          float ss = 0.f;
#pragma unroll
          for (int i = 0; i < 8; ++i) { const f32x4 v = x[k & 1][i]; ss += v[0] * v[0] + v[1] * v[1] + v[2] * v[2] + v[3] * v[3]; }
          ss = wave_sum(ss); const float rstd = rsqrtf(ss * (1.0f / D) + 1e-6f);
#pragma unroll
          for (int i = 0; i < 8; ++i) { const f32x4 y = x[k & 1][i] * rstd * gm[i] + sh[i]; u32x2 w; w.x = pack2(y[0], y[1]); w.y = pack2(y[2], y[3]); *(u32x2*)(hp0 + (size_t)k * D + 256 * i) = w; } } }
    if (gw >= 1024 && gw < 1280) { const int r = NTOK_P + gw - 1024; bf16_t* hp = h + (size_t)r * D + 4 * lane;
        if (r >= NTOK) {
#pragma unroll
            for (int i = 0; i < 8; ++i) *(u32x2*)(hp + 256 * i) = (u32x2){0u, 0u}; }
        else if (pend_s == 0) { const int s = row_stream(r);
            const float* gp = in_ng + (size_t)(l * 3 + which) * D + 4 * lane; const float* mp = mod + (size_t)(l * 10 + s) * MODLD + (which * 3) * D + 4 * lane;
            const float* xp = (first ? in_xs + (size_t)(r - NTOK_P) * D : (const float*)xb + (size_t)r * D) + 4 * lane;
            f32x4 x[8]; float ss = 0.f;
#pragma unroll
            for (int i = 0; i < 8; ++i) x[i] = *(const f32x4*)(xp + 256 * i);
#pragma unroll
            for (int i = 0; i < 8; ++i) ss += x[i][0] * x[i][0] + x[i][1] * x[i][1] + x[i][2] * x[i][2] + x[i][3] * x[i][3];
            ss = wave_sum(ss); const float rstd = rsqrtf(ss * (1.0f / D) + 1e-6f);
            if (first) {
#pragma unroll
                for (int i = 0; i < 8; ++i) *(f32x4*)(xb + (size_t)r * D + 4 * lane + 256 * i) = x[i]; }
#pragma unroll
            for (int i = 0; i < 8; ++i) { const f32x4 g = *(const f32x4*)(gp + 256 * i), sc = *(const f32x4*)(mp + D + 256 * i), shv = *(const f32x4*)(mp + 256 * i); const f32x4 y = x[i] * rstd * (g * (sc + 1.0f)) + shv;
                u32x2 w; w.x = pack2(y[0], y[1]); w.y = pack2(y[2], y[3]); *(u32x2*)(hp + 256 * i) = w; } } }
}
DI void final_phase(const Params& P, ldsp_t lds, int pend_s, const float* pend_gate, float pend_scale) {
    unsigned char* ws = wsp(P); float* out = outp(P); const float* in_fng = INP(I_FNG);
    const int lane = vtid() & 63, gw = sbid() * 8 + (vtid() >> 6), nwv = gridDim.x * 8;
    const float* xb = (const float*)(ws + WS_X);
    f32x4 g[8];
#pragma unroll
    for (int i = 0; i < 8; ++i) g[i] = *(const f32x4*)(in_fng + 4 * lane + 256 * i);
    for (int j = sbid(); j < NTOK - NTOK_P; j += gridDim.x) { const int r = NTOK_P + j; f32x4 a[8];
        sample_row_slab_sum(lds, ws, j, pend_s, a);
        if ((vtid() >> 6) == 0) { const float* gp = pend_gate + (size_t)row_stream(r) * MODLD + 4 * lane; const float* xr = xb + (size_t)r * D + 4 * lane; float ss = 0.f; f32x4 x[8];
#pragma unroll
            for (int i = 0; i < 8; ++i) { x[i] = *(const f32x4*)(xr + 256 * i) + (*(const f32x4*)(gp + 256 * i) * pend_scale) * a[i]; ss += x[i][0] * x[i][0] + x[i][1] * x[i][1] + x[i][2] * x[i][2] + x[i][3] * x[i][3]; }
            ss = wave_sum(ss); const float rstd = rsqrtf(ss * (1.0f / D) + 1e-6f); float* op = out + O_YS + (size_t)j * D + 4 * lane;
#pragma unroll
            for (int i = 0; i < 8; ++i) *(f32x4*)(op + 256 * i) = x[i] * rstd * g[i]; } }
    for (int r = gw; r < NTOK_P; r += nwv) { const float* xp = xb + (size_t)r * D + 4 * lane; f32x4 x[8]; float ss = 0.f;
#pragma unroll
        for (int i = 0; i < 8; ++i) x[i] = *(const f32x4*)(xp + 256 * i);
#pragma unroll
        for (int i = 0; i < 8; ++i) ss += x[i][0] * x[i][0] + x[i][1] * x[i][1] + x[i][2] * x[i][2] + x[i][3] * x[i][3];
        ss = wave_sum(ss); const float rstd = rsqrtf(ss * (1.0f / D) + 1e-6f);
        float* op = out + (r < NTOK_P ? O_YP + (size_t)r * D : O_YS + (size_t)(r - NTOK_P) * D) + 4 * lane;
#pragma unroll
        for (int i = 0; i < 8; ++i) *(f32x4*)(op + 256 * i) = x[i] * rstd * g[i]; }
}

DI void prep_phase(const Params& P, int l) {
    const int lane = vtid() & 63, gw = sbid() * 8 + (vtid() >> 6), nwv = gridDim.x * 8;
    unsigned char* ws = wsp(P); float* out = outp(P); const float* in_clat = INP(I_CLAT); const float* in_ckr = INP(I_CKR); const float* in_rwsh = INP(I_RWSH);
    const bf16_t* z = (const bf16_t*)(ws + WS_Z); bf16_t* latA = (bf16_t*)(ws + WS_LATA); bf16_t* krA = (bf16_t*)(ws + WS_KRA); bf16_t* qR = (bf16_t*)(ws + WS_QR); bf16_t* lin = (bf16_t*)(ws + WS_LIN);
    const f32x2* rope = (const f32x2*)(ws + WS_ROPE);
    f32x4 kg0 = *(const f32x4*)(INP(I_KVG) + l * 512 + 8 * lane), kg1 = *(const f32x4*)(INP(I_KVG) + l * 512 + 8 * lane + 4);
    const f32x4 mu4 = *(const f32x4*)(INP(I_MU) + (size_t)l * 3328 + 3072 + 4 * lane);
    for (int row = gw; row < MP; row += nwv) {
        if (row >= NTOK) { *(u32x2*)(lin + (size_t)row * 256 + 4 * lane) = (u32x2){0u, 0u}; continue; }
        const bool pr = row < NTOK_P; const int s = row_stream(row), b = pr ? s : s - 2, t = pr ? (row & 4095) : ((row - NTOK_P) & 15), pos = pr ? t : 2048 + t, T = pr ? 4096 : 16;
        const bf16_t* zr = z + (size_t)row * ZLD;
        const int keyrow = pr ? row : NTOK_P + b * SKEY + 2048 + t;
        { const u32x4 lv = *(const u32x4*)(zr + ZLAT + 8 * lane);
          float v[8] = {lo16(lv.x), hi16(lv.x), lo16(lv.y), hi16(lv.y), lo16(lv.z), hi16(lv.z), lo16(lv.w), hi16(lv.w)}; float ss = 0.f;
#pragma unroll
          for (int j = 0; j < 8; ++j) ss += v[j] * v[j];
          ss = wave_sum(ss); const float rstd = rsqrtf(ss * (1.0f / 512.0f) + 1e-6f);
          f32x4 o0, o1;
#pragma unroll
          for (int j = 0; j < 4; ++j) { o0[j] = v[j] * rstd * kg0[j]; o1[j] = v[4 + j] * rstd * kg1[j]; }
          float* op = out + (pr ? O_PLAT + ((size_t)(l * 2 + b) * 4096 + t) * 512 : O_SLAT + ((size_t)(l * 8 + b) * 16 + t) * 512) + 8 * lane;
          *(f32x4*)op = o0; *(f32x4*)(op + 4) = o1;
          u32x4 w; w.x = pack2(o0[0], o0[1]); w.y = pack2(o0[2], o0[3]); w.z = pack2(o1[0], o1[1]); w.w = pack2(o1[2], o1[3]);
          *(u32x4*)(latA + (size_t)keyrow * 512 + 8 * lane) = w; }
        if (lane < 8) { const u32x2 a = *(const u32x2*)(zr + ZKR + 4 * lane), c = *(const u32x2*)(zr + ZKR + 32 + 4 * lane);
            const f32x4 c0 = *(const f32x4*)(rope + pos * 32 + 4 * lane), c1 = *(const f32x4*)(rope + pos * 32 + 4 * lane + 2);
            const f32x4 x1 = {lo16(a.x), hi16(a.x), lo16(a.y), hi16(a.y)}, x2 = {lo16(c.x), hi16(c.x), lo16(c.y), hi16(c.y)};
            const f32x4 cc = {c0[0], c0[2], c1[0], c1[2]}, sn = {c0[1], c0[3], c1[1], c1[3]};
            const f32x4 o1 = x1 * cc - x2 * sn, o2 = x2 * cc + x1 * sn;
            float* op = out + (pr ? O_PKR + ((size_t)(l * 2 + b) * 4096 + t) * 64 : O_SKR + ((size_t)(l * 8 + b) * 16 + t) * 64) + 4 * lane;
            *(f32x4*)op = o1; *(f32x4*)(op + 32) = o2;
            u32x2 w1, w2; w1.x = pack2(o1[0], o1[1]); w1.y = pack2(o1[2], o1[3]); w2.x = pack2(o2[0], o2[1]); w2.y = pack2(o2[2], o2[3]);
            *(u32x2*)(krA + (size_t)keyrow * 64 + 4 * lane) = w1; *(u32x2*)(krA + (size_t)keyrow * 64 + 32 + 4 * lane) = w2; }
        { const int hd = lane >> 3, i4 = (lane & 7) * 4; const bf16_t* qp = zr + ZQA + hd * 192 + 128 + i4;
            const u32x2 a = *(const u32x2*)qp, c = *(const u32x2*)(qp + 32);
            const f32x4 c0 = *(const f32x4*)(rope + pos * 32 + i4), c1 = *(const f32x4*)(rope + pos * 32 + i4 + 2);
            const f32x4 x1 = {lo16(a.x), hi16(a.x), lo16(a.y), hi16(a.y)}, x2 = {lo16(c.x), hi16(c.x), lo16(c.y), hi16(c.y)};
            const f32x4 cc = {c0[0], c0[2], c1[0], c1[2]}, sn = {c0[1], c0[3], c1[1], c1[3]};
            const f32x4 o1 = x1 * cc - x2 * sn, o2 = x2 * cc + x1 * sn;
            u32x2 w1, w2; w1.x = pack2(o1[0], o1[1]); w1.y = pack2(o1[2], o1[3]); w2.x = pack2(o2[0], o2[1]); w2.y = pack2(o2[2], o2[3]);
            bf16_t* qo = qR + (size_t)row * 512 + hd * 64 + i4; *(u32x2*)qo = w1; *(u32x2*)(qo + 32) = w2; }
        { const u32x2 cw = *(const u32x2*)(zr + ZWD + 4 * lane); f32x4 cur = {lo16(cw.x), hi16(cw.x), lo16(cw.y), hi16(cw.y)}, prev;
          if (t > 0) { const u32x2 pw = *(const u32x2*)(zr - ZLD + ZWD + 4 * lane); prev = (f32x4){lo16(pw.x), hi16(pw.x), lo16(pw.y), hi16(pw.y)}; }
          else if (pr) prev = (f32x4){0.f, 0.f, 0.f, 0.f};
          else prev = *(const f32x4*)(in_rwsh + (size_t)(l * 8 + b) * 3328 + 3072 + 4 * lane);
          f32x4 xs = cur + (prev - cur) * mu4, o;
#pragma unroll
          for (int j = 0; j < 4; ++j) o[j] = lane < 16 ? tanhf(xs[j]) : (lane < 32 ? xs[j] : sigmoidf_(xs[j]));
          u32x2 w; w.x = pack2(o[0], o[1]); w.y = pack2(o[2], o[3]); *(u32x2*)(lin + (size_t)row * 256 + 4 * lane) = w; }
        if (t == T - 1) { float* op = out + (pr ? O_PSH + (size_t)(l * 2 + b) * 3328 : O_SSH + (size_t)(l * 8 + b) * 3328);
#pragma unroll 2
            for (int c = lane; c < 3328; c += 64) op[c] = bf2f(zr[ZR + c]); }
    }
}

DI void cache_convert(const Params& P, int l, int b0) {
    const int lane = vtid() & 63, gw = (sbid() - b0) * 8 + (vtid() >> 6), nwv = ((int)gridDim.x - b0) * 8;
    unsigned char* ws = wsp(P); const float* in_clat = INP(I_CLAT); const float* in_ckr = INP(I_CKR);
    bf16_t* latA = (bf16_t*)(ws + WS_LATA); bf16_t* krA = (bf16_t*)(ws + WS_KRA);
    for (int idx = gw; idx < 8 * SKEY; idx += nwv) { const int b = idx / SKEY, j = idx % SKEY; const size_t keyrow = NTOK_P + idx;
        if (j < 2048) { const float* cp = in_clat + ((size_t)(l * 8 + b) * 2048 + j) * 512 + 8 * lane; const f32x4 a = *(const f32x4*)cp, c = *(const f32x4*)(cp + 4);
            u32x4 w; w.x = pack2(a[0], a[1]); w.y = pack2(a[2], a[3]); w.z = pack2(c[0], c[1]); w.w = pack2(c[2], c[3]); *(u32x4*)(latA + keyrow * 512 + 8 * lane) = w;
            krA[keyrow * 64 + lane] = f2bf(in_ckr[((size_t)(l * 8 + b) * 2048 + j) * 64 + lane]); }
        else if (j >= 2064) { *(u32x4*)(latA + keyrow * 512 + 8 * lane) = (u32x4){0u, 0u, 0u, 0u}; krA[keyrow * 64 + lane] = 0; } }
}

DI void sample_mix_convert(const Params& P) {
    unsigned char* ws = wsp(P); const f32x4* S = (const f32x4*)(ws + WS_LOUT); u32x2* M = (u32x2*)((bf16_t*)(ws + WS_MIX) + (size_t)NTOK_P * D);
    for (int i = sbid() * 512 + vtid(); i < 128 * D / 4; i += gridDim.x * 512) { f32x4 v = S[i];
#pragma unroll
        for (int k = 1; k < 12; ++k) v += S[(size_t)k * (128 * D / 4) + i];
        u32x2 w; w.x = pack2(v[0], v[1]); w.y = pack2(v[2], v[3]); M[i] = w; }
}

DI f32x16 mma_tile32(const LAS bf16_t* A, int lda, const LAS bf16_t* Bt, int ldb, int K, f32x16 acc, int lane) {
    const int r = lane & 31, hh = lane >> 5;
    const LAS bf16_t* ap = A + r * lda + 8 * hh; const LAS bf16_t* bp = Bt + r * ldb + 8 * hh;
    for (int k = 0; k < K; k += 16) { const bf16x8 a = *(const LAS bf16x8*)(ap + k); const bf16x8 b = *(const LAS bf16x8*)(bp + k); acc = MFMA32(a, b, acc); }
    return acc;
}
DI f32x16 zero16() { f32x16 z; for (int i = 0; i < 16; ++i) z[i] = 0.f; return z; }
struct MlItem { int b, h, row0, L; bool prompt; };
DI MlItem ml_item(int item) { MlItem it; if (item < 512) { const int sh = item >> 6, c = item & 63; it.b = sh >> 2; it.h = sh & 3; it.row0 = it.b * 4096 + 64 * c; it.L = 64; it.prompt = true; }
    else { const int j = item - 512; it.b = j >> 2; it.h = j & 3; it.row0 = NTOK_P + 16 * it.b; it.L = 16; it.prompt = false; } return it; }

constexpr int MLA_QS = 0, MLA_KS = 17408, MLA_KT = 34816, MLA_VT = 53248, MLA_PS = 94720, MLA_G = 103936;
DI void mlstm_pass_a(const Params& P, ldsp_t lds, int l, int istart, int istride) {
    const int tid = vtid(), lane = tid & 63, wave = tid >> 6;
    unsigned char* ws = wsp(P); const bf16_t* z = (const bf16_t*)(ws + WS_Z);
    float* numl = (float*)(ws + WS_NUML); float* denl = (float*)(ws + WS_DENL); float* mlg = (float*)(ws + WS_MLG); float* dC = (float*)(ws + WS_DC); float* mli = (float*)(ws + WS_MLI);
    LAS bf16_t* Qs = (LAS bf16_t*)(lds + MLA_QS); LAS bf16_t* Ks = (LAS bf16_t*)(lds + MLA_KS); LAS bf16_t* KT = (LAS bf16_t*)(lds + MLA_KT);
    LAS bf16_t* VT = (LAS bf16_t*)(lds + MLA_VT); LAS bf16_t* Ps = (LAS bf16_t*)(lds + MLA_PS); LAS float* Gu = (LAS float*)(lds + MLA_G); LAS float* Gpm = Gu + 64; LAS float* Gwp = Gu + 128;
    const float* in_ib = INP(I_MLIB); const float* in_fb = INP(I_MLFB);
    for (int item = istart; item < ML_ITEMS; item += istride) {
        const MlItem it = ml_item(item); const int L = it.L, h = it.h, row0 = it.row0;
        if (wave == 0) { const int t = lane; const bool valid = t < L; const bf16_t* zr = z + (size_t)(row0 + (valid ? t : 0)) * ZLD;
            const float igr = bf2f(zr[ZIG + h]) + in_ib[l * 4 + h], fgr = bf2f(zr[ZFG + h]) + in_fb[l * 4 + h];
            const float ig = softcap15(igr); float bsum = valid ? logsigmoidf_(softcap15(fgr)) : 0.f;
#pragma unroll
            for (int o = 1; o < 64; o <<= 1) { const float v = __shfl_up(bsum, o); if (lane >= o) bsum += v; }
            const float u = valid ? ig - bsum : -1e30f; float pm = u;
#pragma unroll
            for (int o = 1; o < 64; o <<= 1) { const float v = __shfl_up(pm, o); if (lane >= o) pm = fmaxf(pm, v); }
            const float blast = __shfl(bsum, L - 1), pmlast = __shfl(pm, L - 1);
            Gu[t] = u; Gpm[t] = pm; Gwp[t] = valid ? __expf(u - pmlast) : 0.f;
            if (valid) { float* gp = mlg + ((size_t)(row0 + t) * 4 + h) * 2; gp[0] = bsum; gp[1] = bsum + pm; }
            if (lane == 0) { mli[item * 4 + 0] = blast; mli[item * 4 + 1] = blast + pmlast; } }
#pragma unroll
        for (int i = 0; i < 2; ++i) { const int idx = tid + 512 * i, s = idx >> 4, ch = idx & 15; u32x4 q = {0u, 0u, 0u, 0u}, k = q;
            if (s < L) { const bf16_t* zr = z + (size_t)(row0 + s) * ZLD + h * 128 + 8 * ch; q = *(const u32x4*)(zr + ZQM); k = *(const u32x4*)(zr + ZKM); }
            *(LAS u32x4*)(Qs + s * 136 + 8 * ch) = q; *(LAS u32x4*)(Ks + s * 136 + 8 * ch) = k; }
#pragma unroll
        for (int i = 0; i < 4; ++i) { const int idx = tid + 512 * i, s = idx & 63, ch = idx >> 6; u32x4 v = {0u, 0u, 0u, 0u};
            if (s < L) v = *(const u32x4*)(z + (size_t)(row0 + s) * ZLD + ZVM + h * 256 + 8 * ch);
            LAS bf16_t* vp = VT + (8 * ch) * 72 + s;
            vp[0] = (bf16_t)(v.x & 0xffff); vp[72] = (bf16_t)(v.x >> 16); vp[144] = (bf16_t)(v.y & 0xffff); vp[216] = (bf16_t)(v.y >> 16);
            vp[288] = (bf16_t)(v.z & 0xffff); vp[360] = (bf16_t)(v.z >> 16); vp[432] = (bf16_t)(v.w & 0xffff); vp[504] = (bf16_t)(v.w >> 16); }
        for (int idx = tid; idx < 32 * 64; idx += 512) { const int rr = idx >> 6, s = idx & 63; VT[(256 + rr) * 72 + s] = (rr == 0) ? (bf16_t)0x3F80 : (bf16_t)0; }
        __syncthreads();
        { const int s = tid & 63, dg = tid >> 6; const float wp = Gwp[s];
#pragma unroll
          for (int hf = 0; hf < 2; ++hf) { const u32x4 kv = *(const LAS u32x4*)(Ks + s * 136 + dg * 16 + 8 * hf); LAS bf16_t* kp = KT + (dg * 16 + 8 * hf) * 72 + s;
              kp[0] = f2bf(lo16(kv.x) * wp); kp[72] = f2bf(hi16(kv.x) * wp); kp[144] = f2bf(lo16(kv.y) * wp); kp[216] = f2bf(hi16(kv.y) * wp);
              kp[288] = f2bf(lo16(kv.z) * wp); kp[360] = f2bf(hi16(kv.z) * wp); kp[432] = f2bf(lo16(kv.w) * wp); kp[504] = f2bf(hi16(kv.w) * wp); } }
        if (wave < 4) { const int ti = wave >> 1, si = wave & 1, r = lane & 31, hh = lane >> 5;
            f32x16 acc = mma_tile32(Qs + ti * 32 * 136, 136, Ks + si * 32 * 136, 136, 128, zero16(), lane);
            const int s = si * 32 + r; const float us = Gu[s];
#pragma unroll
            for (int i = 0; i < 16; ++i) { const int t = ti * 32 + crow(i, hh); const float d = (s <= t) ? __expf(us - Gpm[t]) : 0.f;
                Ps[t * 72 + s] = f2bf(acc[i] * 0.08838834764831845f * d); } }
        __syncthreads();
        for (int tl = wave; tl < 54; tl += 8) { const int r = lane & 31, hh = lane >> 5;
            if (tl < 18) { const int ti = tl / 9, vj = tl % 9;
                const f32x16 acc = mma_tile32(Ps + ti * 32 * 72, 72, VT + vj * 32 * 72, 72, 64, zero16(), lane);
                if (vj < 8) { float* np = numl + ((size_t)item * 16 + ti * 8 + vj) * 1024 + lane * 16;
#pragma unroll
                    for (int g = 0; g < 4; ++g) *(f32x4*)(np + 4 * g) = (f32x4){acc[4 * g], acc[4 * g + 1], acc[4 * g + 2], acc[4 * g + 3]}; }
                else if (r == 0) {
#pragma unroll
                    for (int i = 0; i < 16; ++i) { const int t = ti * 32 + crow(i, hh); if (t < L) denl[(size_t)(row0 + t) * 4 + h] = acc[i]; } } }
            else { const int q = tl - 18, vi = q >> 2, kj = q & 3;
                const f32x16 acc = mma_tile32(VT + vi * 32 * 72, 72, KT + kj * 32 * 72, 72, 64, zero16(), lane);
#pragma unroll
                for (int i = 0; i < 16; ++i) { const int dv = vi * 32 + crow(i, hh); if (dv < 257) dC[(size_t)item * ML_CSZ + dv * 128 + kj * 32 + r] = acc[i] * 0.08838834764831845f; } } }
        __syncthreads();
    }
}
DI void mlstm_pass_b(const Params& P, int l, int gtid, int gsz) {
    unsigned char* ws = wsp(P); float* out = outp(P); const float* in_mlm = INP(I_MLM); const float* in_mlc = INP(I_MLC); const float* in_mln = INP(I_MLN); float* dC = (float*)(ws + WS_DC); float* mli = (float*)(ws + WS_MLI);
    constexpr int NV = 257 * 128 / 4;
    for (int v = gtid; v < 40 * NV; v += gsz) { const int seq = v / NV, e = v % NV;
        int b, h, item0, nc; float m; f32x4 st;
        if (seq < 8) { b = seq >> 2; h = seq & 3; item0 = seq * 64; nc = 64; m = 0.f; st = (f32x4){0.f, 0.f, 0.f, 0.f}; }
        else { const int j = seq - 8; b = j >> 2; h = j & 3; item0 = 512 + j; nc = 1; m = in_mlm[(l * 8 + b) * 4 + h];
            st = (e < 8192) ? *(const f32x4*)(in_mlc + ((size_t)(l * 8 + b) * 4 + h) * 32768 + 4 * e) : *(const f32x4*)(in_mln + ((size_t)(l * 8 + b) * 4 + h) * 128 + 4 * (e - 8192)); }
        for (int c = 0; c < nc; ++c) { const int item = item0 + c; const float bl = mli[item * 4 + 0], al = mli[item * 4 + 1];
            const float mn = fmaxf(bl + m, al), cw = __expf(bl + m - mn), be = __expf(al - mn);
            f32x4* p = (f32x4*)(dC + (size_t)item * ML_CSZ) + e; const f32x4 d = *p; *p = st; st = st * cw + d * be;
            if (e == 0) mli[item * 4 + 2] = m;
            m = mn; }
        const bool pr = seq < 8; const size_t sh = (size_t)(l * (pr ? 2 : 8) + b) * 4 + h;
        if (e < 8192) *(f32x4*)(out + (pr ? O_PC : O_SC) + sh * 32768 + 4 * e) = st; else *(f32x4*)(out + (pr ? O_PN : O_SN) + sh * 128 + 4 * (e - 8192)) = st;
        if (e == 0) out[(pr ? O_PM : O_SM) + sh] = m; }
}
constexpr int MLC_QS = 0, MLC_CS = 17408, MLC_HS = 17408, MLC_G = 17408 + 78336;
DI void mlstm_pass_c(const Params& P, ldsp_t lds, int l) {
    const int tid = vtid(), lane = tid & 63, wave = tid >> 6;
    unsigned char* ws = wsp(P); const bf16_t* z = (const bf16_t*)(ws + WS_Z);
    const float* numl = (const float*)(ws + WS_NUML); const float* denl = (const float*)(ws + WS_DENL); const float* mlg = (const float*)(ws + WS_MLG);
    const float* dC = (const float*)(ws + WS_DC); const float* mli = (const float*)(ws + WS_MLI); bf16_t* oall = (bf16_t*)(ws + WS_OALL);
    LAS bf16_t* Qs = (LAS bf16_t*)(lds + MLC_QS); LAS bf16_t* Cs = (LAS bf16_t*)(lds + MLC_CS); LAS float* Hs = (LAS float*)(lds + MLC_HS);
    LAS float* Gel = (LAS float*)(lds + MLC_G); LAS float* Gei = Gel + 64; LAS float* Gcl = Gel + 128; LAS float* Gqn = Gel + 192;
    const float* in_hg = INP(I_MLHG);
    for (int item = sbid(); item < ML_ITEMS; item += gridDim.x) {
        const MlItem it = ml_item(item); const int L = it.L, h = it.h, row0 = it.row0;
#pragma unroll
        for (int i = 0; i < 2; ++i) { const int idx = tid + 512 * i, s = idx >> 4, ch = idx & 15; u32x4 q = {0u, 0u, 0u, 0u};
            if (s < L) q = *(const u32x4*)(z + (size_t)(row0 + s) * ZLD + ZQM + h * 128 + 8 * ch);
            *(LAS u32x4*)(Qs + s * 136 + 8 * ch) = q; }
#pragma unroll 2
        for (int idx = tid; idx < 288 * 32; idx += 512) { const int dv = idx >> 5, c4 = idx & 31; u32x2 w = {0u, 0u};
            if (dv < 257) { const f32x4 c = *(const f32x4*)(dC + (size_t)item * ML_CSZ + dv * 128 + 4 * c4); w.x = pack2(c[0], c[1]); w.y = pack2(c[2], c[3]); }
            *(LAS u32x2*)(Cs + dv * 136 + 4 * c4) = w; }
        if (tid < 64) { const int t = tid; float el = 0.f, ei = 0.f, cl = 1.f, dn = 0.f;
            if (t < L) { const float* gp = mlg + ((size_t)(row0 + t) * 4 + h) * 2; const float bt = gp[0], at = gp[1], mp = mli[item * 4 + 2];
                const float mt = fmaxf(bt + mp, at); el = __expf(at - mt); ei = __expf(bt + mp - mt); cl = __expf(-mt); dn = el * denl[(size_t)(row0 + t) * 4 + h]; }
            Gel[t] = el; Gei[t] = ei; Gcl[t] = cl; Gqn[64 + t] = dn; }
        __syncthreads();
        const int r = lane & 31, hh = lane >> 5;
        if (wave < 2) { const f32x16 aq = mma_tile32(Qs + wave * 32 * 136, 136, Cs + 8 * 32 * 136, 136, 128, zero16(), lane);
            if (r == 0) {
#pragma unroll
                for (int i = 0; i < 16; ++i) Gqn[wave * 32 + crow(i, hh)] = aq[i]; } }
        __syncthreads();
        if (tid < 64) { const int t = tid; const float el = Gel[t], ei = Gei[t]; const float den = Gqn[64 + t] + ei * Gqn[t]; const float md = fmaxf(fabsf(den), Gcl[t]);
            Gel[t] = (t < L) ? el / md : 0.f; Gei[t] = (t < L) ? ei / md : 0.f; }
        __syncthreads();
        f32x16 hv2[2];
#pragma unroll
        for (int k = 0; k < 2; ++k) { const int tl = wave + 8 * k, ti = tl >> 3, vj = tl & 7;
            const f32x16 acc = mma_tile32(Qs + ti * 32 * 136, 136, Cs + vj * 32 * 136, 136, 128, zero16(), lane);
            const float* np = numl + ((size_t)item * 16 + tl) * 1024 + lane * 16;
#pragma unroll
            for (int g = 0; g < 4; ++g) { const f32x4 nv = *(const f32x4*)(np + 4 * g); const f32x4 ca = *(const LAS f32x4*)(Gel + ti * 32 + 8 * g + 4 * hh), cb = *(const LAS f32x4*)(Gei + ti * 32 + 8 * g + 4 * hh);
#pragma unroll
                for (int j = 0; j < 4; ++j) hv2[k][4 * g + j] = ca[j] * nv[j] + cb[j] * acc[4 * g + j]; } }
        __syncthreads();
#pragma unroll
        for (int k = 0; k < 2; ++k) { const int tl = wave + 8 * k, ti = tl >> 3, vj = tl & 7;
#pragma unroll
            for (int i = 0; i < 16; ++i) Hs[(ti * 32 + crow(i, hh)) * 260 + vj * 32 + r] = hv2[k][i]; }
        __syncthreads();
        { const f32x4 hg = *(const f32x4*)(in_hg + l * 1024 + h * 256 + 4 * lane);
#pragma unroll
          for (int i = 0; i < 8; ++i) { const int t = wave * 8 + i;
              if (t < L) { const f32x4 hv = *(const LAS f32x4*)(Hs + t * 260 + 4 * lane); float ss = hv[0] * hv[0] + hv[1] * hv[1] + hv[2] * hv[2] + hv[3] * hv[3];
                  ss = wave_sum(ss); const float rstd = rsqrtf(ss * (1.0f / 256.0f) + 1e-6f);
                  const u32x2 ow = *(const u32x2*)(z + (size_t)(row0 + t) * ZLD + ZOM + h * 256 + 4 * lane);
                  const float o0 = sigmoidf_(lo16(ow.x)) * hv[0] * rstd * hg[0], o1 = sigmoidf_(hi16(ow.x)) * hv[1] * rstd * hg[1], o2 = sigmoidf_(lo16(ow.y)) * hv[2] * rstd * hg[2], o3 = sigmoidf_(hi16(ow.y)) * hv[3] * rstd * hg[3];
                  u32x2 w; w.x = pack2(o0, o1); w.y = pack2(o2, o3); *(u32x2*)(oall + (size_t)(row0 + t) * 1024 + h * 256 + 4 * lane) = w; } } }
        __syncthreads();
    }
}

constexpr int RW_R = 0, RW_W = 8192, RW_K = 16384, RW_A = 24576, RW_B = RW_A + 36 * 256, RW_V = RW_B + 8192, RW_CD = RW_V + 2048, RW_BUF = RW_CD + 1024;
constexpr int RW_YOFF = 2 * RW_BUF;
DI float wave_sum_dpp(float v) { v = row16_sum(v);
    const int iv = __builtin_bit_cast(int, v);
    return (__builtin_bit_cast(float, __builtin_amdgcn_readlane(iv, 0)) + __builtin_bit_cast(float, __builtin_amdgcn_readlane(iv, 16))) + (__builtin_bit_cast(float, __builtin_amdgcn_readlane(iv, 32)) + __builtin_bit_cast(float, __builtin_amdgcn_readlane(iv, 48))); }
DI void rwkv_pre(const Params& P, int l) {
    const int lane = vtid() & 63, gw = sbid() * 8 + (vtid() >> 6), nwv = gridDim.x * 8;
    unsigned char* ws = wsp(P); const bf16_t* z = (const bf16_t*)(ws + WS_Z); const float* lout = (const float*)(ws + WS_LOUT);
    float* VR = (float*)(ws + WS_VR); float* VK = (float*)(ws + WS_VK); float* VA = (float*)(ws + WS_VA); float* VB = (float*)(ws + WS_VB); float* VV = (float*)(ws + WS_VV); float* CD = (float*)(ws + WS_CD); float* rkb = (float*)(ws + WS_RK);
    const float* in_mu = INP(I_MU) + (size_t)l * 3328; const float* in_kk = INP(I_KK) + l * 1024; const float* in_ka = INP(I_KA) + l * 1024; const float* in_rk = INP(I_RK) + l * 1024; const float* in_sh = INP(I_RWSH) + (size_t)l * 8 * 3328;
    for (int item = gw; item < 16640; item += nwv) {
        int b, run, hd, T, row0; bool prompt;
        if (item < 16384) { prompt = true; hd = item & 15; run = (item >> 4) & 511; b = item >> 13; T = 4096; row0 = b * 4096; }
        else { const int j = item - 16384; prompt = false; hd = j & 15; run = (j >> 4) & 1; b = j >> 5; T = 16; row0 = NTOK_P + 16 * b; }
        const int col = hd * 64 + lane, t0 = 8 * run;
        const float mu_r = in_mu[col], mu_k = in_mu[1024 + col], mu_v = in_mu[2048 + col], k_k = in_kk[col], k_a = in_ka[col], r_k = in_rk[col];
        float pr, pk, pv;
        if (t0 > 0) { const bf16_t* zp = z + (size_t)(row0 + t0 - 1) * ZLD + ZR + col; pr = bf2f(zp[0]); pk = bf2f(zp[1024]); pv = bf2f(zp[2048]); }
        else if (prompt) { pr = 0.f; pk = 0.f; pv = 0.f; }
        else { const float* sp = in_sh + (size_t)b * 3328 + col; pr = sp[0]; pk = sp[1024]; pv = sp[2048]; }
        float zr[8], zk[9], zv[8], aa[8];
#pragma unroll
        for (int j = 0; j < 8; ++j) { const bf16_t* zp = z + (size_t)(row0 + t0 + j) * ZLD + ZR + col; zr[j] = bf2f(zp[0]); zk[j] = bf2f(zp[1024]); zv[j] = bf2f(zp[2048]); aa[j] = lout[(size_t)(row0 + t0 + j) * 3072 + 1024 + col]; }
        { const int t = t0 + 8 < T ? t0 + 8 : T - 1; zk[8] = bf2f(z[(size_t)(row0 + t) * ZLD + ZR + 1024 + col]); }
        float xk[9], kkn[9];
#pragma unroll
        for (int j = 0; j < 9; ++j) { xk[j] = zk[j] + (pk - zk[j]) * mu_k; pk = zk[j]; const float kk = xk[j] * k_k; const float ss = wave_sum_dpp(kk * kk); kkn[j] = (t0 + j < T) ? kk / fmaxf(sqrtf(ss), 1e-12f) : 0.f; }
#pragma unroll
        for (int j = 0; j < 8; ++j) { const size_t row = (size_t)(row0 + t0 + j);
            const float xr = zr[j] + (pr - zr[j]) * mu_r, xv = zv[j] + (pv - zv[j]) * mu_v; pr = zr[j]; pv = zv[j];
            const float a = aa[j], km = xk[j] * (1.0f + (a - 1.0f) * k_a), bq = kkn[j] * a;
            const float cc = wave_sum_dpp(bq * -kkn[j + 1]), dd = wave_sum_dpp(bq * xr), rk = wave_sum_dpp(xr * km * r_k);
            VR[row * 1024 + col] = xr; VK[row * 1024 + col] = km; VA[row * 1024 + col] = -kkn[j]; VB[row * 1024 + col] = bq; VV[row * 1024 + col] = xv;
            if (lane == 0) { *(f32x2*)(CD + ((size_t)hd * MP + row) * 2) = (f32x2){cc, dd}; rkb[row * 16 + hd] = rk; } }
    }
}
DI void rwkv_flush_y(ldsp_t lds, float* __restrict ybuf, int c, int lane, int T, int row0, int hd, int qd) {
    const LAS float* ysh = (const LAS float*)(lds + RW_YOFF) + (c & 1) * 512;
#pragma unroll
    for (int i = 0; i < 8; ++i) { const int e = lane + 64 * i, tl = e >> 4, rr = e & 15, t = 32 * c + tl; if (t < T) ybuf[(size_t)(row0 + t) * 1024 + hd * 64 + 16 * qd + rr] = ysh[e]; }
}
DI void rwkv_dma_chunk(ldsp_t lds, const unsigned char* __restrict ws, int c, int lane, int T, int row0, int hd, int qd, int part) {
    const int buf = (c & 1) * RW_BUF, t0 = 32 * c, l4 = lane >> 4, c4 = 4 * (lane & 15);
    const float* VR = (const float*)(ws + WS_VR); const float* VK = (const float*)(ws + WS_VK); const float* VA = (const float*)(ws + WS_VA); const float* VB = (const float*)(ws + WS_VB);
    const float* VV = (const float*)(ws + WS_VV); const float* CD = (const float*)(ws + WS_CD); const float* W = (const float*)(ws + WS_LOUT);
    if (part < 2) {
#pragma unroll
        for (int i = 0; i < 8; ++i) { const int t = t0 + 4 * i + l4 < T ? t0 + 4 * i + l4 : T - 1; const size_t off = (size_t)(row0 + t) * 1024 + hd * 64 + c4;
            if (part == 0) { __builtin_amdgcn_global_load_lds((const unsigned*)(VR + off), (LAS unsigned*)(lds + buf + RW_R + i * 1024), 16, 0, 0);
                             __builtin_amdgcn_global_load_lds((const unsigned*)(W + (size_t)(row0 + t) * 3072 + hd * 64 + c4), (LAS unsigned*)(lds + buf + RW_W + i * 1024), 16, 0, 0); }
            else { __builtin_amdgcn_global_load_lds((const unsigned*)(VK + off), (LAS unsigned*)(lds + buf + RW_K + i * 1024), 16, 0, 0);
                   __builtin_amdgcn_global_load_lds((const unsigned*)(VB + off), (LAS unsigned*)(lds + buf + RW_B + i * 1024), 16, 0, 0); } }
    } else {
#pragma unroll
        for (int i = 0; i < 9; ++i) { const int t = t0 + 4 * i + l4 < T ? t0 + 4 * i + l4 : T - 1;
            __builtin_amdgcn_global_load_lds((const unsigned*)(VA + (size_t)(row0 + t) * 1024 + hd * 64 + c4), (LAS unsigned*)(lds + buf + RW_A + i * 1024), 16, 0, 0); }
#pragma unroll
        for (int i = 0; i < 2; ++i) { const int t = t0 + 16 * i + (lane >> 2) < T ? t0 + 16 * i + (lane >> 2) : T - 1;
            __builtin_amdgcn_global_load_lds((const unsigned*)(VV + (size_t)(row0 + t) * 1024 + hd * 64 + 16 * qd + 4 * (lane & 3)), (LAS unsigned*)(lds + buf + RW_V + i * 1024), 16, 0, 0); }
        { const int t = t0 + 2 * lane < T - 1 ? t0 + 2 * lane : T - 2;
          __builtin_amdgcn_global_load_lds((const unsigned*)(CD + ((size_t)hd * MP + row0 + t) * 2), (LAS unsigned*)(lds + buf + RW_CD), 16, 0, 0); }
    }
}
DI void rwkv_item(const Params& P, ldsp_t lds, int l, int b, int hd, int qd, bool prompt) {
    const int tid = vtid(), lane = tid & 63, wave = __builtin_amdgcn_readfirstlane(tid >> 6);
    unsigned char* ws = wsp(P); float* out = outp(P); float* ybuf = (float*)(ws + WS_YB);
    const int T = prompt ? 4096 : 16, row0 = prompt ? b * 4096 : NTOK_P + 16 * b, nc = (T + 31) / 32;
#define RW_BAR() do { asm volatile("s_waitcnt lgkmcnt(0)" ::: "memory"); __builtin_amdgcn_s_barrier(); asm volatile("" ::: "memory"); } while (0)
    if (wave >= 4) {
        if (wave < 7) { rwkv_dma_chunk(lds, ws, 0, lane, T, row0, hd, qd, wave - 4); asm volatile("s_waitcnt vmcnt(0)" ::: "memory"); }
        RW_BAR();
        for (int c = 0; c < nc; ++c) {
            if (wave < 7) { if (c + 1 < nc) rwkv_dma_chunk(lds, ws, c + 1, lane, T, row0, hd, qd, wave - 4); }
            else if (c >= 1) rwkv_flush_y(lds, ybuf, c - 1, lane, T, row0, hd, qd);
            asm volatile("s_waitcnt vmcnt(0)" ::: "memory");
            RW_BAR(); }
        if (wave == 7) rwkv_flush_y(lds, ybuf, nc - 1, lane, T, row0, hd, qd);
    } else {
        const int si = lane >> 4, cg = lane & 15, vrow = 16 * qd + 4 * wave + si;
        f32x4 S = {0.f, 0.f, 0.f, 0.f};
        if (!prompt) S = *(const f32x4*)(INP(I_RWS) + (((size_t)(l * 8 + b) * 16 + hd) * 64 + vrow) * 64 + 4 * cg);
        RW_BAR();
        float sa;
        { const f32x4 a0 = *(const LAS f32x4*)(lds + RW_A + 16 * cg); sa = row16_sum((S[0] * a0[0] + S[1] * a0[1]) + (S[2] * a0[2] + S[3] * a0[3])); }
        for (int c = 0; c < nc; ++c) {
            const LAS unsigned char* Lb = lds + (c & 1) * RW_BUF + 16 * cg; const LAS float* Vq = (const LAS float*)(lds + (c & 1) * RW_BUF + RW_V) + 4 * wave + si; const LAS f32x2* CD = (const LAS f32x2*)(lds + (c & 1) * RW_BUF + RW_CD);
            LAS float* ysh = (LAS float*)(lds + RW_YOFF) + (cg == 0 ? (c & 1) * 512 + 4 * wave + si : 1024 + tid); const int ystep = cg == 0 ? 16 : 0;
            const int ns = (T - 32 * c) < 32 ? (T - 32 * c) : 32;
#define RW_LOAD(R_, W_, K_, A_, B_, V_, C_, t_) do { const int tq = (t_) < ns ? (t_) : ns - 1; \
                R_ = *(const LAS f32x4*)(Lb + RW_R + tq * 256); W_ = *(const LAS f32x4*)(Lb + RW_W + tq * 256); K_ = *(const LAS f32x4*)(Lb + RW_K + tq * 256); \
                A_ = *(const LAS f32x4*)(Lb + RW_A + (tq + 1) * 256); B_ = *(const LAS f32x4*)(Lb + RW_B + tq * 256); V_ = Vq[tq * 16]; C_ = CD[tq]; } while (0)
#define RW_DOT(P_, X_) (((f32x2){P_[2], P_[3]} * (f32x2){X_[2], X_[3]} + (f32x2){P_[0], P_[1]} * (f32x2){X_[0], X_[1]}))
#define RW_STEP2(R0, W0, K0, A0, B0, V0, C0, R1, W1, K1, A1, B1, V1, C1, t_) do { \
                const f32x4 P0 = S * W0 + K0 * V0; const f32x4 S0 = P0 + B0 * sa; const f32x4 P1 = S0 * W1 + K1 * V1; \
                const f32x2 e0 = RW_DOT(P0, A0), e1 = RW_DOT(P0, R0), e2 = RW_DOT(P1, A1), e3 = RW_DOT(P1, R1); \
                float q0 = e0.x + e0.y, u0 = e1.x + e1.y, q1 = e2.x + e2.y, u1 = e3.x + e3.y; \
                q0 += dppf<0xB1>(q0); q1 += dppf<0xB1>(q1); u0 += dppf<0xB1>(u0); u1 += dppf<0xB1>(u1); \
                q0 += dppf<0x4E>(q0); q1 += dppf<0x4E>(q1); u0 += dppf<0x4E>(u0); u1 += dppf<0x4E>(u1); \
                q0 += dppf<0x141>(q0); q1 += dppf<0x141>(q1); u0 += dppf<0x141>(u0); u1 += dppf<0x141>(u1); \
                q0 += dppf<0x140>(q0); q1 += dppf<0x140>(q1); u0 += dppf<0x140>(u0); u1 += dppf<0x140>(u1); \
                const float sa1 = q0 + sa * C0.x; ysh[(t_) * ystep] = u0 + sa * C0.y; \
                S = P1 + B1 * sa1; ysh[((t_) + 1) * ystep] = u1 + sa1 * C1.y; sa = q1 + sa1 * C1.x; } while (0)
            f32x4 rA, wA, kA, aA, bA, rB, wB, kB, aB, bB, rC, wC, kC, aC, bC, rD, wD, kD, aD, bD; float vA, vB, vC, vD; f32x2 cA, cB, cC, cD;
            RW_LOAD(rA, wA, kA, aA, bA, vA, cA, 0); RW_LOAD(rB, wB, kB, aB, bB, vB, cB, 1);
            for (int t = 0; t < ns; t += 4) {
                RW_LOAD(rC, wC, kC, aC, bC, vC, cC, t + 2); RW_LOAD(rD, wD, kD, aD, bD, vD, cD, t + 3);
                RW_STEP2(rA, wA, kA, aA, bA, vA, cA, rB, wB, kB, aB, bB, vB, cB, t);
                RW_LOAD(rA, wA, kA, aA, bA, vA, cA, t + 4); RW_LOAD(rB, wB, kB, aB, bB, vB, cB, t + 5);
                RW_STEP2(rC, wC, kC, aC, bC, vC, cC, rD, wD, kD, aD, bD, vD, cD, t + 2); }
#undef RW_DOT
#undef RW_STEP2
#undef RW_LOAD
            RW_BAR(); }
        float* so = out + (prompt ? O_PS + (((size_t)(l * 2 + b) * 16 + hd) * 64 + vrow) * 64 : O_SS + (((size_t)(l * 8 + b) * 16 + hd) * 64 + vrow) * 64) + 4 * cg; *(f32x4*)so = S;
    }
#undef RW_BAR
    __syncthreads();
}
DI void rwkv_post(const Params& P, int l) {
    const int lane = vtid() & 63, gw = sbid() * 8 + (vtid() >> 6), nwv = gridDim.x * 8;
    unsigned char* ws = wsp(P); const float* in_rwsh = INP(I_RWSH); const bf16_t* z = (const bf16_t*)(ws + WS_Z); const float* lout = (const float*)(ws + WS_LOUT); const float* ybuf = (const float*)(ws + WS_YB);
    const float* rkb = (const float*)(ws + WS_RK); bf16_t* oall = (bf16_t*)(ws + WS_OALL);
    const int hd = lane >> 2, c0 = hd * 64 + (lane & 3) * 16;
    f32x4 lg[4], lb[4], muv[4];
#pragma unroll
    for (int i = 0; i < 4; ++i) { lg[i] = *(const f32x4*)(INP(I_LNG) + l * 1024 + c0 + 4 * i); lb[i] = *(const f32x4*)(INP(I_LNB) + l * 1024 + c0 + 4 * i); muv[i] = *(const f32x4*)(INP(I_MU) + (size_t)l * 3328 + 2048 + c0 + 4 * i); }
    for (int row = gw; row < NTOK; row += nwv) {
        const bool pr = row < NTOK_P; const int s = row_stream(row), b = pr ? s : s - 2, t = pr ? (row & 4095) : ((row - NTOK_P) & 15);
        f32x4 y[4]; float sm = 0.f;
#pragma unroll
        for (int i = 0; i < 4; ++i) { y[i] = *(const f32x4*)(ybuf + (size_t)row * 1024 + c0 + 4 * i); sm += (y[i][0] + y[i][1]) + (y[i][2] + y[i][3]); }
        sm += dppf<0xB1>(sm); sm += dppf<0x4E>(sm); const float mean = sm * (1.0f / 64.0f); float q = 0.f;
#pragma unroll
        for (int i = 0; i < 4; ++i) { const f32x4 d = y[i] - mean; q += (d[0] * d[0] + d[1] * d[1]) + (d[2] * d[2] + d[3] * d[3]); }
        q += dppf<0xB1>(q); q += dppf<0x4E>(q); const float rstd = rsqrtf(q * (1.0f / 64.0f) + 64e-5f);
        const float rk = rkb[(size_t)row * 16 + hd];
        const bf16_t* zv = z + (size_t)row * ZLD + ZRV + c0; const float* gp = lout + (size_t)row * 3072 + 2048 + c0;
        u32x4 cw0 = *(const u32x4*)zv, cw1 = *(const u32x4*)(zv + 8), pw0 = {0u, 0u, 0u, 0u}, pw1 = pw0; float pf[16];
        if (t > 0) { pw0 = *(const u32x4*)(zv - ZLD); pw1 = *(const u32x4*)(zv - ZLD + 8); }
        const unsigned cw[8] = {cw0.x, cw0.y, cw0.z, cw0.w, cw1.x, cw1.y, cw1.z, cw1.w}, pw[8] = {pw0.x, pw0.y, pw0.z, pw0.w, pw1.x, pw1.y, pw1.z, pw1.w};
#pragma unroll
        for (int j = 0; j < 8; ++j) { pf[2 * j] = lo16(pw[j]); pf[2 * j + 1] = hi16(pw[j]); }
        if (t == 0 && !pr) { const float* sp = in_rwsh + (size_t)(l * 8 + b) * 3328 + 2048 + c0;
#pragma unroll
            for (int j = 0; j < 16; ++j) pf[j] = sp[j]; }
        unsigned ow[8];
#pragma unroll
        for (int i = 0; i < 4; ++i) { const f32x4 g = *(const f32x4*)(gp + 4 * i); float o[4];
#pragma unroll
            for (int j = 0; j < 4; ++j) { const int e = 4 * i + j; const float zc = (e & 1) ? hi16(cw[e >> 1]) : lo16(cw[e >> 1]); const float xv = zc + (pf[e] - zc) * muv[i][j];
                o[j] = (((y[i][j] - mean) * rstd) * lg[i][j] + lb[i][j] + rk * xv) * g[j]; }
            ow[2 * i] = pack2(o[0], o[1]); ow[2 * i + 1] = pack2(o[2], o[3]); }
        bf16_t* op = oall + (size_t)2 * MP * 1024 + (size_t)row * 1024 + c0;
        *(u32x4*)op = (u32x4){ow[0], ow[1], ow[2], ow[3]}; *(u32x4*)(op + 8) = (u32x4){ow[4], ow[5], ow[6], ow[7]};
    }
}

struct AttnOut { float m, l; f32x16 o[4]; };
DI void attn_wave(AttnOut& R, const bf16_t* __restrict z, const bf16_t* __restrict qR, const bf16_t* __restrict Kn, const bf16_t* __restrict krA, const bf16_t* __restrict Vt,
                  int qrow, int hd, int kbase, int kb_lo, int kb_hi, int nvalid, int lane) {
    const int r = lane & 31, hh = lane >> 5;
    bf16x8 qf[12];
#pragma unroll
    for (int ks = 0; ks < 8; ++ks) qf[ks] = *(const bf16x8*)(z + (size_t)qrow * ZLD + ZQA + hd * 192 + 16 * ks + 8 * hh);
#pragma unroll
    for (int ks = 0; ks < 4; ++ks) qf[8 + ks] = *(const bf16x8*)(qR + (size_t)qrow * 512 + hd * 64 + 16 * ks + 8 * hh);
    float m = -1e30f, l = 0.f; f32x16 o0 = zero16(), o1 = zero16(), o2 = zero16(), o3 = zero16();
    const float sc = 0.07216878364870322f * 1.4426950408889634f;
    for (int kb = kb_lo; kb < kb_hi; ++kb) {
        const size_t key = (size_t)kbase + 32 * kb + r;
        const bf16_t* kp = Kn + key * 1024 + hd * 128 + 8 * hh; const bf16_t* kp2 = krA + key * 64 + 8 * hh;
        f32x16 st = zero16();
#pragma unroll
        for (int ks = 0; ks < 8; ++ks) { const bf16x8 a = *(const bf16x8*)(kp + 16 * ks); st = MFMA32(a, qf[ks], st); }
#pragma unroll
        for (int ks = 0; ks < 4; ++ks) { const bf16x8 a = *(const bf16x8*)(kp2 + 16 * ks); st = MFMA32(a, qf[8 + ks], st); }
        const bool tail = (32 * kb + 32 > nvalid); float mx = -1e30f;
#pragma unroll
        for (int i = 0; i < 16; ++i) { float s = st[i] * sc; if (tail && (32 * kb + crow(i, hh) >= nvalid)) s = -1e30f; st[i] = s; mx = fmaxf(mx, s); }
        mx = fmaxf(mx, __shfl_xor(mx, 32));
        const float mnew = fmaxf(m, mx), alpha = __builtin_amdgcn_exp2f(m - mnew); float ls = 0.f;
#pragma unroll
        for (int i = 0; i < 16; ++i) { const float p = __builtin_amdgcn_exp2f(st[i] - mnew); st[i] = p; ls += p; }
        l = l * alpha + ls; m = mnew;
        o0 *= alpha; o1 *= alpha; o2 *= alpha; o3 *= alpha;
        const bf16_t* vp = Vt + (size_t)(hd * 128 + r) * KEYS + kbase + 32 * kb + 4 * hh;
#pragma unroll
        for (int s2 = 0; s2 < 2; ++s2) {
            u32x4 pw; pw.x = pack2(st[8 * s2 + 0], st[8 * s2 + 1]); pw.y = pack2(st[8 * s2 + 2], st[8 * s2 + 3]); pw.z = pack2(st[8 * s2 + 4], st[8 * s2 + 5]); pw.w = pack2(st[8 * s2 + 6], st[8 * s2 + 7]);
            const bf16x8 pb = __builtin_bit_cast(bf16x8, pw);
            { const s16x4 lo = *(const s16x4*)(vp + 16 * s2), hi = *(const s16x4*)(vp + 16 * s2 + 8); o0 = MFMA32(__builtin_shufflevector(lo, hi, 0, 1, 2, 3, 4, 5, 6, 7), pb, o0); }
            { const s16x4 lo = *(const s16x4*)(vp + (size_t)32 * KEYS + 16 * s2), hi = *(const s16x4*)(vp + (size_t)32 * KEYS + 16 * s2 + 8); o1 = MFMA32(__builtin_shufflevector(lo, hi, 0, 1, 2, 3, 4, 5, 6, 7), pb, o1); }
            { const s16x4 lo = *(const s16x4*)(vp + (size_t)64 * KEYS + 16 * s2), hi = *(const s16x4*)(vp + (size_t)64 * KEYS + 16 * s2 + 8); o2 = MFMA32(__builtin_shufflevector(lo, hi, 0, 1, 2, 3, 4, 5, 6, 7), pb, o2); }
            { const s16x4 lo = *(const s16x4*)(vp + (size_t)96 * KEYS + 16 * s2), hi = *(const s16x4*)(vp + (size_t)96 * KEYS + 16 * s2 + 8); o3 = MFMA32(__builtin_shufflevector(lo, hi, 0, 1, 2, 3, 4, 5, 6, 7), pb, o3); }
        }
    }
    R.m = m; R.l = l; R.o[0] = o0; R.o[1] = o1; R.o[2] = o2; R.o[3] = o3;
}
constexpr int AT_KP = 200, AT_VP = 72, AT_KBYTES = 64 * AT_KP * 2, AT_BUF = AT_KBYTES + 128 * AT_VP * 2;
DI void attn_prompt_item(const Params& P, ldsp_t lds, int item) {
    const int tid = vtid(), lane = tid & 63, wave = tid >> 6; unsigned char* ws = wsp(P);
    const bf16_t* z = (const bf16_t*)(ws + WS_Z); const bf16_t* qR = (const bf16_t*)(ws + WS_QR); bf16_t* oall = (bf16_t*)(ws + WS_OALL);
    const int bh = item >> 4, jb = item & 15, b = bh >> 3, hd = bh & 7;
    const int qblk = wave < 4 ? 4 * jb + wave : 127 - (4 * jb + wave - 4);
    const int r = lane & 31, hh = lane >> 5, qrow = b * 4096 + 32 * qblk + r, mych = (qblk >> 1) + 1, nch = 64 - 2 * jb, kbase = b * 4096;
    bf16x8 qf[12];
#pragma unroll
    for (int ks = 0; ks < 8; ++ks) qf[ks] = *(const bf16x8*)(z + (size_t)qrow * ZLD + ZQA + hd * 192 + 16 * ks + 8 * hh);
#pragma unroll
    for (int ks = 0; ks < 4; ++ks) qf[8 + ks] = *(const bf16x8*)(qR + (size_t)qrow * 512 + hd * 64 + 16 * ks + 8 * hh);
    const bf16_t* gk0 = (const bf16_t*)(ws + WS_KN) + (size_t)(kbase + (tid >> 4)) * 1024 + hd * 128 + 8 * (tid & 15);
    const bf16_t* gk2 = (const bf16_t*)(ws + WS_KRA) + (size_t)(kbase + (tid >> 3)) * 64 + 8 * (tid & 7);
    const bf16_t* gv0 = (const bf16_t*)(ws + WS_VT) + (size_t)(hd * 128 + (tid >> 3)) * KEYS + kbase + 8 * (tid & 7);
    const int lk0 = ((tid >> 4) * AT_KP + 8 * (tid & 15)) * 2, lk1 = lk0 + 32 * AT_KP * 2, lk2 = ((tid >> 3) * AT_KP + 128 + 8 * (tid & 7)) * 2;
    const int lv0 = AT_KBYTES + ((tid >> 3) * AT_VP + 8 * (tid & 7)) * 2, lv1 = lv0 + 64 * AT_VP * 2;
    u32x4 p0 = *(const u32x4*)gk0, p1 = *(const u32x4*)(gk0 + 32 * 1024), p2 = *(const u32x4*)gk2, p3 = *(const u32x4*)gv0, p4 = *(const u32x4*)(gv0 + (size_t)64 * KEYS);
    *(LAS u32x4*)(lds + lk0) = p0; *(LAS u32x4*)(lds + lk1) = p1; *(LAS u32x4*)(lds + lk2) = p2; *(LAS u32x4*)(lds + lv0) = p3; *(LAS u32x4*)(lds + lv1) = p4;
    __syncthreads();
    float m = -1e30f, l = 0.f; f32x16 o0 = zero16(), o1 = zero16(), o2 = zero16(), o3 = zero16();
    const float sc = 0.07216878364870322f * 1.4426950408889634f;
    for (int ch = 0; ch < nch; ++ch) {
        const bool more = ch + 1 < nch;
        if (more) { const size_t c1 = (size_t)(ch + 1) * 64;
            p0 = *(const u32x4*)(gk0 + c1 * 1024); p1 = *(const u32x4*)(gk0 + c1 * 1024 + 32 * 1024); p2 = *(const u32x4*)(gk2 + c1 * 64); p3 = *(const u32x4*)(gv0 + c1); p4 = *(const u32x4*)(gv0 + (size_t)64 * KEYS + c1); }
        if (ch < mych) { const LAS bf16_t* Ks = (const LAS bf16_t*)(lds + (ch & 1) * AT_BUF); const LAS bf16_t* Vs = (const LAS bf16_t*)(lds + (ch & 1) * AT_BUF + AT_KBYTES);
#pragma unroll
            for (int j = 0; j < 2; ++j) {
                const LAS bf16_t* kp = Ks + (32 * j + r) * AT_KP + 8 * hh; f32x16 st = zero16();
#pragma unroll
                for (int ks = 0; ks < 12; ++ks) { const bf16x8 a = *(const LAS bf16x8*)(kp + 16 * ks); st = MFMA32(a, qf[ks], st); }
                float mx = -1e30f;
#pragma unroll
                for (int i = 0; i < 16; ++i) { st[i] *= sc; mx = fmaxf(mx, st[i]); }
                mx = fmaxf(mx, __shfl_xor(mx, 32));
                const float mnew = fmaxf(m, mx), alpha = __builtin_amdgcn_exp2f(m - mnew); float ls = 0.f;
#pragma unroll
                for (int i = 0; i < 16; ++i) { const float p = __builtin_amdgcn_exp2f(st[i] - mnew); st[i] = p; ls += p; }
                l = l * alpha + ls; m = mnew; o0 *= alpha; o1 *= alpha; o2 *= alpha; o3 *= alpha;
                const LAS bf16_t* vp = Vs + r * AT_VP + 32 * j + 4 * hh;
#pragma unroll
                for (int s2 = 0; s2 < 2; ++s2) {
                    u32x4 pw; pw.x = pack2(st[8 * s2 + 0], st[8 * s2 + 1]); pw.y = pack2(st[8 * s2 + 2], st[8 * s2 + 3]); pw.z = pack2(st[8 * s2 + 4], st[8 * s2 + 5]); pw.w = pack2(st[8 * s2 + 6], st[8 * s2 + 7]);
                    const bf16x8 pb = __builtin_bit_cast(bf16x8, pw);
                    { const s16x4 lo = *(const LAS s16x4*)(vp + 16 * s2), hi = *(const LAS s16x4*)(vp + 16 * s2 + 8); o0 = MFMA32(__builtin_shufflevector(lo, hi, 0, 1, 2, 3, 4, 5, 6, 7), pb, o0); }
                    { const s16x4 lo = *(const LAS s16x4*)(vp + 32 * AT_VP + 16 * s2), hi = *(const LAS s16x4*)(vp + 32 * AT_VP + 16 * s2 + 8); o1 = MFMA32(__builtin_shufflevector(lo, hi, 0, 1, 2, 3, 4, 5, 6, 7), pb, o1); }
                    { const s16x4 lo = *(const LAS s16x4*)(vp + 64 * AT_VP + 16 * s2), hi = *(const LAS s16x4*)(vp + 64 * AT_VP + 16 * s2 + 8); o2 = MFMA32(__builtin_shufflevector(lo, hi, 0, 1, 2, 3, 4, 5, 6, 7), pb, o2); }
                    { const s16x4 lo = *(const LAS s16x4*)(vp + 96 * AT_VP + 16 * s2), hi = *(const LAS s16x4*)(vp + 96 * AT_VP + 16 * s2 + 8); o3 = MFMA32(__builtin_shufflevector(lo, hi, 0, 1, 2, 3, 4, 5, 6, 7), pb, o3); }
                } } }
        if (more) { const int bo = ((ch + 1) & 1) * AT_BUF;
            *(LAS u32x4*)(lds + bo + lk0) = p0; *(LAS u32x4*)(lds + bo + lk1) = p1; *(LAS u32x4*)(lds + bo + lk2) = p2; *(LAS u32x4*)(lds + bo + lv0) = p3; *(LAS u32x4*)(lds + bo + lv1) = p4; }
        __syncthreads();
    }
    const float lt = l + __shfl_xor(l, 32), inv = 1.0f / lt;
    bf16_t* op = oall + (size_t)MP * 1024 + (size_t)qrow * 1024 + hd * 128;
#pragma unroll
    for (int g = 0; g < 4; ++g) { u32x2 w;
        w.x = pack2(o0[4 * g] * inv, o0[4 * g + 1] * inv); w.y = pack2(o0[4 * g + 2] * inv, o0[4 * g + 3] * inv); *(u32x2*)(op + 8 * g + 4 * hh) = w;
        w.x = pack2(o1[4 * g] * inv, o1[4 * g + 1] * inv); w.y = pack2(o1[4 * g + 2] * inv, o1[4 * g + 3] * inv); *(u32x2*)(op + 32 + 8 * g + 4 * hh) = w;
        w.x = pack2(o2[4 * g] * inv, o2[4 * g + 1] * inv); w.y = pack2(o2[4 * g + 2] * inv, o2[4 * g + 3] * inv); *(u32x2*)(op + 64 + 8 * g + 4 * hh) = w;
        w.x = pack2(o3[4 * g] * inv, o3[4 * g + 1] * inv); w.y = pack2(o3[4 * g + 2] * inv, o3[4 * g + 3] * inv); *(u32x2*)(op + 96 + 8 * g + 4 * hh) = w; }
}
DI void attn_sample_item(const Params& P, ldsp_t lds, int item) {
    const int tid = vtid(), lane = tid & 63, wave = tid >> 6; unsigned char* ws = wsp(P);
    const bf16_t* z = (const bf16_t*)(ws + WS_Z); bf16_t* oall = (bf16_t*)(ws + WS_OALL);
    const int b = item >> 3, hd = item & 7, r = lane & 31, hh = lane >> 5;
    const int qrow = NTOK_P + 16 * b + (r < 16 ? r : 15);
    const int lo = wave == 0 ? 0 : 9 + 8 * (wave - 1), hi = 9 + 8 * wave;
    AttnOut R;
    attn_wave(R, z, (const bf16_t*)(ws + WS_QR), (const bf16_t*)(ws + WS_KN), (const bf16_t*)(ws + WS_KRA), (const bf16_t*)(ws + WS_VT), qrow, hd, NTOK_P + b * SKEY, lo, hi, 2064, lane);
    LAS float* oW = (LAS float*)lds;
    LAS float* mW = (LAS float*)(lds + LDS_MAIN);
    LAS float* lW = mW + 256;
    const float lt = R.l + __shfl_xor(R.l, 32);
    if (hh == 0) { mW[wave * 32 + r] = R.m; lW[wave * 32 + r] = lt; }
#pragma unroll
    for (int dvb = 0; dvb < 4; ++dvb)
#pragma unroll
        for (int i = 0; i < 16; ++i) oW[(wave * 128 + 32 * dvb + crow(i, hh)) * 32 + r] = R.o[dvb][i];
    __syncthreads();
    for (int e = tid; e < 128 * 16; e += 512) { const int q = e & 15, dv = e >> 4; float M = -1e30f;
#pragma unroll
        for (int w = 0; w < 8; ++w) M = fmaxf(M, mW[w * 32 + q]);
        float L = 0.f, acc = 0.f;
#pragma unroll
        for (int w = 0; w < 8; ++w) { const float f = __builtin_amdgcn_exp2f(mW[w * 32 + q] - M); L += lW[w * 32 + q] * f; acc += oW[(w * 128 + dv) * 32 + q] * f; }
        oall[(size_t)MP * 1024 + (size_t)(NTOK_P + 16 * b + q) * 1024 + hd * 128 + dv] = f2bf(acc / L); }
    __syncthreads();
}

__global__ void __launch_bounds__(512, 2) hybrid_fwd(Params P) {
    extern __shared__ __attribute__((aligned(16))) unsigned char smem[];
    ldsp_t lds = (ldsp_t)smem;
    const int tid = threadIdx.x;
    if (tid < 4) ((LAS unsigned*)(lds + LDS_XB))[tid] = 0u;
    ((LAS int*)(lds + LDS_WSLOT))[hw_slot()] = tid >> 6;
    __syncthreads();
    XcdBarrier bar = xcd_barrier_post((unsigned*)(P.ws + WS_BAR), (volatile LAS unsigned*)(lds + LDS_XB));
#define PHASE_PTRS() unsigned char* ws = wsp(P); float* xb = (float*)(ws + WS_X); bf16_t* hb = (bf16_t*)(ws + WS_H); bf16_t* act = (bf16_t*)(ws + WS_ACT); bf16_t* zb = (bf16_t*)(ws + WS_Z); const float* modl = (const float*)(ws + WS_MOD) + (size_t)l * 10 * MODLD; (void)xb; (void)hb; (void)act; (void)zb; (void)modl
#define SEAM2() do { XcdBarrier b_ = bar; { unsigned* q_ = b_.bar; asm volatile("" : "+v"(q_)); b_.bar = q_; } xcd_barrier(b_); } while (0)
#define SEAM() do { XcdBarrier b_ = bar; { unsigned* q_ = b_.bar; asm volatile("" : "+v"(q_)); b_.bar = q_; } xcd_barrier(b_); } while (0)

    prologue_phase(P, lds);
    SEAM();
    { constexpr int l = 0;
        if (l == 0) norm_phase(P, lds, l, 0, true); else norm_phase(P, lds, l, 0, false, 22, (const float*)(wsp(P) + WS_MOD) + (size_t)(l - 1) * 10 * MODLD + 8 * D, 0.5f);
        SEAM();
        { PHASE_PTRS(); EpiSwiglu E{act}; run_gemm(lds, hb, (const bf16_t*)(ws + WS_WFI + (size_t)(l * 2 + 0) * SZ_WFI), MP, 2 * DFF, D, E); }
        if (l == 1 && sbid() >= 172) conv_deferred(P, lds, 672, 1344, 172);
        SEAM();
        { PHASE_PTRS(); EpiResid E{l == 0 ? INP(I_XP) : (const float*)xb, xb, modl + 2 * D, 0.5f}; run_gemm(lds, act, (const bf16_t*)(ws + WS_WFO + (size_t)(l * 2 + 0) * SZ_WFO), NTOK_P, D, DFF, E); }
        { PHASE_PTRS(); EpiSlab E{(float*)(ws + WS_LOUT)}; run_gemm_splitk(lds, act + (size_t)NTOK_P * DFF, (const bf16_t*)(ws + WS_WFO + (size_t)(l * 2 + 0) * SZ_WFO), D, DFF, 256, E); }
        SEAM();
        norm_phase(P, lds, l, 1, false, 22, (const float*)(wsp(P) + WS_MOD) + (size_t)l * 10 * MODLD + 2 * D, 0.5f);
        SEAM();
        { PHASE_PTRS(); EpiBf16Plain E{zb, ZLD}; run_gemm(lds, hb, (const bf16_t*)(ws + WS_WIN + (size_t)l * SZ_WIN), MP, ZLD, D, E); }
        if (sbid() >= 122) cache_convert(P, l, 122);
        if (l == 1 && sbid() >= 122) conv_deferred(P, lds, 1344, 2112, 122);
        SEAM();
        prep_phase(P, l);
        SEAM();
        { PHASE_PTRS(); EpiLora E{(float*)(ws + WS_LOUT), INP(I_W0) + l * 1024, INP(I_A0) + l * 1024}; run_gemm(lds, (const bf16_t*)(ws + WS_LIN), (const bf16_t*)(ws + WS_WLO + (size_t)l * SZ_WLO), MP, 3072, 256, E); }
        __syncthreads();
        mlstm_pass_a(P, lds, l, (int)gridDim.x - 1 - sbid(), gridDim.x);
        SEAM();
        rwkv_pre(P, l);
        SEAM();
        { const int G = gridDim.x, nR = G / 2, bx = blockIdx.x;
          if (bx < nR) { for (int i0 = bx; i0 < 128; i0 += nR) { const int it = (nR == 128) ? ((i0 & 7) * 16 + (i0 >> 3)) : i0;
              rwkv_item(P, lds, l, it >> 6, (it >> 2) & 15, it & 3, true); } } }
        { const int G = gridDim.x, nR = G / 2, bx = blockIdx.x;
          if (bx >= nR) { const int bb = bx - nR, nO = G - nR, nH = nO / 2;
              { PHASE_PTRS(); EpiBf16Plain E{(bf16_t*)(ws + WS_VT), KEYS}; run_gemm_sub(lds, (const bf16_t*)(ws + WS_WKV + (size_t)l * SZ_WKK), (const bf16_t*)(ws + WS_LATA), 1024, KEYS, 512, E, nO, bb); }
              { PHASE_PTRS(); EpiBf16Plain E{(bf16_t*)(ws + WS_KN), 1024}; run_gemm_sub(lds, (const bf16_t*)(ws + WS_LATA), (const bf16_t*)(ws + WS_WKK + (size_t)l * SZ_WKK), KEYS, 1024, 512, E, nO, bb); }
              sub_barrier((unsigned*)(wsp(P) + WS_BAR) + 3584, (unsigned*)(wsp(P) + WS_BAR) + XB_TMO, (unsigned)nO, (unsigned)l);
              for (int it = bb; it < 512; it += nO) rwkv_item(P, lds, l, it >> 6, (it >> 2) & 15, it & 3, false);
              if (nO == 128) { const int x = bb & 7, j = (bb >> 3) & 15;
                  attn_prompt_item(P, lds, (2 * x) * 16 + j); attn_prompt_item(P, lds, (2 * x + 1) * 16 + (15 - j)); }
              else { for (int it = bb; it < 256; it += nO) attn_prompt_item(P, lds, it); }
              for (int it = bb - nH; it >= 0 && it < 64; it += nO) attn_sample_item(P, lds, it); } }
        { const int G = gridDim.x, nR = G / 2, bx = blockIdx.x; if (bx >= nR) mlstm_pass_b(P, l, (bx - nR) * 512 + vtid(), (G - nR) * 512); }
        if (l == 0 && (int)sbid() >= 128 && (int)sbid() < 192) { __syncthreads(); conv_deferred_fo(P, lds, (int)sbid() - 128, 64); }
        SEAM();
        mlstm_pass_c(P, lds, l);
        rwkv_post(P, l);
        SEAM();
        { PHASE_PTRS(); EpiBranchSeq E{zb + ZG, INP(I_BM) + (size_t)l * 3 * D, (float*)(ws + WS_ACT), (bf16_t*)(ws + WS_MIX)};
          pg8::Gemm g{(const bf16_t*)(ws + WS_OALL), (const bf16_t*)(ws + WS_WBR + (size_t)(l * 3) * SZ_WBR), NTOK_P, D, 1024, 1024, 1024, (long)1024 * 512, (long)1024 * 512, 0};
          BranchOrder S{(int)sbid(), 256}; pg8::gemm_phase<EpiBranchSeq, BranchOrder, false>((PG8_LAS unsigned char*)lds, g, S, E, nullptr); }
        for (int n = 0; n < 3; ++n) { PHASE_PTRS(); EpiBranchSlab E{zb + ZG + n * D, INP(I_BM) + (size_t)l * 3 * D + n * D, (float*)(ws + WS_LOUT), 4 * n};
            run_gemm_splitk(lds, (const bf16_t*)(ws + WS_OALL) + (size_t)n * MP * 1024 + (size_t)NTOK_P * 1024, (const bf16_t*)(ws + WS_WBR + (size_t)(l * 3 + n) * SZ_WBR), D, 1024, 256, E, 32 * n); }
        SEAM();
        sample_mix_convert(P);
        SEAM();
        { PHASE_PTRS(); EpiResid E{xb, xb, modl + 5 * D, 1.0f}; run_gemm(lds, (const bf16_t*)(ws + WS_MIX), (const bf16_t*)(ws + WS_WO + (size_t)l * SZ_WO), NTOK_P, D, D, E); }
        { PHASE_PTRS(); EpiSlab E{(float*)(ws + WS_LOUT)}; run_gemm_splitk(lds, (const bf16_t*)(ws + WS_MIX) + (size_t)NTOK_P * D, (const bf16_t*)(ws + WS_WO + (size_t)l * SZ_WO), D, D, 256, E); }
        SEAM();
        norm_phase(P, lds, l, 2, false, 8, (const float*)(wsp(P) + WS_MOD) + (size_t)l * 10 * MODLD + 5 * D, 1.0f);
        SEAM();
        { PHASE_PTRS(); EpiSwiglu E{act}; run_gemm(lds, hb, (const bf16_t*)(ws + WS_WFI + (size_t)(l * 2 + 1) * SZ_WFI), MP, 2 * DFF, D, E); }
        if (l == 0 && sbid() >= 172) conv_deferred(P, lds, 0, 672, 172);
        SEAM();
        { PHASE_PTRS(); EpiResid E{xb, xb, modl + 8 * D, 0.5f}; run_gemm(lds, act, (const bf16_t*)(ws + WS_WFO + (size_t)(l * 2 + 1) * SZ_WFO), NTOK_P, D, DFF, E); }
        { PHASE_PTRS(); EpiSlab E{(float*)(ws + WS_LOUT)}; run_gemm_splitk(lds, act + (size_t)NTOK_P * DFF, (const bf16_t*)(ws + WS_WFO + (size_t)(l * 2 + 1) * SZ_WFO), D, DFF, 256, E); }
        SEAM();
    }
    { constexpr int l = 1;
        if (l == 0) norm_phase(P, lds, l, 0, true); else norm_phase(P, lds, l, 0, false, 22, (const float*)(wsp(P) + WS_MOD) + (size_t)(l - 1) * 10 * MODLD + 8 * D, 0.5f);
        SEAM();
        { PHASE_PTRS(); EpiSwiglu E{act}; run_gemm(lds, hb, (const bf16_t*)(ws + WS_WFI + (size_t)(l * 2 + 0) * SZ_WFI), MP, 2 * DFF, D, E); }
        if (l == 1 && sbid() >= 172) conv_deferred(P, lds, 672, 1344, 172);
        SEAM();
        { PHASE_PTRS(); EpiResid E{l == 0 ? INP(I_XP) : (const float*)xb, xb, modl + 2 * D, 0.5f}; run_gemm(lds, act, (const bf16_t*)(ws + WS_WFO + (size_t)(l * 2 + 0) * SZ_WFO), NTOK_P, D, DFF, E); }
        { PHASE_PTRS(); EpiSlab E{(float*)(ws + WS_LOUT)}; run_gemm_splitk(lds, act + (size_t)NTOK_P * DFF, (const bf16_t*)(ws + WS_WFO + (size_t)(l * 2 + 0) * SZ_WFO), D, DFF, 256, E); }
        SEAM();
        norm_phase(P, lds, l, 1, false, 22, (const float*)(wsp(P) + WS_MOD) + (size_t)l * 10 * MODLD + 2 * D, 0.5f);
        SEAM();
        { PHASE_PTRS(); EpiBf16Plain E{zb, ZLD}; run_gemm(lds, hb, (const bf16_t*)(ws + WS_WIN + (size_t)l * SZ_WIN), MP, ZLD, D, E); }
        if (sbid() >= 122) cache_convert(P, l, 122);
        if (l == 1 && sbid() >= 122) conv_deferred(P, lds, 1344, 2112, 122);
        SEAM();
        prep_phase(P, l);
        SEAM();
        { PHASE_PTRS(); EpiLora E{(float*)(ws + WS_LOUT), INP(I_W0) + l * 1024, INP(I_A0) + l * 1024}; run_gemm(lds, (const bf16_t*)(ws + WS_LIN), (const bf16_t*)(ws + WS_WLO + (size_t)l * SZ_WLO), MP, 3072, 256, E); }
        __syncthreads();
        mlstm_pass_a(P, lds, l, (int)gridDim.x - 1 - sbid(), gridDim.x);
        SEAM();
        rwkv_pre(P, l);
        SEAM();
        { const int G = gridDim.x, nR = G / 2, bx = blockIdx.x;
          if (bx < nR) { for (int i0 = bx; i0 < 128; i0 += nR) { const int it = (nR == 128) ? ((i0 & 7) * 16 + (i0 >> 3)) : i0;
              rwkv_item(P, lds, l, it >> 6, (it >> 2) & 15, it & 3, true); } } }
        { const int G = gridDim.x, nR = G / 2, bx = blockIdx.x;
          if (bx >= nR) { const int bb = bx - nR, nO = G - nR, nH = nO / 2;
              { PHASE_PTRS(); EpiBf16Plain E{(bf16_t*)(ws + WS_VT), KEYS}; run_gemm_sub(lds, (const bf16_t*)(ws + WS_WKV + (size_t)l * SZ_WKK), (const bf16_t*)(ws + WS_LATA), 1024, KEYS, 512, E, nO, bb); }
              { PHASE_PTRS(); EpiBf16Plain E{(bf16_t*)(ws + WS_KN), 1024}; run_gemm_sub(lds, (const bf16_t*)(ws + WS_LATA), (const bf16_t*)(ws + WS_WKK + (size_t)l * SZ_WKK), KEYS, 1024, 512, E, nO, bb); }
              sub_barrier((unsigned*)(wsp(P) + WS_BAR) + 3584, (unsigned*)(wsp(P) + WS_BAR) + XB_TMO, (unsigned)nO, (unsigned)l);
              for (int it = bb; it < 512; it += nO) rwkv_item(P, lds, l, it >> 6, (it >> 2) & 15, it & 3, false);
              if (nO == 128) { const int x = bb & 7, j = (bb >> 3) & 15;
                  attn_prompt_item(P, lds, (2 * x) * 16 + j); attn_prompt_item(P, lds, (2 * x + 1) * 16 + (15 - j)); }
              else { for (int it = bb; it < 256; it += nO) attn_prompt_item(P, lds, it); }
              for (int it = bb - nH; it >= 0 && it < 64; it += nO) attn_sample_item(P, lds, it); } }
        { const int G = gridDim.x, nR = G / 2, bx = blockIdx.x; if (bx >= nR) mlstm_pass_b(P, l, (bx - nR) * 512 + vtid(), (G - nR) * 512); }
        if (l == 0 && (int)sbid() >= 128 && (int)sbid() < 192) { __syncthreads(); conv_deferred_fo(P, lds, (int)sbid() - 128, 64); }
        SEAM();
        mlstm_pass_c(P, lds, l);
        rwkv_post(P, l);
        SEAM();
        { PHASE_PTRS(); EpiBranchSeq E{zb + ZG, INP(I_BM) + (size_t)l * 3 * D, (float*)(ws + WS_ACT), (bf16_t*)(ws + WS_MIX)};
          pg8::Gemm g{(const bf16_t*)(ws + WS_OALL), (const bf16_t*)(ws + WS_WBR + (size_t)(l * 3) * SZ_WBR), NTOK_P, D, 1024, 1024, 1024, (long)1024 * 512, (long)1024 * 512, 0};
          BranchOrder S{(int)sbid(), 256}; pg8::gemm_phase<EpiBranchSeq, BranchOrder, false>((PG8_LAS unsigned char*)lds, g, S, E, nullptr); }
        for (int n = 0; n < 3; ++n) { PHASE_PTRS(); EpiBranchSlab E{zb + ZG + n * D, INP(I_BM) + (size_t)l * 3 * D + n * D, (float*)(ws + WS_LOUT), 4 * n};
            run_gemm_splitk(lds, (const bf16_t*)(ws + WS_OALL) + (size_t)n * MP * 1024 + (size_t)NTOK_P * 1024, (const bf16_t*)(ws + WS_WBR + (size_t)(l * 3 + n) * SZ_WBR), D, 1024, 256, E, 32 * n); }
        SEAM();
        sample_mix_convert(P);
        SEAM();
        { PHASE_PTRS(); EpiResid E{xb, xb, modl + 5 * D, 1.0f}; run_gemm(lds, (const bf16_t*)(ws + WS_MIX), (const bf16_t*)(ws + WS_WO + (size_t)l * SZ_WO), NTOK_P, D, D, E); }
        { PHASE_PTRS(); EpiSlab E{(float*)(ws + WS_LOUT)}; run_gemm_splitk(lds, (const bf16_t*)(ws + WS_MIX) + (size_t)NTOK_P * D, (const bf16_t*)(ws + WS_WO + (size_t)l * SZ_WO), D, D, 256, E); }
        SEAM();
        norm_phase(P, lds, l, 2, false, 8, (const float*)(wsp(P) + WS_MOD) + (size_t)l * 10 * MODLD + 5 * D, 1.0f);
        SEAM();
        { PHASE_PTRS(); EpiSwiglu E{act}; run_gemm(lds, hb, (const bf16_t*)(ws + WS_WFI + (size_t)(l * 2 + 1) * SZ_WFI), MP, 2 * DFF, D, E); }
        if (l == 0 && sbid() >= 172) conv_deferred(P, lds, 0, 672, 172);
        SEAM();
        { PHASE_PTRS(); EpiResid E{xb, xb, modl + 8 * D, 0.5f}; run_gemm(lds, act, (const bf16_t*)(ws + WS_WFO + (size_t)(l * 2 + 1) * SZ_WFO), NTOK_P, D, DFF, E); }
        { PHASE_PTRS(); EpiSlab E{(float*)(ws + WS_LOUT)}; run_gemm_splitk(lds, act + (size_t)NTOK_P * DFF, (const bf16_t*)(ws + WS_WFO + (size_t)(l * 2 + 1) * SZ_WFO), D, DFF, 256, E); }
        SEAM();
    }
    final_phase(P, lds, 22, (const float*)(wsp(P) + WS_MOD) + (size_t)(NLAYER - 1) * 10 * MODLD + 8 * D, 0.5f);
}

extern "C" void kernel_launch(void* const* d_in, const int* in_sizes, int n_in, void* d_out, int out_size, void* d_ws, size_t ws_size, hipStream_t stream) {
    static int grid = 0;
    if (grid == 0) {
        if (n_in != 37 || (size_t)out_size != O_END || ws_size < WS_END) { fprintf(stderr, "kernel_launch: unexpected shapes: n_in %d out %d ws %zu (need %zu)\n", n_in, out_size, ws_size, (size_t)WS_END); grid = -1; return; }
        int dev = 0, cus = 0;
        if (hipGetDevice(&dev) != hipSuccess || hipDeviceGetAttribute(&cus, hipDeviceAttributeMultiprocessorCount, dev) != hipSuccess) { grid = -1; return; }
        if (hipFuncSetAttribute((const void*)hybrid_fwd, hipFuncAttributeMaxDynamicSharedMemorySize, LDS_BYTES) != hipSuccess) { fprintf(stderr, "kernel_launch: hipFuncSetAttribute failed\n"); grid = -1; return; }
        int per_cu = 0;
        if (hipOccupancyMaxActiveBlocksPerMultiprocessor(&per_cu, (const void*)hybrid_fwd, 512, LDS_BYTES) != hipSuccess || per_cu < 1) { fprintf(stderr, "kernel_launch: occupancy query says %d\n", per_cu); }
        (void)hipGetLastError();
        grid = cus;
    }
    if (grid < 0) return;
    hipMemsetAsync((char*)d_ws + WS_BAR, 0, 16384, stream);
    Params p{};
    for (int i = 0; i < 37; ++i) p.in[i] = (const float*)d_in[i];
    p.out = (float*)d_out; p.ws = (unsigned char*)d_ws;
    hipLaunchKernelGGL(hybrid_fwd, dim3(grid), dim3(512), LDS_BYTES, stream, p);
}
```
